# Optimizing an MI355X kernel written in HIP

```python
import math
import jax, jax.numpy as jnp
from jax import lax
import numpy as np

D_MODEL = 1024
BATCH = 4
SEQ = 8192
DEPTH = 1
DEC_BATCH = 2
DEC_SEQ = 8192
PAST_LEN = 128

GRID_W = 64
HEAD_DIM = 64
HQ_A = 8
HKV_A = 2
GROUP_A = HQ_A // HKV_A
AX_DIM = HEAD_DIM // 2
AX_THETA = 10000.0
A_Q = HQ_A * HEAD_DIM
A_KV = HKV_A * HEAD_DIM
BR_A = A_Q
H_B = 4
B_QK = H_B * 2 * HEAD_DIM
B_V = H_B * 2 * HEAD_DIM
BR_B = B_V
ROT_DIM = HEAD_DIM // 4
ROPE_THETA = 500000.0
D_IN = A_Q + 2 * A_KV + BR_A + 2 * B_QK + B_V + BR_B + 2 * D_MODEL
Q_BLOCK = 128
EPS = 1e-6

kernel_name = "hybrid_gqa_axial_diffattn_encoder"


def rms_norm(x, g):
    x32 = x.astype(jnp.float32)
    y = x32 * lax.rsqrt(jnp.mean(x32 * x32, axis=-1, keepdims=True) + EPS)
    return (y * g.astype(jnp.float32)).astype(x.dtype)


def rope_tables(pos, dim, theta):
    inv = theta ** (-jnp.arange(0, dim, 2, dtype=jnp.float32) / dim)
    ang = pos.astype(jnp.float32)[:, None] * inv[None, :]
    ang = jnp.concatenate([ang, ang], axis=-1)
    return jnp.cos(ang), jnp.sin(ang)


def apply_rope(x, cos, sin):
    shape = (1, x.shape[1]) + (1,) * (x.ndim - 3) + (x.shape[-1],)
    cos = cos.reshape(shape).astype(x.dtype)
    sin = sin.reshape(shape).astype(x.dtype)
    half = x.shape[-1] // 2
    x1, x2 = x[..., :half], x[..., half:]
    rot = jnp.concatenate([-x2, x1], axis=-1)
    return x * cos + rot * sin


def gqa_attention(q, k, v):
    B, S = q.shape[0], q.shape[1]
    nb = S // Q_BLOCK
    scale = 1.0 / math.sqrt(HEAD_DIM)
    qb = q.reshape(B, nb, Q_BLOCK, HKV_A, GROUP_A, HEAD_DIM).transpose(1, 0, 2, 3, 4, 5)

    def one(qblk):
        s = jnp.einsum('bqgrd,bkgd->bgrqk', qblk, k).astype(jnp.float32) * scale
        p = jax.nn.softmax(s, axis=-1).astype(v.dtype)
        return jnp.einsum('bgrqk,bkgd->bqgrd', p, v)

    o = lax.map(one, qb)
    return o.transpose(1, 0, 2, 3, 4, 5).reshape(B, S, HQ_A * HEAD_DIM)


def diff_attention(q, k, v, lam):
    B, S = q.shape[0], q.shape[1]
    nb = S // Q_BLOCK
    scale = 1.0 / math.sqrt(HEAD_DIM)
    qb = q.reshape(B, nb, Q_BLOCK, H_B, 2, HEAD_DIM).transpose(1, 0, 2, 3, 4, 5)

    def one(qblk):
        s = jnp.einsum('bqhmd,bkhmd->bhmqk', qblk, k).astype(jnp.float32) * scale
        p = jax.nn.softmax(s, axis=-1)
        pd = (p[:, :, 0] - lam * p[:, :, 1]).astype(v.dtype)
        return jnp.einsum('bhqk,bkhe->bqhe', pd, v)

    o = lax.map(one, qb)
    return o.transpose(1, 0, 2, 3, 4).reshape(B, S, H_B, 2 * HEAD_DIM)


def encoder_layer(x, c, layer_idx, w_ada, b_ada, norm_g, w_in, qn_a, kn_a, qn_b, kn_b,
                  lam_q1, lam_k1, lam_q2, lam_k2, subln_g, w_proj_a, w_proj_b, w_out):
    B, S, _ = x.shape
    rows = S // GRID_W
    mod = jnp.einsum('bd,de->be', jax.nn.silu(c), w_ada) + b_ada
    shift, scale, gate = jnp.split(mod, 3, axis=-1)
    h = rms_norm(x, norm_g) * (1.0 + scale[:, None, :]) + shift[:, None, :]

    proj = jnp.einsum('bsd,de->bse', h, w_in)
    o1 = A_Q
    o2 = o1 + A_KV
    o3 = o2 + A_KV
    o4 = o3 + BR_A
    o5 = o4 + B_QK
    o6 = o5 + B_QK
    o7 = o6 + B_V
    o8 = o7 + BR_B
    o9 = o8 + D_MODEL
    qa, ka, va, za, qb, kb, vb, zb, ga, gb = jnp.split(proj, [o1, o2, o3, o4, o5, o6, o7, o8, o9], axis=-1)

    qa = rms_norm(qa.reshape(B, S, HQ_A, HEAD_DIM), qn_a)
    ka = rms_norm(ka.reshape(B, S, HKV_A, HEAD_DIM), kn_a)
    va = va.reshape(B, S, HKV_A, HEAD_DIM)
    row = jnp.repeat(jnp.arange(rows), GRID_W)
    col = jnp.tile(jnp.arange(GRID_W), rows)
    cos_r, sin_r = rope_tables(row, AX_DIM, AX_THETA)
    cos_c, sin_c = rope_tables(col, AX_DIM, AX_THETA)
    qa = jnp.concatenate([apply_rope(qa[..., :AX_DIM], cos_r, sin_r),
                          apply_rope(qa[..., AX_DIM:], cos_c, sin_c)], axis=-1)
    ka = jnp.concatenate([apply_rope(ka[..., :AX_DIM], cos_r, sin_r),
                          apply_rope(ka[..., AX_DIM:], cos_c, sin_c)], axis=-1)
    oa = gqa_attention(qa, ka, va) * jax.nn.silu(za)

    qb = rms_norm(qb.reshape(B, S, H_B, 2, HEAD_DIM), qn_b)
    kb = rms_norm(kb.reshape(B, S, H_B, 2, HEAD_DIM), kn_b)
    vb = vb.reshape(B, S, H_B, 2 * HEAD_DIM)
    cos_p, sin_p = rope_tables(jnp.arange(S), ROT_DIM, ROPE_THETA)
    qb = jnp.concatenate([apply_rope(qb[..., :ROT_DIM], cos_p, sin_p), qb[..., ROT_DIM:]], axis=-1)
    kb = jnp.concatenate([apply_rope(kb[..., :ROT_DIM], cos_p, sin_p), kb[..., ROT_DIM:]], axis=-1)
    lam_init = 0.8 - 0.6 * math.exp(-0.3 * layer_idx)
    lam = (jnp.exp(jnp.sum(lam_q1.astype(jnp.float32) * lam_k1.astype(jnp.float32)))
           - jnp.exp(jnp.sum(lam_q2.astype(jnp.float32) * lam_k2.astype(jnp.float32)))
           + lam_init)
    ob = diff_attention(qb, kb, vb, lam)
    ob = rms_norm(ob, subln_g) * (1.0 - lam_init)
    ob = ob.reshape(B, S, BR_B) * jax.nn.silu(zb)

    pa = jnp.einsum('bse,ed->bsd', oa, w_proj_a)
    pb = jnp.einsum('bse,ed->bsd', ob, w_proj_b)
    merged = jax.nn.sigmoid(ga) * pa + jax.nn.sigmoid(gb) * pb
    out = jnp.einsum('bsd,de->bse', merged, w_out)
    return x + gate[:, None, :] * out


def setup_inputs(seed: int = 0) -> dict:
    key = jax.random.key(seed)
    ks = jax.random.split(key, 20)
    f32 = jnp.float32
    D = D_MODEL

    def nrm(k, shape, s):
        return jax.random.normal(k, shape, f32) * s

    return {
        "x_prompt": nrm(ks[0], (BATCH, SEQ, D), 1.0),
        "x_sample": nrm(ks[1], (DEC_BATCH, DEC_SEQ, D), 1.0),
        "c_prompt": nrm(ks[2], (BATCH, D), 1.0),
        "c_sample": nrm(ks[3], (DEC_BATCH, D), 1.0),
        "w_ada": nrm(ks[4], (DEPTH, D, 3 * D), 0.5 * D ** -0.5),
        "b_ada": nrm(ks[5], (DEPTH, 3 * D), 0.01),
        "norm_g": 1.0 + nrm(ks[6], (DEPTH, D), 0.02),
        "w_in": nrm(ks[7], (DEPTH, D, D_IN), D ** -0.5),
        "qn_a": 1.0 + nrm(ks[8], (DEPTH, HEAD_DIM), 0.02),
        "kn_a": 1.0 + nrm(ks[9], (DEPTH, HEAD_DIM), 0.02),
        "qn_b": 1.0 + nrm(ks[10], (DEPTH, HEAD_DIM), 0.02),
        "kn_b": 1.0 + nrm(ks[11], (DEPTH, HEAD_DIM), 0.02),
        "lam_q1": nrm(ks[12], (DEPTH, HEAD_DIM), 0.1),
        "lam_k1": nrm(ks[13], (DEPTH, HEAD_DIM), 0.1),
        "lam_q2": nrm(ks[14], (DEPTH, HEAD_DIM), 0.1),
        "lam_k2": nrm(ks[15], (DEPTH, HEAD_DIM), 0.1),
        "subln_g": 1.0 + nrm(ks[16], (DEPTH, 2 * HEAD_DIM), 0.02),
        "w_proj_a": nrm(ks[17], (DEPTH, BR_A, D), BR_A ** -0.5),
        "w_proj_b": nrm(ks[18], (DEPTH, BR_B, D), BR_B ** -0.5),
        "w_out": nrm(ks[19], (DEPTH, D, D), D ** -0.5),
    }


def reference(x_prompt, x_sample, c_prompt, c_sample, w_ada, b_ada, norm_g, w_in,
              qn_a, kn_a, qn_b, kn_b, lam_q1, lam_k1, lam_q2, lam_k2, subln_g,
              w_proj_a, w_proj_b, w_out):
    yp = x_prompt
    ys = x_sample
    for i in range(DEPTH):
        args = (w_ada[i], b_ada[i], norm_g[i], w_in[i], qn_a[i], kn_a[i], qn_b[i], kn_b[i],
                lam_q1[i], lam_k1[i], lam_q2[i], lam_k2[i], subln_g[i],
                w_proj_a[i], w_proj_b[i], w_out[i])
        yp = encoder_layer(yp, c_prompt, i, *args)
        ys = encoder_layer(ys, c_sample, i, *args)
    y_prompt = yp
    y_sample = ys
    return (y_prompt, y_sample)
```

```cpp
#include <hip/hip_runtime.h>
#include <cstdio>
#include <cstdint>
#include <cmath>

#define LAS __attribute__((address_space(3)))
#define GAS __attribute__((address_space(1)))
typedef unsigned short h16_t;
#ifndef LP_BF16
#define LP_BF16 1
#endif
#if LP_BF16
typedef __bf16 lp_t;
typedef short f16x8 __attribute__((ext_vector_type(8)));
#define MFMA16(a, b, c) __builtin_amdgcn_mfma_f32_16x16x32_bf16(a, b, c, 0, 0, 0)
#define MFMA32(a, b, c) __builtin_amdgcn_mfma_f32_32x32x16_bf16(a, b, c, 0, 0, 0)
#else
typedef _Float16 lp_t;
typedef _Float16 f16x8 __attribute__((ext_vector_type(8)));
#define MFMA16(a, b, c) __builtin_amdgcn_mfma_f32_16x16x32_f16(a, b, c, 0, 0, 0)
#endif
typedef lp_t f16x2 __attribute__((ext_vector_type(2)));
typedef float f32x2 __attribute__((ext_vector_type(2)));
typedef float f32x4 __attribute__((ext_vector_type(4)));
typedef float f32x8 __attribute__((ext_vector_type(8)));
typedef float f32x16 __attribute__((ext_vector_type(16)));
typedef unsigned u32x2 __attribute__((ext_vector_type(2)));
typedef unsigned u32x4 __attribute__((ext_vector_type(4)));
typedef short s16x4 __attribute__((ext_vector_type(4)));
typedef int i32x4 __attribute__((ext_vector_type(4)));
typedef int i32x8 __attribute__((ext_vector_type(8)));
typedef int i32x6 __attribute__((ext_vector_type(6)));
#define MFMA8S_G(a, b, c) __builtin_amdgcn_mfma_scale_f32_16x16x128_f8f6f4(a, b, c, 0, 0, 0, scv, 1, scv)

constexpr int DM = 1024, SEQ = 8192, NBATCH = 6, TOK = NBATCH * SEQ, TOKP = 4 * SEQ, DIN = 5376;
constexpr float EPS = 1e-6f;
constexpr float C2 = 0.125f * 1.4426950408889634f;
constexpr float SQK6 = 1.2011224087864498f;
constexpr float LAM_INIT = 0.2f;

constexpr size_t MiB = 1u << 20;
constexpr size_t WS_MODP = 1 * MiB;
constexpr size_t WS_GATE = 3 * MiB;
constexpr size_t WS_TAR = 3 * MiB + 65536;
constexpr size_t WS_TAC = WS_TAR + 8192;
constexpr size_t WS_TB = WS_TAC + 4096;
constexpr size_t WS_NRM = WS_GATE + 32768;
constexpr size_t WS_AMAX = WS_GATE + 32768 + 4096;
constexpr size_t WS_SSQ = 4 * MiB;
constexpr size_t WS_WIN = 6 * MiB;
constexpr size_t WS_WAB = 17 * MiB;
constexpr size_t WS_WOUT = 21 * MiB;
constexpr size_t WS_XN = 24 * MiB;
constexpr size_t WS_MG = WS_XN;
constexpr size_t WS_QA = 120 * MiB, WS_KA = 168 * MiB, WS_VA = 180 * MiB, WS_QB = 192 * MiB, WS_KB = 240 * MiB, WS_VB = 288 * MiB;
constexpr size_t WS_OAB = 336 * MiB;
constexpr size_t WS_SGA = 120 * MiB, WS_SGB = 216 * MiB;
constexpr size_t WS_VTA = 432 * MiB;
constexpr size_t WS_VTB = 438 * MiB;
constexpr size_t WS_XN8 = WS_VB;
constexpr size_t WS_WIN8G = WS_VA + 2 * MiB;
constexpr size_t WS_AMAXG = WS_AMAX + 1024;
constexpr size_t WS_WIN8 = WS_VA;
constexpr size_t WS_END = 462 * MiB;

__device__ __forceinline__ unsigned pk2h(float lo, float hi) { f32x2 v = {lo, hi}; f16x2 b = __builtin_convertvector(v, f16x2); return __builtin_bit_cast(unsigned, b); }
__device__ __forceinline__ float h2f(unsigned short u) { return (float)__builtin_bit_cast(lp_t, u); }
__device__ __forceinline__ unsigned short f2h(float v) { return __builtin_bit_cast(unsigned short, (lp_t)v); }
__device__ __forceinline__ int lane_id() { unsigned z = 0u; asm volatile("" : "+v"(z)); return (int)__builtin_amdgcn_mbcnt_hi(~0u, __builtin_amdgcn_mbcnt_lo(~0u, z)); }
__device__ __forceinline__ float wave_sum(float v) {
#pragma unroll
    for (int o = 1; o < 64; o <<= 1) v += __shfl_xor(v, o);
    return v;
}
__device__ __forceinline__ float silu_f(float v) { return v * __builtin_amdgcn_rcpf(1.0f + __expf(-v)); }
__device__ __forceinline__ float sigm_f(float v) { return __builtin_amdgcn_rcpf(1.0f + __expf(-v)); }

namespace pg8 {
constexpr int BM = 256, BK = 64, HALF = 128, HTB = HALF * BK * 2, STAGE_BYTES = 8 * HTB, NXCD = 8, WGM = 8;
__host__ __device__ __forceinline__ int lds_byte(int r, int c) { const int st = (r >> 4) * 2 + (c >> 5), rr = r & 15, cc = c & 31, ob = rr * 64 + cc * 2; return st * 1024 + (ob ^ (((ob >> 9) & 1) << 5)); }
__host__ __device__ __forceinline__ void stage_rc(int b, int& R, int& C) { const int st = b / 1024, sb = b % 1024, swz = sb ^ (((sb >> 9) & 1) << 5); R = (st >> 1) * 16 + swz / 64; C = (st & 1) * 32 + (swz % 64) / 2; }
__host__ __device__ __forceinline__ int perm32(int rho) { const int n = rho >> 4, i = rho & 15; return 8 * (i >> 2) + 4 * n + (i & 3); }
struct Unit { int pm, pn; };
struct Gemm { const h16_t* A; const h16_t* Bt; int M, N, K; int sc = 0x7f7f; };
struct StaticOrder {
    int nM, nN, nwg, G, c, i2, G2, c2;
    __device__ void init(int M, int N, int G_, int c_) { nM = M / BM; nN = N / BM; nwg = nM * nN; G = G_; c = c_; i2 = 1 << 20; G2 = G_; c2 = c_; }
    __device__ bool next(int i, Unit& u) const {
        long L;
        if (i < i2) L = (long)i * G + c; else { if (c2 < 0) return false; L = (long)i2 * G + (long)(i - i2) * G2 + c2; }
        if (L >= nwg) return false;
        int wgid = (int)L; { const int q = nwg / NXCD, r = nwg % NXCD, xcd = wgid % NXCD, off = wgid / NXCD; wgid = (xcd < r ? xcd * (q + 1) : r * (q + 1) + (xcd - r) * q) + off; }
        const int nig = WGM * nN, gid = wgid / nig, fm = gid * WGM, gsz = (nM - fm) < WGM ? (nM - fm) : WGM;
        u.pm = fm + ((wgid % nig) % gsz); u.pn = (wgid % nig) / gsz; return true;
    }
};
__device__ __forceinline__ i32x8 cat8(f16x8 a, f16x8 b) { const i32x4 x = __builtin_bit_cast(i32x4, a), y = __builtin_bit_cast(i32x4, b); return __builtin_shufflevector(x, y, 0, 1, 2, 3, 4, 5, 6, 7); }
template <class Epi, bool DIAG = false, bool F8 = false>
__device__ __forceinline__ void gemm_phase(LAS unsigned char* lds, const Gemm g, const StaticOrder& S, const Epi& E, int wave_in) {
    int tid = wave_in * 64 + lane_id(); asm volatile("" : "+v"(tid));
    const int wid = wave_in, lane = tid & 63, wr = wid >> 2, wc = wid & 3, fr = lane & 15, fq = lane >> 4;
    const int K = g.K, nt = K / BK;
    int scv = g.sc; asm volatile("" : "+v"(scv)); (void)scv;
    unsigned voffA[2], voffB[2];
#pragma unroll
    for (int i = 0; i < 2; ++i) { int R, C; stage_rc(tid * 16 + i * 8192, R, C); const int Rb = Epi::PERM ? ((R & ~31) + perm32(R & 31)) : R;
        voffA[i] = (unsigned)(R * K + C) * 2u; voffB[i] = (unsigned)(Rb * K + C) * 2u; }
    const size_t kstep = (size_t)(BK * 2);
    const size_t hstep = (size_t)HALF * K * 2;
    const size_t tstep = 2 * hstep;
    const unsigned ldsw = (unsigned)wid * 1024u;
    const int aoff = lds_byte(wr * 64 + fr, fq * 8), boff = lds_byte(wc * 32 + fr, fq * 8);
#define PG8_SA(b, h) (((b) * 2 + (h)) * HTB)
#define PG8_SB(b, h) ((4 + (b) * 2 + (h)) * HTB)
#define PG8_STAGE(bufoff, gbase, voff) do { _Pragma("unroll") for (int _i = 0; _i < 2; ++_i) \
        __builtin_amdgcn_global_load_lds((const unsigned*)((const char*)(gbase) + (voff)[_i]), (LAS unsigned*)(lds + (bufoff) + ldsw + _i * 8192), 16, 0, 0); } while (0)
#define PG8_LD8(p) ({ const i32x4 x_ = *(const LAS i32x4*)(p), y_ = *(const LAS i32x4*)((p) + 1024); (i32x8){x_[0], x_[1], x_[2], x_[3], y_[0], y_[1], y_[2], y_[3]}; })
#define PG8_LDA(dst, b, h) do { if constexpr (F8) { _Pragma("unroll") for (int m = 0; m < 4; ++m) dst##8[m] = PG8_LD8(lds + PG8_SA(b, h) + aoff + m * 2048); } else { \
        _Pragma("unroll") for (int m = 0; m < 4; ++m) _Pragma("unroll") for (int k = 0; k < 2; ++k) dst[m][k] = *(const LAS f16x8*)(lds + PG8_SA(b, h) + aoff + m * 2048 + k * 1024); } } while (0)
#define PG8_LDB(dst, b, h) do { if constexpr (F8) { _Pragma("unroll") for (int n = 0; n < 2; ++n) dst##8[n] = PG8_LD8(lds + PG8_SB(b, h) + boff + n * 2048); } else { \
        _Pragma("unroll") for (int n = 0; n < 2; ++n) _Pragma("unroll") for (int k = 0; k < 2; ++k) dst[n][k] = *(const LAS f16x8*)(lds + PG8_SB(b, h) + boff + n * 2048 + k * 1024); } } while (0)
#define PG8_MMA(ai, bj, At, Bt) do { __builtin_amdgcn_s_setprio(1); if constexpr (F8) { _Pragma("unroll") for (int m = 0; m < 4; ++m) _Pragma("unroll") for (int n = 0; n < 2; ++n) \
        { if (n == 0) acc8[ai][bj][m].lo = MFMA8S_G(Bt##8[n], At##8[m], acc8[ai][bj][m].lo); else acc8[ai][bj][m].hi = MFMA8S_G(Bt##8[n], At##8[m], acc8[ai][bj][m].hi); } \
        _Pragma("unroll") for (int m = 0; m < 4; ++m) asm volatile("" : "+v"(acc8[ai][bj][m])); } else { \
        _Pragma("unroll") for (int m = 0; m < 4; ++m) _Pragma("unroll") for (int n = 0; n < 2; ++n) _Pragma("unroll") for (int k = 0; k < 2; ++k) \
        acc[ai][bj][m][n] = MFMA16(Bt[n][k], At[m][k], acc[ai][bj][m][n]); } __builtin_amdgcn_s_setprio(0); } while (0)
#define PG8_WAIT_V(n) asm volatile("s_waitcnt vmcnt(" #n ")" ::: "memory")
#define PG8_WAIT_L(n) asm volatile("s_waitcnt lgkmcnt(" #n ")" ::: "memory")
#define PG8_BAR __builtin_amdgcn_s_barrier()
#define PG8_SCHED __builtin_amdgcn_sched_barrier(0)
    Unit cur, nxt; int ui = 0;
    if (!S.next(0, cur)) return;
    f32x4 acc[2][2][4][2];
    f32x8 acc8[2][2][4];
#pragma unroll
    for (int a = 0; a < 2; ++a)
#pragma unroll
        for (int b = 0; b < 2; ++b)
#pragma unroll
            for (int m = 0; m < 4; ++m) acc8[a][b][m] = (f32x8){0.f, 0.f, 0.f, 0.f, 0.f, 0.f, 0.f, 0.f};
#pragma unroll
    for (int a = 0; a < 2; ++a)
#pragma unroll
        for (int b = 0; b < 2; ++b)
#pragma unroll
            for (int m = 0; m < 4; ++m)
#pragma unroll
                for (int n = 0; n < 2; ++n) acc[a][b][m][n] = (f32x4){0.f, 0.f, 0.f, 0.f};
    f16x8 At[4][2], B0[2][2], B1[2][2]; i32x8 At8[4], B08[2], B18[2];
    const char* cA = (const char*)g.A + (size_t)cur.pm * tstep; const char* cB = (const char*)g.Bt + (size_t)cur.pn * tstep;
    PG8_STAGE(PG8_SB(0, 0), cB, voffB); if (!DIAG) PG8_STAGE(PG8_SB(0, 1), cB + hstep, voffB); PG8_STAGE(PG8_SA(0, 0), cA, voffA); PG8_STAGE(PG8_SA(0, 1), cA + hstep, voffA);
    if (wr == 1) PG8_BAR;
    PG8_WAIT_V(2); PG8_BAR;
    PG8_STAGE(PG8_SB(1, 0), cB + kstep, voffB); PG8_STAGE(PG8_SA(1, 0), cA + kstep, voffA); if (!DIAG) PG8_STAGE(PG8_SB(1, 1), cB + hstep + kstep, voffB);
    if (DIAG) { PG8_WAIT_V(4); } else { PG8_WAIT_V(6); } PG8_BAR;
    for (;;) {
        const bool has_next = S.next(ui + 1, nxt);
        const char* nA = has_next ? (const char*)g.A + (size_t)nxt.pm * tstep : cA; const char* nB = has_next ? (const char*)g.Bt + (size_t)nxt.pn * tstep : cB;
#pragma unroll 1
        for (int t = 0; t < nt; t += 2) {
            const bool last = (t == nt - 2); const bool lo_half = (2 * t < nt); (void)lo_half;
            const char* a1 = cA + (size_t)(t + 1) * kstep;
            const char* a2 = last ? nA : cA + (size_t)(t + 2) * kstep; const char* b2 = last ? nB : cB + (size_t)(t + 2) * kstep;
            const char* a3 = a2 + kstep; const char* b3 = b2 + kstep;
            const bool lo2 = last || (2 * (t + 2) < nt), lo3 = last || (2 * (t + 3) < nt); (void)lo2; (void)lo3;
#define PG8_WV() do { if (DIAG) { PG8_WAIT_V(6); } else { PG8_WAIT_V(8); } } while (0)
            if (!DIAG || lo_half) PG8_LDB(B0, 0, 0); if (!DIAG || !lo_half) PG8_LDB(B1, 0, 1); PG8_SCHED; PG8_LDA(At, 0, 0); PG8_STAGE(PG8_SA(1, 1), a1 + hstep, voffA);
            PG8_WV(); PG8_WAIT_L(0); PG8_BAR; if (!DIAG || lo_half) PG8_MMA(0, 0, At, B0); if (!DIAG || !lo_half) PG8_MMA(0, 1, At, B1); PG8_BAR; PG8_SCHED;
            PG8_LDA(At, 0, 1); if (!DIAG || lo2) PG8_STAGE(PG8_SB(0, 0), b2, voffB); if (!DIAG || !lo2) PG8_STAGE(PG8_SB(0, 1), b2 + hstep, voffB); PG8_STAGE(PG8_SA(0, 0), a2, voffA);
            PG8_WV(); PG8_WAIT_L(0); PG8_BAR; if (!DIAG || lo_half) PG8_MMA(1, 0, At, B0); if (!DIAG || !lo_half) PG8_MMA(1, 1, At, B1); PG8_BAR; PG8_SCHED;
            if (!DIAG || lo_half) PG8_LDB(B0, 1, 0); if (!DIAG || !lo_half) PG8_LDB(B1, 1, 1); PG8_SCHED; PG8_LDA(At, 1, 0); PG8_STAGE(PG8_SA(0, 1), a2 + hstep, voffA);
            PG8_WV(); PG8_WAIT_L(0); PG8_BAR; if (!DIAG || lo_half) PG8_MMA(0, 0, At, B0); if (!DIAG || !lo_half) PG8_MMA(0, 1, At, B1); PG8_BAR; PG8_SCHED;
            PG8_LDA(At, 1, 1); if (!DIAG || lo3) PG8_STAGE(PG8_SB(1, 0), b3, voffB); if (!DIAG || !lo3) PG8_STAGE(PG8_SB(1, 1), b3 + hstep, voffB); PG8_STAGE(PG8_SA(1, 0), a3, voffA);
            PG8_WV(); PG8_WAIT_L(0); PG8_BAR; if (!DIAG || lo_half) PG8_MMA(1, 0, At, B0); if (!DIAG || !lo_half) PG8_MMA(1, 1, At, B1); PG8_BAR; PG8_SCHED;
#undef PG8_WV
        }
        if (wr == 0) PG8_BAR;
        if constexpr (F8) {
#pragma unroll
            for (int a = 0; a < 2; ++a)
#pragma unroll
                for (int b = 0; b < 2; ++b)
#pragma unroll
                    for (int m = 0; m < 4; ++m) { acc[a][b][m][0] = acc8[a][b][m].lo; acc[a][b][m][1] = acc8[a][b][m].hi; acc8[a][b][m] = (f32x8){0.f, 0.f, 0.f, 0.f, 0.f, 0.f, 0.f, 0.f}; }
        }
        { int l2 = lane_id(); asm volatile("" : "+v"(l2)); E(acc, cur, wr, wc, l2 & 15, l2 >> 4); }
        if (!has_next) break;
#pragma unroll
        for (int a = 0; a < 2; ++a)
#pragma unroll
            for (int b = 0; b < 2; ++b)
#pragma unroll
                for (int m = 0; m < 4; ++m)
#pragma unroll
                    for (int n = 0; n < 2; ++n) acc[a][b][m][n] = (f32x4){0.f, 0.f, 0.f, 0.f};
        cur = nxt; cA = nA; cB = nB; ++ui;
        if (wr == 1) PG8_BAR;
    }
    PG8_WAIT_V(0);
    PG8_BAR;
#undef PG8_SA
#undef PG8_SB
#undef PG8_STAGE
#undef PG8_LDA
#undef PG8_LDB
#undef PG8_MMA
#undef PG8_WAIT_V
#undef PG8_WAIT_L
#undef PG8_BAR
#undef PG8_SCHED
}
}

__device__ __forceinline__ float xsum16(float x) { const auto r = __builtin_amdgcn_permlane16_swap(__float_as_uint(x), __float_as_uint(x), false, false); return __uint_as_float(r[0]) + __uint_as_float(r[1]); }
__device__ __forceinline__ float xsum32(float x) { const auto r = __builtin_amdgcn_permlane32_swap(__float_as_uint(x), __float_as_uint(x), false, false); return __uint_as_float(r[0]) + __uint_as_float(r[1]); }
struct EpiInProj {
    static constexpr bool PERM = true;
    int part; unsigned char* ws; int use8; int pnoff; float wsc;
    __device__ __forceinline__ void operator()(const f32x4 (&acc)[2][2][4][2], const pg8::Unit& u, int wr, int wc, int fr, int fq) const {
        asm volatile("" : "+v"(fr), "+v"(fq));
        const int row0 = u.pm * 256 + wr * 64 + fr;
        const int pi = u.pn + pnoff;
        const int T = part == 0 ? (pi < 2 ? pi : (pi < 6 ? pi + 3 : (pi == 6 ? 2 : pi + 2))) : (pi < 2 ? pi + 3 : pi + 9);
        if (part == 0) {
            const bool normed = (T <= 1) || (T == 2 && wc < 2) || (T >= 5 && T <= 8);
            if (normed) {
                const bool isA = (T <= 2), isQ = (T <= 1) || (T == 5) || (T == 6);
                const float* gw = (const float*)(ws + WS_NRM) + 64 * ((isA ? 0 : 2) + (isQ ? 0 : 1));
                h16_t* dst; int pitch, colbase;
                if (T <= 1) { dst = (h16_t*)(ws + WS_QA); pitch = 512; colbase = 256 * T + 64 * wc; }
                else if (T == 2) { dst = (h16_t*)(ws + WS_KA); pitch = 128; colbase = 64 * wc; }
                else if (T <= 6) { dst = (h16_t*)(ws + WS_QB); pitch = 512; colbase = 256 * (T - 5) + 64 * wc; }
                else { dst = (h16_t*)(ws + WS_KB); pitch = 512; colbase = 256 * (T - 7) + 64 * wc; }
                f32x4 gv[2][2];
#pragma unroll
                for (int bj = 0; bj < 2; ++bj)
#pragma unroll
                    for (int n = 0; n < 2; ++n) gv[bj][n] = *(const f32x4*)(gw + 32 * bj + 8 * fq + 4 * n) * (use8 ? SQK6 : 1.0f);
                const float sc = isQ ? C2 : 1.0f;
                const int pidx32 = ((fr | (fq << 4)) ^ 32) << 2, pidx16 = ((fr | (fq << 4)) ^ 16) << 2;
                const h16_t* tar = (const h16_t*)(ws + WS_TAR); const h16_t* tac = (const h16_t*)(ws + WS_TAC); const h16_t* tb = (const h16_t*)(ws + WS_TB);
                const int pitch6 = (pitch >> 6) * 48, hoff6 = (colbase >> 6) * 48;
                f32x4 ysv[4][2][2];
                extern __shared__ __attribute__((aligned(16))) unsigned char epi_lds_[];
                LAS unsigned char* stl = (LAS unsigned char*)epi_lds_ + pg8::STAGE_BYTES + (wr * 4 + wc) * 3072;
#pragma unroll
                for (int ai = 0; ai < 2; ++ai) {
#pragma unroll
                    for (int m = 0; m < 4; ++m) {
                        const int r = row0 + ai * 128 + m * 16, t = r & (SEQ - 1);
                        float ss = 0.f;
#pragma unroll
                        for (int bj = 0; bj < 2; ++bj)
#pragma unroll
                            for (int n = 0; n < 2; ++n) { const f32x4 v = acc[ai][bj][m][n]; ss += (v[0] * v[0] + v[1] * v[1]) + (v[2] * v[2] + v[3] * v[3]); }
                        ss = xsum16(ss); ss = xsum32(ss);
                        const float rs = __builtin_amdgcn_rsqf(ss * (wsc * wsc * (1.0f / 64.0f)) + EPS) * wsc;
                        f32x4 y[2][2];
#pragma unroll
                        for (int bj = 0; bj < 2; ++bj)
#pragma unroll
                            for (int n = 0; n < 2; ++n) y[bj][n] = acc[ai][bj][m][n] * rs * gv[bj][n];
                        if (isA) {
#pragma unroll
                            for (int bj = 0; bj < 2; ++bj) {
                                const int pos = bj == 0 ? (t >> 6) : (t & 63);
                                const h16_t* tp = (bj == 0 ? tar : tac) + pos * 32 + 8 * (fq & 1);
                                const u32x4 cw = *(const u32x4*)tp, sw = *(const u32x4*)(tp + 16);
                                const float sgn = fq < 2 ? -1.0f : 1.0f;
#pragma unroll
                                for (int n = 0; n < 2; ++n)
#pragma unroll
                                    for (int i = 0; i < 4; ++i) {
                                        const int e = 4 * n + i; const unsigned cwe = cw[e >> 1], swe = sw[e >> 1];
                                        const float cs = h2f((unsigned short)((e & 1) ? (cwe >> 16) : (cwe & 0xffffu))), sn = h2f((unsigned short)((e & 1) ? (swe >> 16) : (swe & 0xffffu)));
                                        const float yv = y[bj][n][i], pv = __uint_as_float((unsigned)__builtin_amdgcn_ds_bpermute(pidx32, (int)__float_as_uint(yv)));
                                        y[bj][n][i] = yv * cs + sgn * pv * sn;
                                    }
                            }
                        } else {
                            const h16_t* tp = tb + t * 16;
                            const u32x4 cw = *(const u32x4*)tp, sw = *(const u32x4*)(tp + 8);
                            const float sgn = fq == 0 ? -1.0f : 1.0f;
#pragma unroll
                            for (int n = 0; n < 2; ++n)
#pragma unroll
                                for (int i = 0; i < 4; ++i) {
                                    const int e = 4 * n + i; const unsigned cwe = cw[e >> 1], swe = sw[e >> 1];
                                    const float cs = h2f((unsigned short)((e & 1) ? (cwe >> 16) : (cwe & 0xffffu))), sn = h2f((unsigned short)((e & 1) ? (swe >> 16) : (swe & 0xffffu)));
                                    const float yv = y[0][n][i], pv = __uint_as_float((unsigned)__builtin_amdgcn_ds_bpermute(pidx16, (int)__float_as_uint(yv)));
                                    y[0][n][i] = fq < 2 ? (yv * cs + sgn * pv * sn) : yv;
                                }
                        }
#pragma unroll
                        for (int bj = 0; bj < 2; ++bj) {
                            if (use8) { ysv[m][bj][0] = y[bj][0]; ysv[m][bj][1] = y[bj][1];
                            } else {
                            u32x4 w; w.x = pk2h(y[bj][0][0] * sc, y[bj][0][1] * sc); w.y = pk2h(y[bj][0][2] * sc, y[bj][0][3] * sc); w.z = pk2h(y[bj][1][0] * sc, y[bj][1][1] * sc); w.w = pk2h(y[bj][1][2] * sc, y[bj][1][3] * sc);
                            *(u32x4*)(dst + (size_t)r * pitch + colbase + 32 * bj + 8 * fq) = w; }
                        }
                    }
                    if (use8) {
#pragma unroll
                        for (int bj = 0; bj < 2; ++bj) {
                            f32x16 s0, s1;
#pragma unroll
                            for (int i = 0; i < 16; ++i) { const int m_ = i >> 2, c0 = 2 * (i & 3); s0[i] = ysv[m_][bj][c0 >> 2][c0 & 3]; s1[i] = ysv[m_][bj][(c0 + 1) >> 2][(c0 + 1) & 3]; }
                            const i32x6 d6 = __builtin_amdgcn_cvt_scalef32_2xpk16_fp6_f32(s0, s1, 1.0f);
                            const int dwoff = fq == 0 ? 16 * bj : (fq == 1 ? 16 * bj + 8 : (fq == 2 ? 16 * bj + 12 : 36 + 8 * bj));
                            const int shoff = fq == 0 ? 16 * bj + 4 : (fq == 1 ? 16 * bj + 6 : (fq == 2 ? 32 + 8 * bj : 34 + 8 * bj));
#pragma unroll
                            for (int m = 0; m < 4; ++m) {
                                const unsigned a0 = (unsigned)d6[3 * (m >> 1)], a1 = (unsigned)d6[3 * (m >> 1) + 1], a2 = (unsigned)d6[3 * (m >> 1) + 2];
                                const unsigned lo = (m & 1) ? ((a1 >> 16) | (a2 << 16)) : a0, hi16 = (m & 1) ? (a2 >> 16) : (a1 & 0xffffu);
                                const unsigned dwv = (fq & 1) ? ((lo >> 16) | (hi16 << 16)) : lo, shv = (fq & 1) ? (lo & 0xffffu) : hi16;
                                LAS unsigned char* p6 = stl + (m * 16 + fr) * 48;
                                *(LAS unsigned*)(p6 + dwoff) = dwv; *(LAS unsigned short*)(p6 + shoff) = (unsigned short)shv;
                            }
                        }
                        asm volatile("s_waitcnt lgkmcnt(0)" ::: "memory");
                        {   const int lrow = fr + 16 * fq;
                            unsigned char* g6 = (unsigned char*)dst + (size_t)(u.pm * 256 + wr * 64 + ai * 128 + lrow) * pitch6 + hoff6;
#pragma unroll
                            for (int j = 0; j < 3; ++j) { const u32x4 v = *(const LAS u32x4*)(stl + lrow * 48 + 16 * j); *(u32x4*)(g6 + 16 * j) = v; }
                        }
                        asm volatile("s_waitcnt lgkmcnt(0)" ::: "memory");
                    }
                }
            } else if (use8) {
                unsigned char* vt; int drow0;
                if (T == 2) { vt = ws + WS_VTA; drow0 = (wc - 2) * 64; } else { vt = ws + WS_VTB; drow0 = (2 * (T - 9) + (wc >> 1)) * 128 + (wc & 1) * 64; }
                const int rows_per_b = (T == 2) ? 128 : 512;
                extern __shared__ __attribute__((aligned(16))) unsigned char epi_lds_[];
                LAS unsigned char* stl = (LAS unsigned char*)epi_lds_ + pg8::STAGE_BYTES + (wr * 4 + wc) * 3072;
#pragma unroll
                for (int ai = 0; ai < 2; ++ai) {
                    const int rt = u.pm * 256 + wr * 64 + ai * 128, b = rt >> 13, tk0 = rt & (SEQ - 1);
#pragma unroll
                    for (int bj = 0; bj < 2; ++bj) {
#pragma unroll
                        for (int m = 0; m < 4; ++m) {
                            const int tau = 16 * m + fr;
                            const int pos = 32 * ((tau >> 2) & 1) + 16 * (tau >> 5) + 4 * ((tau >> 3) & 3) + (tau & 3);
#pragma unroll
                            for (int n = 0; n < 2; ++n) { const f32x4 v = acc[ai][bj][m][n];
                                int w0 = 0; w0 = __builtin_amdgcn_cvt_pk_fp8_f32(v[0], v[1], w0, false); w0 = __builtin_amdgcn_cvt_pk_fp8_f32(v[2], v[3], w0, true);
#pragma unroll
                                for (int i = 0; i < 4; ++i) stl[(8 * fq + 4 * n + i) * 64 + pos] = (unsigned char)((unsigned)w0 >> (8 * i)); }
                        }
                        asm volatile("s_waitcnt lgkmcnt(0)" ::: "memory");
                        const int ln_ = fr + 16 * fq;
#pragma unroll
                        for (int j = 0; j < 2; ++j) { const int id = ln_ + 64 * j, dl = id >> 2, c16 = id & 3;
                            const u32x4 v = *(const LAS u32x4*)(stl + dl * 64 + 16 * c16);
                            *(u32x4*)(vt + ((size_t)(b * rows_per_b + drow0 + 32 * bj + dl)) * SEQ + tk0 + 16 * c16) = v; }
                        asm volatile("s_waitcnt lgkmcnt(0)" ::: "memory");
                    }
                }
            } else {
                h16_t* dst; int pitch, colbase;
                if (T == 2) { dst = (h16_t*)(ws + WS_VA); pitch = 128; colbase = 64 * (wc - 2); }
                else { dst = (h16_t*)(ws + WS_VB); pitch = 512; colbase = 256 * (T - 9) + 64 * wc; }
#pragma unroll
                for (int ai = 0; ai < 2; ++ai)
#pragma unroll
                    for (int m = 0; m < 4; ++m) {
                        const int r = row0 + ai * 128 + m * 16;
#pragma unroll
                        for (int bj = 0; bj < 2; ++bj) {
                            const f32x4 v0 = acc[ai][bj][m][0], v1 = acc[ai][bj][m][1];
                            u32x4 w; w.x = pk2h(v0[0], v0[1]); w.y = pk2h(v0[2], v0[3]); w.z = pk2h(v1[0], v1[1]); w.w = pk2h(v1[2], v1[3]);
                            *(u32x4*)(dst + (size_t)r * pitch + colbase + 32 * bj + 8 * fq) = w;
                        }
                    }
            }
        } else {
            if (T <= 12) {
                h16_t* oab = (h16_t*)(ws + WS_OAB);
                const int colt = (T >= 11 ? 512 + 256 * (T - 11) : 256 * (T - 3)) + 64 * wc;
#pragma unroll
                for (int aim = 0; aim < 4; ++aim) { const int ai = aim >> 1, m0 = (aim & 1) * 2;
                    u32x4 ovs[2][4][2];
#pragma unroll
                    for (int m = m0; m < m0 + 2; ++m)
#pragma unroll
                        for (int bj = 0; bj < 2; ++bj) ovs[ai][m][bj] = *(const u32x4*)(oab + (size_t)(row0 + ai * 128 + m * 16) * 1024 + colt + 16 * fq + 8 * bj);
                    __builtin_amdgcn_sched_barrier(0);
#pragma unroll
                    for (int m = m0; m < m0 + 2; ++m) {
                        const int r = row0 + ai * 128 + m * 16;
#pragma unroll
                        for (int bj = 0; bj < 2; ++bj) {
                            h16_t* p = oab + (size_t)r * 1024 + colt + 16 * fq + 8 * bj;
                            const u32x4 ov = ovs[ai][m][bj];
                            float o[8];
#pragma unroll
                            for (int e = 0; e < 4; ++e) { o[2 * e] = h2f((unsigned short)(ov[e] & 0xffffu)); o[2 * e + 1] = h2f((unsigned short)(ov[e] >> 16)); }
                            float q[8];
#pragma unroll
                            for (int n = 0; n < 2; ++n)
#pragma unroll
                                for (int i = 0; i < 4; ++i) q[4 * n + i] = o[4 * n + i] * silu_f(acc[ai][bj][m][n][i]);
                            u32x4 w; w.x = pk2h(q[0], q[1]); w.y = pk2h(q[2], q[3]); w.z = pk2h(q[4], q[5]); w.w = pk2h(q[6], q[7]);
                            *(u32x4*)p = w;
                        }
                    }
                    __builtin_amdgcn_sched_barrier(0);
                }
            } else {
                unsigned char* dst = ws + (T <= 16 ? WS_SGA : WS_SGB);
                const int colt = 256 * (T <= 16 ? T - 13 : T - 17) + 64 * wc;
#pragma unroll
                for (int ai = 0; ai < 2; ++ai)
#pragma unroll
                    for (int m = 0; m < 4; ++m) {
                        const int r = row0 + ai * 128 + m * 16;
                        u32x4 w;
#pragma unroll
                        for (int bj = 0; bj < 2; ++bj) {
                            const f32x4 v0 = acc[ai][bj][m][0], v1 = acc[ai][bj][m][1];
                            unsigned w0 = 0u, w1 = 0u;
#pragma unroll
                            for (int i = 0; i < 4; ++i) {
                                w0 = __builtin_amdgcn_cvt_pk_u8_f32(__builtin_amdgcn_rcpf(__builtin_fmaf(__builtin_amdgcn_exp2f(v0[i] * wsc), 1.0f / 255.0f, 1.0f / 255.0f)), i, w0);
                                w1 = __builtin_amdgcn_cvt_pk_u8_f32(__builtin_amdgcn_rcpf(__builtin_fmaf(__builtin_amdgcn_exp2f(v1[i] * wsc), 1.0f / 255.0f, 1.0f / 255.0f)), i, w1); }
                            w[2 * bj] = w0; w[2 * bj + 1] = w1;
                        }
                        *(u32x4*)(dst + (size_t)r * 1024 + colt + 16 * fq) = w;
                    }
            }
        }
    }
};
struct EpiMerge {
    static constexpr bool PERM = true;
    const unsigned char* SGA; const unsigned char* SGB; h16_t* MG;
    __device__ __forceinline__ void operator()(const f32x4 (&acc)[2][2][4][2], const pg8::Unit& u, int wr, int wc, int fr, int fq) const {
        asm volatile("" : "+v"(fr), "+v"(fq));
        const int row0 = u.pm * 256 + wr * 64 + fr, col0 = u.pn * 128 + wc * 32 + 8 * fq;
#pragma unroll
        for (int ai = 0; ai < 2; ++ai) {
            u32x2 gas[2][4], gbs[2][4];
#pragma unroll
            for (int m = 0; m < 4; ++m) { const size_t off = (size_t)(row0 + ai * 128 + m * 16) * 1024 + col0; gas[ai][m] = *(const u32x2*)(SGA + off); gbs[ai][m] = *(const u32x2*)(SGB + off); }
            __builtin_amdgcn_sched_barrier(0);
#pragma unroll
            for (int m = 0; m < 4; ++m) {
                const size_t off = (size_t)(row0 + ai * 128 + m * 16) * 1024 + col0;
                const u32x2 ga = gas[ai][m], gb = gbs[ai][m];
                float q[8];
#pragma unroll
                for (int e = 0; e < 8; ++e) {
                    const float a = (float)((ga[e >> 2] >> (8 * (e & 3))) & 0xffu), b = (float)((gb[e >> 2] >> (8 * (e & 3))) & 0xffu);
                    q[e] = (a * acc[ai][0][m][e >> 2][e & 3] + b * acc[ai][1][m][e >> 2][e & 3]) * (1.0f / 255.0f);
                }
                u32x4 w; w.x = pk2h(q[0], q[1]); w.y = pk2h(q[2], q[3]); w.z = pk2h(q[4], q[5]); w.w = pk2h(q[6], q[7]);
                *(u32x4*)(MG + off) = w;
            }
            __builtin_amdgcn_sched_barrier(0);
        }
    }
};
struct EpiOut {
    static constexpr bool PERM = false;
    const float* xp; long xs_delta; const float* gate; float* out;
    __device__ __forceinline__ void operator()(const f32x4 (&acc)[2][2][4][2], const pg8::Unit& u, int wr, int wc, int fr, int fq) const {
        asm volatile("" : "+v"(fr), "+v"(fq));
        const int row0 = u.pm * 256 + wr * 64 + fr, col0 = u.pn * 256 + wc * 32 + 4 * fq;
        const float* grow = gate + ((u.pm * 256) >> 13) * DM;
        f32x4 gvs[2][2];
#pragma unroll
        for (int bj = 0; bj < 2; ++bj)
#pragma unroll
            for (int n = 0; n < 2; ++n) gvs[bj][n] = *(const f32x4*)(grow + col0 + bj * 128 + n * 16);
#pragma unroll
        for (int aim = 0; aim < 4; ++aim) { const int ai = aim >> 1, m0 = (aim & 1) * 2;
            f32x4 xvs[4][2][2];
#pragma unroll
            for (int m = m0; m < m0 + 2; ++m) {
                const int r = row0 + ai * 128 + m * 16;
                const float* xrow = (const float*)((const char*)(xp + (size_t)r * DM) + (r >= TOKP ? xs_delta : 0l));
#pragma unroll
                for (int bj = 0; bj < 2; ++bj)
#pragma unroll
                    for (int n = 0; n < 2; ++n) xvs[m][bj][n] = *(const f32x4*)(xrow + col0 + bj * 128 + n * 16);
            }
            __builtin_amdgcn_sched_barrier(0);
#pragma unroll
            for (int m = m0; m < m0 + 2; ++m) {
                const int r = row0 + ai * 128 + m * 16;
#pragma unroll
                for (int bj = 0; bj < 2; ++bj)
#pragma unroll
                    for (int n = 0; n < 2; ++n) {
                        const int c = col0 + bj * 128 + n * 16;
                        *(f32x4*)(out + (size_t)r * DM + c) = xvs[m][bj][n] + gvs[bj][n] * acc[ai][bj][m][n];
                    }
            }
            __builtin_amdgcn_sched_barrier(0);
        }
    }
};

namespace att {
constexpr int NW = 8, QBLK = 32, QB = QBLK * NW, KVBLK = 64, NT = SEQ / KVBLK;
constexpr int NSLOT = 3, SLOTB = 8192;
constexpr int NS8 = 6, SB8 = 4096;
constexpr int LDS_K = 0, LDS_V = NSLOT * SLOTB, LDS_WS = LDS_V + NSLOT * 2 * SLOTB, LDS_OST = LDS_WS + NW * 64 * 4, OST_WAVE = 8192, LDS_BYTES = LDS_OST + NW * OST_WAVE;
__device__ __forceinline__ int crow(int r, int hi) { return (r & 3) + 8 * (r >> 2) + 4 * hi; }
#define SBAR() __builtin_amdgcn_sched_barrier(0)
__device__ __forceinline__ void glds16(const void* gsrc, unsigned lds_dst) { unsigned keep;
    asm volatile("s_mov_b32 %0, m0\n\ts_mov_b32 m0, %2\n\ts_nop 0\n\tglobal_load_lds_dwordx4 %1, off\n\ts_mov_b32 m0, %0" : "=&s"(keep) : "v"(gsrc), "s"(lds_dst) : "memory"); }
__device__ __forceinline__ float max3f(float a, float b, float c) { float r; asm("v_max3_f32 %0, %1, %2, %3" : "=v"(r) : "v"(a), "v"(b), "v"(c)); return r; }
__device__ __forceinline__ float max2f(float a, float b) { float r; asm("v_max_f32_e32 %0, %1, %2" : "=v"(r) : "v"(a), "v"(b)); return r; }
__device__ __forceinline__ float fadd_s(float a, float b) { float r; asm("v_add_f32_e32 %0, %1, %2" : "=v"(r) : "v"(a), "v"(b)); return r; }
__device__ __forceinline__ float fsub_s(float a, float b) { float r; asm("v_sub_f32_e32 %0, %1, %2" : "=v"(r) : "v"(a), "v"(b)); return r; }
#define WAIT_BAR(N) asm volatile("s_waitcnt vmcnt(" #N ") lgkmcnt(0)\n\ts_barrier" ::: "memory")
__device__ __forceinline__ void qkt(f32x16& p0, f32x16& p1, const char* Kslot, const f16x8* qr, const f32x16& negm, int r32, int hi) {
    const char* kb = Kslot + hi * 1024 + r32 * 16;
#pragma unroll
    for (int d0 = 0; d0 < 4; ++d0) {
        const f16x8 b0 = *reinterpret_cast<const f16x8*>(kb + d0 * 2048);
        const f16x8 b1 = *reinterpret_cast<const f16x8*>(kb + d0 * 2048 + 512);
        if (d0 == 0) { p0 = MFMA32(b0, qr[0], negm); p1 = MFMA32(b1, qr[0], negm); }
        else { p0 = MFMA32(b0, qr[d0], p0); p1 = MFMA32(b1, qr[d0], p1); } }
}
typedef LAS const char* lds_cptr;
typedef short v4i16_t __attribute__((ext_vector_type(4)));
__device__ __forceinline__ void kload8(f16x8* kf, lds_cptr kp) {
    kf[0] = *(const LAS f16x8*)(kp);        kf[1] = *(const LAS f16x8*)(kp + 512);
    kf[2] = *(const LAS f16x8*)(kp + 2048); kf[3] = *(const LAS f16x8*)(kp + 2560);
    kf[4] = *(const LAS f16x8*)(kp + 4096); kf[5] = *(const LAS f16x8*)(kp + 4608);
    kf[6] = *(const LAS f16x8*)(kp + 6144); kf[7] = *(const LAS f16x8*)(kp + 6656);
}
__device__ __forceinline__ void kload2(f16x8* kf, lds_cptr kp, int j) { kf[2 * j] = *(const LAS f16x8*)(kp + j * 2048); kf[2 * j + 1] = *(const LAS f16x8*)(kp + j * 2048 + 512); }
__device__ __forceinline__ s16x4 vtr(lds_cptr p) { return __builtin_bit_cast(s16x4, __builtin_amdgcn_ds_read_tr16_b64_v4i16((LAS v4i16_t*)p)); }
__device__ __forceinline__ float rowmax(const f32x16& p0, const f32x16& p1) {
    float a = max3f(p0[0], p0[1], p1[0]), b = max3f(p0[2], p0[3], p1[1]); a = max3f(a, p1[2], p1[3]);
#pragma unroll
    for (int r = 4; r < 16; r += 4) { a = max3f(a, p0[r], p0[r + 1]); b = max3f(b, p0[r + 2], p0[r + 3]); a = max3f(a, p1[r], p1[r + 1]); b = max3f(b, p1[r + 2], p1[r + 3]); }
    const float m = max2f(a, b);
    auto rr = __builtin_amdgcn_permlane32_swap(__float_as_uint(m), __float_as_uint(m), false, false);
    return max2f(__uint_as_float(rr[0]), __uint_as_float(rr[1]));
}
__device__ __forceinline__ f16x8 mk8(s16x4 lo, s16x4 hi) { typedef short s16x8 __attribute__((ext_vector_type(8))); s16x8 v = {lo[0], lo[1], lo[2], lo[3], hi[0], hi[1], hi[2], hi[3]}; return __builtin_bit_cast(f16x8, v); }
__device__ __forceinline__ void pv(f32x16* o, int vb, f16x8 pa0, f16x8 pa1, f16x8 pa2, f16x8 pa3) {
#pragma unroll
    for (int d0 = 0; d0 < 2; ++d0) { s16x4 lo[4], hi[4];
#pragma unroll
        for (int ks = 0; ks < 4; ++ks) {
            asm volatile("ds_read_b64_tr_b16 %0,%1 offset:%c2" : "=&v"(lo[ks]) : "v"(vb), "i"(d0 * 4096 + ks * 1024) : "memory");
            asm volatile("ds_read_b64_tr_b16 %0,%1 offset:%c2" : "=&v"(hi[ks]) : "v"(vb), "i"(d0 * 4096 + ks * 1024 + 512) : "memory"); }
        asm volatile("s_waitcnt lgkmcnt(0)" ::: "memory"); SBAR();
        o[d0] = MFMA32(pa0, mk8(lo[0], hi[0]), o[d0]);
        o[d0] = MFMA32(pa1, mk8(lo[1], hi[1]), o[d0]);
        o[d0] = MFMA32(pa2, mk8(lo[2], hi[2]), o[d0]);
        o[d0] = MFMA32(pa3, mk8(lo[3], hi[3]), o[d0]);
    }
}
template <int THRL, bool FAST> __device__ __forceinline__ void attn_pass(const h16_t* Qw, int QP, const h16_t* Kh, int KP, const h16_t* Vh, int VP, char* shm, f32x16 (&o)[2], float& l_out, int wave_in) {
    int tid = wave_in * 64 + lane_id(); asm volatile("" : "+v"(tid));
    const int lane = tid & 63, r32 = lane & 31, hi = lane >> 5; const int wid = wave_in;
    const unsigned lds0 = (unsigned)(uintptr_t)shm;
    float* wsf = (float*)(shm + LDS_WS) + wid * 64;
    const h16_t* ksrc = Kh + (long)lane * KP + wid * 8;
    const h16_t* vsrc = Vh + (long)(16 * (wid & 3) + (lane >> 2)) * VP + (wid >> 2) * 32 + (lane & 3) * 8;
    const unsigned kdst = lds0 + LDS_K + wid * 1024, vdst = lds0 + LDS_V + wid * 1024;
#define DMA_K(t, slot) glds16(ksrc + (long)(t) * KVBLK * KP, (unsigned)__builtin_amdgcn_readfirstlane(kdst + (slot)))
#define DMA_V(t, slot) glds16(vsrc + (long)(t) * KVBLK * VP, (unsigned)__builtin_amdgcn_readfirstlane(vdst + (slot)))
    const int vb0 = (int)(lds0 + LDS_V) + ((lane >> 4) & 1) * 32 + (lane & 3) * 8 + (4 * hi + ((lane & 15) >> 2)) * 64;
    const char* Kbase = shm + LDS_K; f16x8 kf[8];
    const lds_cptr shm3 = (lds_cptr)shm; const lds_cptr kp0 = shm3 + LDS_K + hi * 1024 + r32 * 16; const lds_cptr vp0 = shm3 + LDS_V + ((lane >> 4) & 1) * 32 + (lane & 3) * 8 + (4 * hi + ((lane & 15) >> 2)) * 64;
    DMA_K(0, 0); DMA_V(0, 0); DMA_K(1, SLOTB);
    f16x8 qr[4];
#pragma unroll
    for (int d0 = 0; d0 < 4; ++d0) qr[d0] = *reinterpret_cast<const f16x8*>(&Qw[(long)r32 * QP + d0 * 16 + hi * 8]);
    float mhat = 0.f, l_reg = 0.f; o[0] = f32x16{}; o[1] = f32x16{}; f32x16 negm = f32x16{}; if constexpr (!FAST) asm volatile("" : "+v"(negm));
    bool resc = false;
#define NEGM (FAST ? f32x16{} : negm)
#define START(P0, P1) do { if constexpr (!FAST) { const float rm = rowmax(P0, P1); resc = false; \
    { const float dl = rm; mhat = fadd_s(mhat, dl); \
      _Pragma("unroll") for (int r = 0; r < 16; ++r) { P0[r] = fsub_s(P0[r], dl); P1[r] = fsub_s(P1[r], dl); } \
      _Pragma("unroll") for (int r = 0; r < 16; ++r) negm[r] = -mhat; asm volatile("" : "+v"(negm)); } } \
    _Pragma("unroll") for (int r = 0; r < 16; ++r) P0[r] = __builtin_amdgcn_exp2f(P0[r]); } while (0)
#define RESC() do { if constexpr (!FAST) { if (resc) { asm volatile("s_waitcnt lgkmcnt(0)" ::: "memory"); \
      _Pragma("unroll") for (int d_ = 0; d_ < 2; ++d_) _Pragma("unroll") for (int r = 0; r < 16; ++r) o[d_][r] *= wsf[crow(r, hi)]; } } } while (0)
    f32x16 pA0, pA1, pB0, pB1;
    int sl_prev = 0, sl_cur = 0, sl_next = SLOTB;
#define ROT() do { sl_prev = sl_cur; sl_cur = sl_next; sl_next = (sl_next == (NSLOT - 1) * SLOTB) ? 0 : sl_next + SLOTB; } while (0)
    DMA_K(2, 2 * SLOTB);
    WAIT_BAR(3);
    qkt(pA0, pA1, Kbase, qr, NEGM, r32, hi); asm volatile("s_nop 15\n\ts_nop 7" : "+v"(pA0), "+v"(pA1));
    START(pA0, pA1);
    _Pragma("unroll") for (int r = 0; r < 16; ++r) pA1[r] = __builtin_amdgcn_exp2f(pA1[r]);
    WAIT_BAR(0);
    DMA_K(3, 0); DMA_V(1, SLOTB);
    ROT();
    kload8(kf, kp0 + sl_cur);
    WAIT_BAR(2);
    s16x4 vlo[8], vhi[8]; u32x4 pw0, pw1, pw2, pw3;
#define PKW(P, B) pk2h(P[B], P[B + 1])
#define PAF(k) __builtin_bit_cast(f16x8, pw##k)
#define VFR(i) mk8(vlo[i], vhi[i])
#define PIN(x) asm volatile("" : "+v"(x))
#define MX3(a, b, c) __builtin_fmaxf(__builtin_fmaxf((a), (b)), (c))
#define GAPA(MF, A0, A1, A2, A3, W0, W1, PW) do { MF; sacc += A0; sacc += A1; sacc += A2; sacc += A3; PIN(sacc); W0; W1; PIN(PW); SBAR(); } while (0)
#define EX(v) __builtin_amdgcn_exp2f(v)
#define GAPB(MF, X, B) do { MF; X[B] = EX(X[B]); X[B + 1] = EX(X[B + 1]); X[B + 2] = EX(X[B + 2]); X[B + 3] = EX(X[B + 3]); PIN(X); SBAR(); } while (0)
#define VRD(i) do { vlo[i] = vtr(vp_ + (((i) >> 2) * 4096 + ((i) & 3) * 1024)); vhi[i] = vtr(vp_ + (((i) >> 2) * 4096 + ((i) & 3) * 1024 + 512)); } while (0)
#define KRD(G, j) do { if (G) { kload2(kf, kp0 + sl_next, j); SBAR(); } } while (0)
#define STEP(C0, C1, P0, P1, t, GK, GV, GL) do { SBAR(); \
    const lds_cptr vp_ = vp0 + sl_prev; \
    if constexpr (FAST) { if (GK) { DMA_K((t) + 3, sl_cur); } } \
    VRD(0); SBAR(); float sacc = (P0[0] + P0[1]); \
    GAPA(C0 = MFMA32(kf[0], qr[0], NEGM), P0[2], P0[3], P0[4], P0[5],     pw0[0] = PKW(P0, 0), pw0[1] = PKW(P0, 2), pw0); \
    if constexpr (FAST) { if (GV) { DMA_V((t) + 1, sl_next); } } \
    VRD(4); SBAR(); GAPA(C1 = MFMA32(kf[1], qr[0], NEGM), P0[6], P0[7], P0[8], P0[9],     pw0[2] = PKW(P0, 4), pw0[3] = PKW(P0, 6), pw0); \
    VRD(1); SBAR(); GAPA(C0 = MFMA32(kf[2], qr[1], C0),   P0[10], P0[11], P0[12], P0[13], pw1[0] = PKW(P0, 8), pw1[1] = PKW(P0, 10), pw1); \
    VRD(5); SBAR(); GAPA(C1 = MFMA32(kf[3], qr[1], C1),   P0[14], P0[15], P1[0], P1[1],   pw1[2] = PKW(P0, 12), pw1[3] = PKW(P0, 14), pw1); \
    VRD(2); SBAR(); GAPA(C0 = MFMA32(kf[4], qr[2], C0),   P1[2], P1[3], P1[4], P1[5],     pw2[0] = PKW(P1, 0), pw2[1] = PKW(P1, 2), pw2); \
    VRD(6); SBAR(); GAPA(C1 = MFMA32(kf[5], qr[2], C1),   P1[6], P1[7], P1[8], P1[9],     pw2[2] = PKW(P1, 4), pw2[3] = PKW(P1, 6), pw2); \
    VRD(3); SBAR(); GAPA(C0 = MFMA32(kf[6], qr[3], C0),   P1[10], P1[11], P1[12], P1[13], pw3[0] = PKW(P1, 8), pw3[1] = PKW(P1, 10), pw3); \
    VRD(7); SBAR(); GAPA(C1 = MFMA32(kf[7], qr[3], C1),   P1[14], P1[15], 0.f, 0.f,       pw3[2] = PKW(P1, 12), pw3[3] = PKW(P1, 14), pw3); \
    l_reg += sacc; \
    if constexpr (!FAST) { \
    if (GK) { DMA_K((t) + 3, sl_cur); } if (GV) { DMA_V((t) + 1, sl_next); } \
    { float a = MX3(C0[0], C0[1], C1[0]), b = MX3(C0[2], C0[3], C1[1]); a = MX3(a, C1[2], C1[3]); \
      _Pragma("unroll") for (int r = 4; r < 16; r += 4) { a = MX3(a, C0[r], C0[r + 1]); b = MX3(b, C0[r + 2], C0[r + 3]); a = MX3(a, C1[r], C1[r + 1]); b = MX3(b, C1[r + 2], C1[r + 3]); } \
      float rm = __builtin_fmaxf(a, b); { auto rr = __builtin_amdgcn_permlane32_swap(__float_as_uint(rm), __float_as_uint(rm), false, false); rm = __builtin_fmaxf(__uint_as_float(rr[0]), __uint_as_float(rr[1])); } \
      resc = false; \
      if (__builtin_expect(__any(rm > (float)THRL), 0)) { const float dl = __builtin_fmaxf(rm, 0.f); mhat += dl; \
        _Pragma("unroll") for (int r = 0; r < 16; ++r) { C0[r] -= dl; C1[r] -= dl; } \
        _Pragma("unroll") for (int r = 0; r < 16; ++r) negm[r] = -mhat; asm volatile("" : "+v"(negm)); \
        const float f = __builtin_amdgcn_exp2f(-dl); l_reg *= f; if (hi == 0) wsf[r32] = f; resc = true; } } } \
    SBAR(); \
    GAPB(o[0] = MFMA32(PAF(0), VFR(0), o[0]), C0, 0); \
    GAPB(o[1] = MFMA32(PAF(0), VFR(4), o[1]), C0, 4); \
    KRD(GL, 0); GAPB(o[0] = MFMA32(PAF(1), VFR(1), o[0]), C0, 8); \
    KRD(GL, 1); GAPB(o[1] = MFMA32(PAF(1), VFR(5), o[1]), C0, 12); \
    KRD(GL, 2); GAPB(o[0] = MFMA32(PAF(2), VFR(2), o[0]), C1, 0); \
    KRD(GL, 3); GAPB(o[1] = MFMA32(PAF(2), VFR(6), o[1]), C1, 4); \
    GAPB(o[0] = MFMA32(PAF(3), VFR(3), o[0]), C1, 8); \
    GAPB(o[1] = MFMA32(PAF(3), VFR(7), o[1]), C1, 12); \
    } while (0)
    int t = 1;
    for (; t + 5 < NT; t += 2) {
        STEP(pB0, pB1, pA0, pA1, t, true, true, true);     WAIT_BAR(2); RESC(); ROT();
        STEP(pA0, pA1, pB0, pB1, t + 1, true, true, true); WAIT_BAR(2); RESC(); ROT();
    }
#define ENDW(tt) do { if ((tt) + 3 < NT) { WAIT_BAR(2); } else if ((tt) + 2 < NT) { WAIT_BAR(1); } else { WAIT_BAR(0); } } while (0)
    for (; t + 1 < NT; t += 2) {
        STEP(pB0, pB1, pA0, pA1, t, (t + 3 < NT), (t + 1 < NT), (t + 1 < NT));         ENDW(t);     RESC(); ROT();
        STEP(pA0, pA1, pB0, pB1, t + 1, (t + 4 < NT), (t + 2 < NT), (t + 2 < NT));     ENDW(t + 1); RESC(); ROT();
    }
    STEP(pB0, pB1, pA0, pA1, NT - 1, false, false, false); RESC();
    { float sacc = pB0[0] + pB0[1]; _Pragma("unroll") for (int r = 2; r < 16; ++r) sacc += pB0[r]; _Pragma("unroll") for (int r = 0; r < 16; ++r) sacc += pB1[r]; l_reg += sacc;
      pw0 = (u32x4){PKW(pB0, 0), PKW(pB0, 2), PKW(pB0, 4), PKW(pB0, 6)}; pw1 = (u32x4){PKW(pB0, 8), PKW(pB0, 10), PKW(pB0, 12), PKW(pB0, 14)}; pw2 = (u32x4){PKW(pB1, 0), PKW(pB1, 2), PKW(pB1, 4), PKW(pB1, 6)}; pw3 = (u32x4){PKW(pB1, 8), PKW(pB1, 10), PKW(pB1, 12), PKW(pB1, 14)};
      SBAR(); pv(o, vb0 + sl_cur, PAF(0), PAF(1), PAF(2), PAF(3)); }
#undef PKW
#undef PAF
#undef VFR
#undef PIN
#undef MX3
#undef GAPA
#undef GAPB
#undef EX
#undef VRD
#undef KRD
#undef STEP
#undef ENDW
    { auto rr = __builtin_amdgcn_permlane32_swap(__float_as_uint(l_reg), __float_as_uint(l_reg), false, false); l_reg = __uint_as_float(rr[0]) + __uint_as_float(rr[1]); }
    l_out = l_reg;
    asm volatile("s_waitcnt lgkmcnt(0)\n\ts_barrier" ::: "memory");
#undef DMA_K
#undef DMA_V
#undef START
#undef NEGM
#undef RESC
#undef ROT
}

__device__ __forceinline__ void pv128(f32x16* o, int vb, f16x8 pa0, f16x8 pa1, f16x8 pa2, f16x8 pa3) {
#pragma unroll
    for (int d0 = 0; d0 < 4; ++d0) { s16x4 lo[4], hi[4];
#pragma unroll
        for (int ks = 0; ks < 4; ++ks) {
            asm volatile("ds_read_b64_tr_b16 %0,%1 offset:%c2" : "=&v"(lo[ks]) : "v"(vb), "i"(d0 * 4096 + ks * 1024) : "memory");
            asm volatile("ds_read_b64_tr_b16 %0,%1 offset:%c2" : "=&v"(hi[ks]) : "v"(vb), "i"(d0 * 4096 + ks * 1024 + 512) : "memory"); }
        asm volatile("s_waitcnt lgkmcnt(0)" ::: "memory"); SBAR();
        o[d0] = MFMA32(pa0, mk8(lo[0], hi[0]), o[d0]);
        o[d0] = MFMA32(pa1, mk8(lo[1], hi[1]), o[d0]);
        o[d0] = MFMA32(pa2, mk8(lo[2], hi[2]), o[d0]);
        o[d0] = MFMA32(pa3, mk8(lo[3], hi[3]), o[d0]);
    }
}
template <int THRL, bool FAST> __device__ __forceinline__ void attn_pass128(const h16_t* Qw, int QP, const h16_t* Kh, int KP, const h16_t* Vh, int VP, char* shm, f32x16 (&o)[4], float& l_out, int wave_in) {
    int tid = wave_in * 64 + lane_id(); asm volatile("" : "+v"(tid));
    const int lane = tid & 63, r32 = lane & 31, hi = lane >> 5; const int wid = wave_in;
    const unsigned lds0 = (unsigned)(uintptr_t)shm;
    float* wsf = (float*)(shm + LDS_WS) + wid * 64;
    const h16_t* ksrc = Kh + (long)lane * KP + wid * 8;
    const h16_t* vsrc = Vh + (long)(16 * (wid & 3) + (lane >> 2)) * VP + (wid >> 2) * 32 + (lane & 3) * 8;
    const unsigned kdst = lds0 + LDS_K + wid * 1024, vdst = lds0 + LDS_V + wid * 1024;
#define DMA_K(t, slot) glds16(ksrc + (long)(t) * KVBLK * KP, (unsigned)__builtin_amdgcn_readfirstlane(kdst + (slot)))
#define DMA_V(t, slot) do { glds16(vsrc + (long)(t) * KVBLK * VP, (unsigned)__builtin_amdgcn_readfirstlane(vdst + (slot))); glds16(vsrc + (long)(t) * KVBLK * VP + 64, (unsigned)__builtin_amdgcn_readfirstlane(vdst + (slot) + 8192)); } while (0)
    const int vb0 = (int)(lds0 + LDS_V) + ((lane >> 4) & 1) * 32 + (lane & 3) * 8 + (4 * hi + ((lane & 15) >> 2)) * 64;
    const char* Kbase = shm + LDS_K; f16x8 kf[8];
    const lds_cptr shm3 = (lds_cptr)shm; const lds_cptr kp0 = shm3 + LDS_K + hi * 1024 + r32 * 16; const lds_cptr vp0 = shm3 + LDS_V + ((lane >> 4) & 1) * 32 + (lane & 3) * 8 + (4 * hi + ((lane & 15) >> 2)) * 64;
    DMA_K(0, 0); DMA_V(0, 0); DMA_K(1, SLOTB);
    f16x8 qr[4];
#pragma unroll
    for (int d0 = 0; d0 < 4; ++d0) qr[d0] = *reinterpret_cast<const f16x8*>(&Qw[(long)r32 * QP + d0 * 16 + hi * 8]);
    float mhat = 0.f, l_reg = 0.f; o[0] = f32x16{}; o[1] = f32x16{}; o[2] = f32x16{}; o[3] = f32x16{}; f32x16 negm = f32x16{}; if constexpr (!FAST) asm volatile("" : "+v"(negm));
    bool resc = false;
#define NEGM (FAST ? f32x16{} : negm)
#define RESC() do { if constexpr (!FAST) if (resc) { asm volatile("s_waitcnt lgkmcnt(0)" ::: "memory"); \
      _Pragma("unroll") for (int d_ = 0; d_ < 4; ++d_) _Pragma("unroll") for (int r = 0; r < 16; ++r) o[d_][r] *= wsf[crow(r, hi)]; } } while (0)
    f32x16 C0, C1; u32x4 pA0, pA1, pA2, pA3, pB0, pB1, pB2, pB3;
    int sl_prev = 0, sl_cur = 0, sl_next = SLOTB;
#define ROT() do { sl_prev = sl_cur; sl_cur = sl_next; sl_next = (sl_next == (NSLOT - 1) * SLOTB) ? 0 : sl_next + SLOTB; } while (0)
    DMA_K(2, 2 * SLOTB);
    WAIT_BAR(3);
    qkt(C0, C1, Kbase, qr, NEGM, r32, hi); asm volatile("s_nop 15\n\ts_nop 7" : "+v"(C0), "+v"(C1));
    { float rm = 0.f; if constexpr (!FAST) { rm = rowmax(C0, C1); mhat = rm; }
      _Pragma("unroll") for (int r = 0; r < 16; ++r) { C0[r] = __builtin_amdgcn_exp2f(C0[r] - rm); C1[r] = __builtin_amdgcn_exp2f(C1[r] - rm); }
      if constexpr (!FAST) { _Pragma("unroll") for (int r = 0; r < 16; ++r) negm[r] = -mhat; asm volatile("" : "+v"(negm)); }
      float sacc = 0.f; _Pragma("unroll") for (int r = 0; r < 16; ++r) sacc += C0[r] + C1[r]; l_reg = sacc;
      pA0 = (u32x4){pk2h(C0[0], C0[1]), pk2h(C0[2], C0[3]), pk2h(C0[4], C0[5]), pk2h(C0[6], C0[7])}; pA1 = (u32x4){pk2h(C0[8], C0[9]), pk2h(C0[10], C0[11]), pk2h(C0[12], C0[13]), pk2h(C0[14], C0[15])};
      pA2 = (u32x4){pk2h(C1[0], C1[1]), pk2h(C1[2], C1[3]), pk2h(C1[4], C1[5]), pk2h(C1[6], C1[7])}; pA3 = (u32x4){pk2h(C1[8], C1[9]), pk2h(C1[10], C1[11]), pk2h(C1[12], C1[13]), pk2h(C1[14], C1[15])}; }
    WAIT_BAR(0);
    DMA_K(3, 0); DMA_V(1, 2 * SLOTB);
    ROT();
    kload8(kf, kp0 + sl_cur);
    WAIT_BAR(3);
    s16x4 vlo[16], vhi[16];
#define PAFW(w) __builtin_bit_cast(f16x8, w)
#define VFR(i) mk8(vlo[i], vhi[i])
#define PIN(x) asm volatile("" : "+v"(x))
#define MX3(a, b, c) __builtin_fmaxf(__builtin_fmaxf((a), (b)), (c))
#define EX(v) __builtin_amdgcn_exp2f(v)
#define VRD(i) do { vlo[i] = vtr(vp_ + (((i) >> 2) * 4096 + ((i) & 3) * 1024)); vhi[i] = vtr(vp_ + (((i) >> 2) * 4096 + ((i) & 3) * 1024 + 512)); } while (0)
#define KRD(G, j) do { if (G) { kload2(kf, kp0 + sl_next, j); } } while (0)
#define QK1(PRE, CC, KF, QR, CI) do { PRE; SBAR(); CC = MFMA32(KF, QR, CI); SBAR(); } while (0)
#define NOP_ do { } while (0)
#define GB0(PRE, OA, PW, FI, X, B) do { PRE; SBAR(); OA = MFMA32(PAFW(PW), VFR(FI), OA); X[B] = EX(X[B]); X[B + 1] = EX(X[B + 1]); PIN(X); SBAR(); } while (0)
#define GB(PRE, OA, PW, FI, X, B, Y, YB, PN, W) do { PRE; SBAR(); OA = MFMA32(PAFW(PW), VFR(FI), OA); X[B] = EX(X[B]); X[B + 1] = EX(X[B + 1]); PIN(X); \
    sacc += Y[YB]; sacc += Y[YB + 1]; PN[W] = pk2h(Y[YB], Y[YB + 1]); PIN(sacc); PIN(PN); SBAR(); } while (0)
#define STEP128(PC0, PC1, PC2, PC3, PN0, PN1, PN2, PN3, t, GK, GV, GL) do { SBAR(); \
    const lds_cptr vp_ = vp0 + 2 * sl_prev; \
    QK1(if constexpr (FAST) { if (GK) { DMA_K((t) + 3, sl_cur); } }, C0, kf[0], qr[0], NEGM); \
    QK1(if constexpr (FAST) { if (GV) { DMA_V((t) + 1, 2 * sl_next); } }, C1, kf[1], qr[0], NEGM); \
    QK1(NOP_,    C0, kf[2], qr[1], C0); \
    QK1(NOP_,    C1, kf[3], qr[1], C1); \
    QK1(VRD(0),  C0, kf[4], qr[2], C0); \
    QK1(VRD(4),  C1, kf[5], qr[2], C1); \
    QK1(VRD(8),  C0, kf[6], qr[3], C0); \
    QK1(VRD(12), C1, kf[7], qr[3], C1); \
    if constexpr (!FAST) { \
    if (GK) { DMA_K((t) + 3, sl_cur); } if (GV) { DMA_V((t) + 1, 2 * sl_next); } \
    { float a = MX3(C0[0], C0[1], C1[0]), b = MX3(C0[2], C0[3], C1[1]); a = MX3(a, C1[2], C1[3]); \
      _Pragma("unroll") for (int r = 4; r < 16; r += 4) { a = MX3(a, C0[r], C0[r + 1]); b = MX3(b, C0[r + 2], C0[r + 3]); a = MX3(a, C1[r], C1[r + 1]); b = MX3(b, C1[r + 2], C1[r + 3]); } \
      float rm = __builtin_fmaxf(a, b); { auto rr = __builtin_amdgcn_permlane32_swap(__float_as_uint(rm), __float_as_uint(rm), false, false); rm = __builtin_fmaxf(__uint_as_float(rr[0]), __uint_as_float(rr[1])); } \
      resc = false; \
      if (__builtin_expect(__any(rm > (float)THRL), 0)) { const float dl = __builtin_fmaxf(rm, 0.f); mhat += dl; \
        _Pragma("unroll") for (int r = 0; r < 16; ++r) { C0[r] -= dl; C1[r] -= dl; } \
        _Pragma("unroll") for (int r = 0; r < 16; ++r) negm[r] = -mhat; asm volatile("" : "+v"(negm)); \
        const float f = __builtin_amdgcn_exp2f(-dl); l_reg *= f; if (hi == 0) wsf[r32] = f; resc = true; } } } \
    SBAR(); float sacc = 0.f; \
    GB0(VRD(1),  o[0], PC0, 0,  C0, 0); \
    GB(VRD(5),   o[1], PC0, 4,  C0, 2,  C0, 0,  PN0, 0); \
    GB(VRD(9),   o[2], PC0, 8,  C0, 4,  C0, 2,  PN0, 1); \
    GB(VRD(13),  o[3], PC0, 12, C0, 6,  C0, 4,  PN0, 2); \
    GB(VRD(2),   o[0], PC1, 1,  C0, 8,  C0, 6,  PN0, 3); \
    GB(VRD(6),   o[1], PC1, 5,  C0, 10, C0, 8,  PN1, 0); \
    GB(VRD(10),  o[2], PC1, 9,  C0, 12, C0, 10, PN1, 1); \
    GB(VRD(14),  o[3], PC1, 13, C0, 14, C0, 12, PN1, 2); \
    GB(VRD(3),   o[0], PC2, 2,  C1, 0,  C0, 14, PN1, 3); \
    GB(VRD(7),   o[1], PC2, 6,  C1, 2,  C1, 0,  PN2, 0); \
    GB(VRD(11),  o[2], PC2, 10, C1, 4,  C1, 2,  PN2, 1); \
    GB(VRD(15),  o[3], PC2, 14, C1, 6,  C1, 4,  PN2, 2); \
    GB(KRD(GL, 0), o[0], PC3, 3,  C1, 8,  C1, 6,  PN2, 3); \
    GB(KRD(GL, 1), o[1], PC3, 7,  C1, 10, C1, 8,  PN3, 0); \
    GB(KRD(GL, 2), o[2], PC3, 11, C1, 12, C1, 10, PN3, 1); \
    GB(KRD(GL, 3), o[3], PC3, 15, C1, 14, C1, 12, PN3, 2); \
    sacc += C1[14]; sacc += C1[15]; PN3[3] = pk2h(C1[14], C1[15]); l_reg += sacc; \
    } while (0)
    int t = 1;
    for (; t + 5 < NT; t += 2) {
        STEP128(pA0, pA1, pA2, pA3, pB0, pB1, pB2, pB3, t, true, true, true);     WAIT_BAR(3); RESC(); ROT();
        STEP128(pB0, pB1, pB2, pB3, pA0, pA1, pA2, pA3, t + 1, true, true, true); WAIT_BAR(3); RESC(); ROT();
    }
#define ENDW(tt) do { if ((tt) + 3 < NT) { WAIT_BAR(3); } else if ((tt) + 2 < NT) { WAIT_BAR(2); } else { WAIT_BAR(0); } } while (0)
    for (; t + 1 < NT; t += 2) {
        STEP128(pA0, pA1, pA2, pA3, pB0, pB1, pB2, pB3, t, (t + 3 < NT), (t + 1 < NT), (t + 1 < NT));         ENDW(t);     RESC(); ROT();
        STEP128(pB0, pB1, pB2, pB3, pA0, pA1, pA2, pA3, t + 1, (t + 4 < NT), (t + 2 < NT), (t + 2 < NT));     ENDW(t + 1); RESC(); ROT();
    }
    STEP128(pA0, pA1, pA2, pA3, pB0, pB1, pB2, pB3, NT - 1, false, false, false); RESC();
    SBAR(); pv128(o, vb0 + 2 * sl_cur, PAFW(pB0), PAFW(pB1), PAFW(pB2), PAFW(pB3));
#undef PAFW
#undef VFR
#undef PIN
#undef MX3
#undef EX
#undef VRD
#undef KRD
#undef QK1
#undef NOP_
#undef GB0
#undef GB
#undef STEP128
#undef ENDW
    { auto rr = __builtin_amdgcn_permlane32_swap(__float_as_uint(l_reg), __float_as_uint(l_reg), false, false); l_reg = __uint_as_float(rr[0]) + __uint_as_float(rr[1]); }
    l_out = l_reg;
    asm volatile("s_waitcnt lgkmcnt(0)\n\ts_barrier" ::: "memory");
#undef DMA_K
#undef DMA_V
#undef NEGM
#undef RESC
#undef ROT
}

typedef int v8i __attribute__((ext_vector_type(8)));
#define MFMA8(a, b, c) __builtin_amdgcn_mfma_scale_f32_32x32x64_f8f6f4(a, b, c, 0, 0, 0, 0, 0, 0)
#define MFMA8S(a, b, c) __builtin_amdgcn_mfma_scale_f32_16x16x128_f8f6f4(a, b, c, 0, 0, 0, 0, 0, 0)
#define MFMA6(a, b, c) __builtin_amdgcn_mfma_scale_f32_32x32x64_f8f6f4(a, b, c, 2, 2, 0, sc6, 0, sc6)
__device__ __forceinline__ v8i ld24(lds_cptr p16, lds_cptr p8) { const u32x4 a = *(const LAS u32x4*)p16; const u32x2 b = *(const LAS u32x2*)p8; return (v8i){(int)a.x, (int)a.y, (int)a.z, (int)a.w, (int)b.x, (int)b.y, 0, 0}; }
__device__ __forceinline__ v8i ld32(lds_cptr p0, lds_cptr p1) { const u32x4 a = *(const LAS u32x4*)p0, b = *(const LAS u32x4*)p1; return (v8i){(int)a.x, (int)a.y, (int)a.z, (int)a.w, (int)b.x, (int)b.y, (int)b.z, (int)b.w}; }
template <int NV> __device__ __forceinline__ void attn_first_dma(const unsigned char* Kh8, int KP, const unsigned char* VT, char* shm, int wave_in) {
    int tid = wave_in * 64 + lane_id(); asm volatile("" : "+v"(tid));
    const int lane = tid & 63, wid = wave_in; const bool kw = wid < 4, kwk = wid < 3;
    const unsigned lds0 = (unsigned)(uintptr_t)shm; constexpr int VCH = NV * 512;
    const unsigned char* ksrc = Kh8 + (long)lane * KP + (wid & 3) * 16;
    const unsigned char* vsrc = VT + (long)(lane + ((kw && NV == 4) ? 64 : 0)) * SEQ + (wid & 3) * 16;
    const unsigned kdst = lds0 + LDS_K + (wid & 3) * 1024, vdst = lds0 + LDS_V + (wid & 3) * VCH + ((kw && NV == 4) ? 1024 : 0);
    const bool vw = !kw || NV == 4;
#define FD_K(t) do { if (kwk) glds16(ksrc + (long)(t) * KVBLK * KP, (unsigned)__builtin_amdgcn_readfirstlane(kdst + (t) * SB8)); } while (0)
#define FD_V(t) do { if (vw) glds16(vsrc + (t) * KVBLK, (unsigned)__builtin_amdgcn_readfirstlane(vdst + (t) * 2 * SB8)); } while (0)
    FD_K(0); FD_K(1); FD_V(0); FD_K(2); FD_K(3); FD_V(1); FD_K(4); FD_K(5); FD_V(2); FD_V(3);
#undef FD_K
#undef FD_V
}
template <int NV> __device__ __forceinline__ void attn_pass8(const unsigned char* Qw8, int QP, const unsigned char* Kh8, int KP, const unsigned char* VT, int mI, char* shm, f32x16 (&o)[NV], float& l_out, int wave_in, bool pre = false) {
    int tid = wave_in * 64 + lane_id(); asm volatile("" : "+v"(tid));
    const int lane = tid & 63, r32 = lane & 31, hi = lane >> 5; const int wid = wave_in;
    const unsigned lds0 = (unsigned)(uintptr_t)shm;
    constexpr int VCH = NV * 512;
    const bool kw = wid < 4, kwk = wid < 3;
    const unsigned char* ksrc = Kh8 + (long)lane * KP + (wid & 3) * 16;
    const unsigned char* vsrc = VT + (long)(lane + ((kw && NV == 4) ? 64 : 0)) * SEQ + (wid & 3) * 16;
    const unsigned kdst = lds0 + LDS_K + (wid & 3) * 1024, vdst = lds0 + LDS_V + (wid & 3) * VCH + ((kw && NV == 4) ? 1024 : 0);
#define DMA_K8(t, slot) do { if (kwk) glds16(ksrc + (long)(t) * KVBLK * KP, (unsigned)__builtin_amdgcn_readfirstlane(kdst + (slot))); } while (0)
#define DMA_V8(t, slot) do { if (!kw || NV == 4) glds16(vsrc + (t) * KVBLK, (unsigned)__builtin_amdgcn_readfirstlane(vdst + (slot))); } while (0)
#define OWN_BAR() do { if (kwk && NV == 4) { WAIT_BAR(4); } else { WAIT_BAR(2); } } while (0)
    const lds_cptr shm3 = (lds_cptr)shm;
    const lds_cptr kp0 = shm3 + LDS_K + hi * 1024 + r32 * 16, kq0 = shm3 + LDS_K + 2048 + r32 * 16 + 8 * hi;
    const lds_cptr vp0 = shm3 + LDS_V + (2 * hi) * VCH + r32 * 16;
    if (!pre) attn_first_dma<NV>(Kh8, KP, VT, shm, wave_in);
    v8i q8; { const u32x4 a = *(const u32x4*)(Qw8 + (long)r32 * QP + 16 * hi); const u32x2 b = *(const u32x2*)(Qw8 + (long)r32 * QP + 32 + 8 * hi); q8 = (v8i){(int)a.x, (int)a.y, (int)a.z, (int)a.w, (int)b.x, (int)b.y, 0, 0}; }
    float l_reg = 0.f;
#pragma unroll
    for (int d = 0; d < NV; ++d) o[d] = f32x16{};
    f32x16 cinit; { int mI_ = mI; asm volatile("" : "+s"(mI_)); float cv = 8.0f * (float)(7 - mI_) * (1.0f / 65536.0f); asm volatile("" : "+v"(cv));
#pragma unroll
        for (int r = 0; r < 16; ++r) cinit[r] = cv; }
    asm volatile("" : "+v"(cinit));
    int sc6 = 0x77; asm volatile("" : "+v"(sc6));
    f32x16 C0, C1; v8i pA, pB, kf0, kf1;
    v8i ones8; { int one4 = ((lane & 15) == ((lane >> 4) & 1)) ? 0x38383838 : 0; asm volatile("" : "+v"(one4));
#pragma unroll
        for (int w = 0; w < 8; ++w) ones8[w] = one4; }
    f32x4 lsum = f32x4{};
    int sl_prev = 0, sl_cur = 0, sl_next = SB8;
#define ROT() do { sl_prev = sl_cur; sl_cur = sl_next; sl_next = (sl_next == (NS8 - 1) * SB8) ? 0 : sl_next + SB8; } while (0)
#define SL3() (sl_cur >= 3 * SB8 ? sl_cur - 3 * SB8 : sl_cur + 3 * SB8)
#define KLD(sl) do { kf0 = ld24(kp0 + (sl), kq0 + (sl)); kf1 = ld24(kp0 + (sl) + 512, kq0 + (sl) + 512); } while (0)
#define CODES(PW, w0, w1) do { _Pragma("unroll") for (int w_ = (w0); w_ < (w1); ++w_) { \
      const float c0_ = w_ < 4 ? C0[4 * w_] : C1[4 * (w_ - 4)], c1_ = w_ < 4 ? C0[4 * w_ + 1] : C1[4 * (w_ - 4) + 1], c2_ = w_ < 4 ? C0[4 * w_ + 2] : C1[4 * (w_ - 4) + 2], c3_ = w_ < 4 ? C0[4 * w_ + 3] : C1[4 * (w_ - 4) + 3]; \
      const unsigned x_ = __builtin_bit_cast(unsigned, __builtin_amdgcn_cvt_pknorm_u16(c0_, c1_)), y_ = __builtin_bit_cast(unsigned, __builtin_amdgcn_cvt_pknorm_u16(c2_, c3_));     \
      PW[w_] = (int)__builtin_amdgcn_perm(y_, x_, 0x06040200u); } } while (0)
    asm volatile("s_waitcnt vmcnt(0) lgkmcnt(0)\n\ts_barrier" ::: "memory");
    KLD(0);
    C0 = MFMA6(kf0, q8, cinit); C1 = MFMA6(kf1, q8, cinit);
    CODES(pA, 0, 8);
    ROT();
    KLD(sl_cur);
    WAIT_BAR(0);
#define VLD(db) ld32(vp_ + (db) * 512, vp_ + (db) * 512 + VCH)
#define PINV(x) asm volatile("" : "+v"(x))
#define STEP8(PC, PN, t, GK, GV, GL) do { SBAR(); \
    const lds_cptr vp_ = vp0 + 2 * sl_prev; \
    v8i vfa = VLD(0), vfb = VLD(1); SBAR(); \
    C0 = MFMA6(kf0, q8, cinit); C1 = MFMA6(kf1, q8, cinit); PINV(C0); PINV(C1); SBAR(); \
    if (GK) { DMA_K8((t) + 5, sl_prev); } if (GV) { DMA_V8((t) + 3, 2 * SL3()); } \
    if (GL) { KLD(sl_next); } SBAR(); \
    o[0] = MFMA8(PC, vfa, o[0]); PINV(o[0]); if constexpr (NV == 4) { vfa = VLD(2); } CODES(PN, 0, 8 / NV); PINV(PN); SBAR(); \
    o[1] = MFMA8(PC, vfb, o[1]); PINV(o[1]); if constexpr (NV == 4) { vfb = VLD(3); } CODES(PN, 8 / NV, 16 / NV); PINV(PN); SBAR(); \
    if constexpr (NV == 4) { \
    o[2] = MFMA8(PC, vfa, o[2]); PINV(o[2]); CODES(PN, 4, 6); PINV(PN); SBAR(); \
    o[3] = MFMA8(PC, vfb, o[3]); PINV(o[3]); CODES(PN, 6, 8); PINV(PN); SBAR(); } \
    lsum = MFMA8S(PC, ones8, lsum); PINV(lsum); SBAR(); \
    } while (0)
#define ENDW8(tt) do { if ((tt) + 6 < NT) { OWN_BAR(); } else { WAIT_BAR(0); } } while (0)
    int t = 1;
    if (wid >= 4) __builtin_amdgcn_s_setprio(1);
#pragma unroll 1
    for (; t + 1 < NT; t += 2) {
        STEP8(pA, pB, t, (t + 5 < NT), (t + 3 < NT), (t + 1 < NT));         ROT();
        STEP8(pB, pA, t + 1, (t + 6 < NT), (t + 4 < NT), (t + 2 < NT));     ENDW8(t); ROT();
    }
    STEP8(pA, pB, NT - 1, false, false, false);
    { const lds_cptr vp_ = vp0 + 2 * sl_cur;
#pragma unroll
      for (int db = 0; db < NV; ++db) { const v8i vf = ld32(vp_ + db * 512, vp_ + db * 512 + VCH); o[db] = MFMA8(pB, vf, o[db]); } }
    lsum = MFMA8S(pB, ones8, lsum);
    __builtin_amdgcn_s_setprio(0);
    { float* wsf = (float*)(shm + LDS_WS) + wid * 64;
#pragma unroll
      for (int r = 0; r < 4; ++r) if ((lane & 15) < 2) wsf[16 * (lane & 15) + 4 * (lane >> 4) + r] = lsum[r];
      asm volatile("s_waitcnt lgkmcnt(0)" ::: "memory");
      l_reg = wsf[r32]; asm volatile("s_waitcnt lgkmcnt(0)" ::: "memory"); }
    l_out = l_reg;
    asm volatile("s_waitcnt lgkmcnt(0)\n\ts_barrier" ::: "memory");
#undef DMA_K8
#undef DMA_V8
#undef OWN_BAR
#undef ROT
#undef SL3
#undef KLD
#undef CODES
#undef STEP8
#undef PINV
#undef VLD
#undef ENDW8
}
__device__ __forceinline__ void attn_pass8_2x(const unsigned char* Qw8, int QP, const unsigned char* Kh8, int KP, const unsigned char* VT, int mI, char* shm, f32x16 (&oa)[2], f32x16 (&ob)[2], float& la_out, float& lb_out, int wave_in, bool pre = false) {
    constexpr int NV = 2;
    int tid = wave_in * 64 + lane_id(); asm volatile("" : "+v"(tid));
    const int lane = tid & 63, r32 = lane & 31, hi = lane >> 5; const int wid = wave_in;
    const unsigned lds0 = (unsigned)(uintptr_t)shm;
    constexpr int VCH = NV * 512;
    const bool kw = wid < 4, kwk = wid < 3;
    const unsigned char* ksrc = Kh8 + (long)lane * KP + (wid & 3) * 16;
    const unsigned char* vsrc = VT + (long)lane * SEQ + (wid & 3) * 16;
    const unsigned kdst = lds0 + LDS_K + (wid & 3) * 1024, vdst = lds0 + LDS_V + (wid & 3) * VCH;
#define DMA_K8(t, slot) do { if (kwk) glds16(ksrc + (long)(t) * KVBLK * KP, (unsigned)__builtin_amdgcn_readfirstlane(kdst + (slot))); } while (0)
#define DMA_V8(t, slot) do { if (!kw) glds16(vsrc + (t) * KVBLK, (unsigned)__builtin_amdgcn_readfirstlane(vdst + (slot))); } while (0)
#define OWN_BAR() WAIT_BAR(2)
    const lds_cptr shm3 = (lds_cptr)shm;
    const lds_cptr kp0 = shm3 + LDS_K + hi * 1024 + r32 * 16, kq0 = shm3 + LDS_K + 2048 + r32 * 16 + 8 * hi;
    const lds_cptr vp0 = shm3 + LDS_V + (2 * hi) * VCH + r32 * 16;
    if (!pre) attn_first_dma<2>(Kh8, KP, VT, shm, wave_in);
    v8i q8a, q8b;
    { const u32x4 a = *(const u32x4*)(Qw8 + (long)r32 * QP + 16 * hi); const u32x2 b = *(const u32x2*)(Qw8 + (long)r32 * QP + 32 + 8 * hi); q8a = (v8i){(int)a.x, (int)a.y, (int)a.z, (int)a.w, (int)b.x, (int)b.y, 0, 0}; }
    { const u32x4 a = *(const u32x4*)(Qw8 + (long)(32 + r32) * QP + 16 * hi); const u32x2 b = *(const u32x2*)(Qw8 + (long)(32 + r32) * QP + 32 + 8 * hi); q8b = (v8i){(int)a.x, (int)a.y, (int)a.z, (int)a.w, (int)b.x, (int)b.y, 0, 0}; }
#pragma unroll
    for (int d = 0; d < NV; ++d) { oa[d] = f32x16{}; ob[d] = f32x16{}; }
    f32x16 cinit; { int mI_ = mI; asm volatile("" : "+s"(mI_)); float cv = 8.0f * (float)(7 - mI_) * (1.0f / 65536.0f); asm volatile("" : "+v"(cv));
#pragma unroll
        for (int r = 0; r < 16; ++r) cinit[r] = cv; }
    asm volatile("" : "+v"(cinit));
    int sc6 = 0x77; asm volatile("" : "+v"(sc6));
    f32x16 C0, C1; v8i pAa, pBa, pAb, pBb, kf0, kf1;
    v8i ones8; { int one4 = ((lane & 15) == ((lane >> 4) & 1)) ? 0x38383838 : 0; asm volatile("" : "+v"(one4));
#pragma unroll
        for (int w = 0; w < 8; ++w) ones8[w] = one4; }
    f32x4 lsa = f32x4{}, lsb = f32x4{};
    int sl_prev = 0, sl_cur = 0, sl_next = SB8;
#define ROT() do { sl_prev = sl_cur; sl_cur = sl_next; sl_next = (sl_next == (NS8 - 1) * SB8) ? 0 : sl_next + SB8; } while (0)
#define SL3() (sl_cur >= 3 * SB8 ? sl_cur - 3 * SB8 : sl_cur + 3 * SB8)
#define KLD(sl) do { kf0 = ld24(kp0 + (sl), kq0 + (sl)); kf1 = ld24(kp0 + (sl) + 512, kq0 + (sl) + 512); } while (0)
#define CODES(PW, w0, w1) do { _Pragma("unroll") for (int w_ = (w0); w_ < (w1); ++w_) { \
      const float c0_ = w_ < 4 ? C0[4 * w_] : C1[4 * (w_ - 4)], c1_ = w_ < 4 ? C0[4 * w_ + 1] : C1[4 * (w_ - 4) + 1], c2_ = w_ < 4 ? C0[4 * w_ + 2] : C1[4 * (w_ - 4) + 2], c3_ = w_ < 4 ? C0[4 * w_ + 3] : C1[4 * (w_ - 4) + 3]; \
      const unsigned x_ = __builtin_bit_cast(unsigned, __builtin_amdgcn_cvt_pknorm_u16(c0_, c1_)), y_ = __builtin_bit_cast(unsigned, __builtin_amdgcn_cvt_pknorm_u16(c2_, c3_));     \
      PW[w_] = (int)__builtin_amdgcn_perm(y_, x_, 0x06040200u); } } while (0)
    asm volatile("s_waitcnt vmcnt(0) lgkmcnt(0)\n\ts_barrier" ::: "memory");
    KLD(0);
    C0 = MFMA6(kf0, q8a, cinit); C1 = MFMA6(kf1, q8a, cinit);
    CODES(pAa, 0, 8);
    C0 = MFMA6(kf0, q8b, cinit); C1 = MFMA6(kf1, q8b, cinit);
    CODES(pAb, 0, 8);
    ROT();
    KLD(sl_cur);
    WAIT_BAR(0);
#define VLD(db) ld32(vp_ + (db) * 512, vp_ + (db) * 512 + VCH)
#define PINV(x) asm volatile("" : "+v"(x))
#define STEP2(PCa, PNa, PCb, PNb, t, GK, GV, GL) do { SBAR(); \
    const lds_cptr vp_ = vp0 + 2 * sl_prev; \
    v8i vfa = VLD(0), vfb = VLD(1); SBAR(); \
    C0 = MFMA6(kf0, q8a, cinit); C1 = MFMA6(kf1, q8a, cinit); PINV(C0); PINV(C1); SBAR(); \
    if (GK) { DMA_K8((t) + 5, sl_prev); } if (GV) { DMA_V8((t) + 3, 2 * SL3()); } SBAR(); \
    oa[0] = MFMA8(PCa, vfa, oa[0]); PINV(oa[0]); CODES(PNa, 0, 4); PINV(PNa); SBAR(); \
    oa[1] = MFMA8(PCa, vfb, oa[1]); PINV(oa[1]); CODES(PNa, 4, 8); PINV(PNa); SBAR(); \
    C0 = MFMA6(kf0, q8b, cinit); C1 = MFMA6(kf1, q8b, cinit); PINV(C0); PINV(C1); SBAR(); \
    if (GL) { KLD(sl_next); } SBAR(); \
    ob[0] = MFMA8(PCb, vfa, ob[0]); PINV(ob[0]); CODES(PNb, 0, 4); PINV(PNb); SBAR(); \
    ob[1] = MFMA8(PCb, vfb, ob[1]); PINV(ob[1]); CODES(PNb, 4, 8); PINV(PNb); SBAR(); \
    lsa = MFMA8S(PCa, ones8, lsa); PINV(lsa); lsb = MFMA8S(PCb, ones8, lsb); PINV(lsb); SBAR(); \
    } while (0)
#define ENDW8(tt) do { if ((tt) + 6 < NT) { OWN_BAR(); } else { WAIT_BAR(0); } } while (0)
    int t = 1;
    if (wid >= 4) __builtin_amdgcn_s_setprio(1);
#pragma unroll 1
    for (; t + 1 < NT; t += 2) {
        STEP2(pAa, pBa, pAb, pBb, t, (t + 5 < NT), (t + 3 < NT), (t + 1 < NT));         ROT();
        STEP2(pBa, pAa, pBb, pAb, t + 1, (t + 6 < NT), (t + 4 < NT), (t + 2 < NT));     ENDW8(t); ROT();
    }
    STEP2(pAa, pBa, pAb, pBb, NT - 1, false, false, false);
    { const lds_cptr vp_ = vp0 + 2 * sl_cur;
#pragma unroll
      for (int db = 0; db < NV; ++db) { const v8i vf = ld32(vp_ + db * 512, vp_ + db * 512 + VCH); oa[db] = MFMA8(pBa, vf, oa[db]); ob[db] = MFMA8(pBb, vf, ob[db]); } }
    lsa = MFMA8S(pBa, ones8, lsa); lsb = MFMA8S(pBb, ones8, lsb);
    __builtin_amdgcn_s_setprio(0);
    { float* wsf = (float*)(shm + LDS_WS) + wid * 64;
#pragma unroll
      for (int r = 0; r < 4; ++r) if ((lane & 15) < 2) { wsf[16 * (lane & 15) + 4 * (lane >> 4) + r] = lsa[r]; wsf[32 + 16 * (lane & 15) + 4 * (lane >> 4) + r] = lsb[r]; }
      asm volatile("s_waitcnt lgkmcnt(0)" ::: "memory");
      la_out = wsf[r32]; lb_out = wsf[32 + r32]; asm volatile("s_waitcnt lgkmcnt(0)" ::: "memory"); }
    asm volatile("s_waitcnt lgkmcnt(0)\n\ts_barrier" ::: "memory");
#undef DMA_K8
#undef DMA_V8
#undef OWN_BAR
#undef ROT
#undef SL3
#undef KLD
#undef CODES
#undef STEP2
#undef PINV
#undef VLD
#undef ENDW8
}
#undef SBAR
#undef WAIT_BAR
}

constexpr int LDS_BYTES = 156 * 1024;
static_assert(att::LDS_BYTES <= LDS_BYTES && pg8::STAGE_BYTES <= LDS_BYTES, "LDS map");
constexpr int NWAVES = 8;

struct Args {
    const float* x_prompt; const float* x_sample; const float* c_prompt; const float* c_sample;
    const float* w_ada; const float* b_ada; const float* norm_g; const float* w_in;
    const float* qn_a; const float* kn_a; const float* qn_b; const float* kn_b;
    const float* lq1; const float* lk1; const float* lq2; const float* lk2; const float* subln_g;
    const float* w_proj_a; const float* w_proj_b; const float* w_out;
    float* out; unsigned char* ws;
};
__constant__ double INV_A[16] = {1.0, 0.5623413251903491, 0.31622776601683794, 0.1778279410038923, 0.1, 0.05623413251903491, 0.03162277660168379, 0.01778279410038923, 0.01, 0.005623413251903491, 0.0031622776601683794, 0.0017782794100389228, 0.001, 0.0005623413251903491, 0.00031622776601683794, 0.00017782794100389227};
__constant__ double INV_B[8] = {1.0, 0.19392274474868576, 0.03760603093086393, 0.007292664737217109, 0.001414213562373095, 0.0002742481756762073, 5.318295896944988e-05, 1.031338537721246e-05};

__device__ __forceinline__ int win_row(int n) {
    const int T = n >> 8, o = n & 255;
    int base;
    if (T < 2) base = T * 256; else if (T == 2) base = 6 * 256; else if (T < 5) base = (9 + (T - 3)) * 256; else if (T < 9) base = (T - 3) * 256; else if (T < 11) base = (T - 2) * 256; else base = T * 256;
    if (T == 3 || T == 4 || T >= 11) return base + 128 * ((o >> 3) & 1) + 32 * (o >> 6) + 8 * ((o >> 4) & 3) + (o & 7);
    return base + 128 * ((o >> 5) & 1) + 32 * (o >> 6) + (o & 31);
}
__device__ __forceinline__ void transpose_item(const float* W, int N, h16_t* WT, int KD, int kofs, int k0, int n0, int drow0, LAS float* scr, int lane, unsigned char* WT8 = nullptr, int drow8 = 0, float sc8 = 1.0f, float wmul = 1.0f) {
#pragma unroll 8
    for (int i = 0; i < 32; ++i) { const int kk = 2 * i + (lane >> 5); scr[kk * 33 + (lane & 31)] = W[(size_t)(k0 + kk) * N + n0 + (lane & 31)]; }
    asm volatile("s_waitcnt lgkmcnt(0)" ::: "memory");
    const int c = lane & 7;
#pragma unroll
    for (int j = 0; j < 4; ++j) { const int n = (lane >> 3) + 8 * j; const LAS float* s = scr + (8 * c) * 33 + n;
        u32x4 o; o.x = pk2h(s[0 * 33] * wmul, s[1 * 33] * wmul); o.y = pk2h(s[2 * 33] * wmul, s[3 * 33] * wmul); o.z = pk2h(s[4 * 33] * wmul, s[5 * 33] * wmul); o.w = pk2h(s[6 * 33] * wmul, s[7 * 33] * wmul);
        *(u32x4*)(WT + (size_t)(drow0 >= 0 ? drow0 + n : win_row(n0 + n)) * KD + kofs + k0 + 8 * c) = o;
        if (WT8) { int w0 = 0, w1 = 0;
            w0 = __builtin_amdgcn_cvt_pk_fp8_f32(s[0 * 33] * sc8, s[1 * 33] * sc8, w0, false); w0 = __builtin_amdgcn_cvt_pk_fp8_f32(s[2 * 33] * sc8, s[3 * 33] * sc8, w0, true);
            w1 = __builtin_amdgcn_cvt_pk_fp8_f32(s[4 * 33] * sc8, s[5 * 33] * sc8, w1, false); w1 = __builtin_amdgcn_cvt_pk_fp8_f32(s[6 * 33] * sc8, s[7 * 33] * sc8, w1, true);
            *(u32x2*)(WT8 + (size_t)(drow8 >= 0 ? drow8 + n : win_row(n0 + n) + drow8) * 1024 + k0 + 8 * c) = (u32x2){(unsigned)w0, (unsigned)w1}; } }
    asm volatile("s_waitcnt lgkmcnt(0)" ::: "memory");
}
__device__ __forceinline__ unsigned amax_bits(const unsigned char* ws, int G, size_t off = WS_AMAX) {
    int ln = lane_id(); asm volatile("" : "+v"(ln));
    float m = 0.f; for (int i = ln; i < G; i += 64) m = fmaxf(m, ((const float*)(ws + off))[i]);
#pragma unroll
    for (int o_ = 1; o_ < 64; o_ <<= 1) m = fmaxf(m, __shfl_xor(m, o_));
    return (unsigned)__builtin_amdgcn_readfirstlane((int)__float_as_uint(m));
}
__device__ __forceinline__ int w8_exp(unsigned amax_bits) {
    const float am = __uint_as_float(amax_bits);
    if (!(am > 1e-30f) || !(am < 1e30f)) return 0;
    const float r = 224.0f / am; return (int)((__float_as_uint(r) >> 23) & 255u) - 127;
}


__device__ __forceinline__ void score_bounds(const Args& A, float& boundA, float& boundB) {
    int ln = lane_id(); asm volatile("" : "+v"(ln));
    float qa = fabsf(A.qn_a[ln]), ka = fabsf(A.kn_a[ln]), qb_ = fabsf(A.qn_b[ln]), kb_ = fabsf(A.kn_b[ln]);
#pragma unroll
    for (int o_ = 1; o_ < 64; o_ <<= 1) { qa = fmaxf(qa, __shfl_xor(qa, o_)); ka = fmaxf(ka, __shfl_xor(ka, o_)); qb_ = fmaxf(qb_, __shfl_xor(qb_, o_)); kb_ = fmaxf(kb_, __shfl_xor(kb_, o_)); }
    boundA = __uint_as_float(__builtin_amdgcn_readfirstlane(__float_as_uint(C2 * 64.0f * 1.01f * qa * ka))); boundB = __uint_as_float(__builtin_amdgcn_readfirstlane(__float_as_uint(C2 * 64.0f * 1.01f * qb_ * kb_)));
}
__device__ __forceinline__ bool use_fp8(float boundA, float boundB) { return (boundA <= 13.7f) && (boundB <= 13.7f); }

#define XB_TMO      128
#define XB_XCNT(j)  (256  + 64 * (j))
#define XB_XSUB(j)  (1280 + 64 * (j))
#define XB_XGEN(j)  (2304 + 64 * (j))
#define XB_TOP      3328
#define XB_TOPGEN   3392
#define XB_AMAX      3456
#define XCD_BAR_WORDS 3472
#define XB_SPIN_CAP (1u << 18)
__device__ __forceinline__ unsigned xb_ld(unsigned* p)              { return __hip_atomic_load(p, __ATOMIC_RELAXED, __HIP_MEMORY_SCOPE_AGENT); }
__device__ __forceinline__ unsigned xb_add(unsigned* p, unsigned v) { return __hip_atomic_fetch_add(p, v, __ATOMIC_RELAXED, __HIP_MEMORY_SCOPE_AGENT); }
__device__ __forceinline__ unsigned xb_xcc_id() { return (unsigned)__builtin_amdgcn_s_getreg((3 << 11) | 20) & 0xFu; }
#define XB_SPIN(cond, bar) do { unsigned _sp = 0; while (cond) { __builtin_amdgcn_s_sleep(1); \
    if ((++_sp & 255u) == 0u) { if (xb_ld(&(bar)[XB_TMO])) break; if (_sp > XB_SPIN_CAP) { atomicAdd(&(bar)[XB_TMO], 1u); break; } } } } while (0)
struct XcdBarrier { unsigned* bar; unsigned x; volatile LAS unsigned* st; int wave; };
__device__ __forceinline__ XcdBarrier xcd_barrier_post(unsigned* bar, volatile LAS unsigned* st, int wave) {
    XcdBarrier b; b.bar = bar; b.x = xb_xcc_id(); b.st = st; b.wave = wave;
    if (wave == 0 && lane_id() == 0) (void)xb_add(&bar[XB_XCNT(b.x)], 1u);
    return b;
}
__device__ __forceinline__ void xcd_barrier_complete(unsigned* bar, unsigned x, unsigned& nloc, unsigned& nx) {
    const unsigned G = gridDim.x * gridDim.y * gridDim.z;
    unsigned sum, cnt, mine, sp = 0u;
    for (;;) {
        sum = 0u; cnt = 0u; mine = 0u;
#pragma unroll
        for (unsigned j = 0; j < 16; ++j) { const unsigned c = xb_ld(&bar[XB_XCNT(j)]); sum += c; cnt += (c > 0u) ? 1u : 0u; mine = (j == x) ? c : mine; }
        if (sum == G) break;
        __builtin_amdgcn_s_sleep(1);
        if ((++sp & 255u) == 0u) { if (xb_ld(&bar[XB_TMO])) break; if (sp > XB_SPIN_CAP) { atomicAdd(&bar[XB_TMO], 1u); break; } }
    }
    nloc = mine > 0u ? mine : 1u; nx = cnt > 0u ? cnt : 1u;
}
__device__ __forceinline__ void xcd_barrier(const XcdBarrier& b) {
    asm volatile("s_waitcnt vmcnt(0)" ::: "memory");
    __syncthreads();
    if (b.wave == 0 && lane_id() == 0) {
        unsigned* bar = b.bar;
        __builtin_amdgcn_s_waitcnt(0);
        unsigned nloc = b.st[0], nx = b.st[1];
        if (nloc == 0u) { xcd_barrier_complete(bar, b.x, nloc, nx); b.st[0] = nloc; b.st[1] = nx; }
        const unsigned old = xb_add(&bar[XB_XSUB(b.x)], 1u);
        const unsigned gen = old / nloc;
        if (old + 1u == (gen + 1u) * nloc) {
            __builtin_amdgcn_fence(__ATOMIC_RELEASE, "agent");
            asm volatile("s_waitcnt vmcnt(0)" ::: "memory");
            const unsigned og = xb_add(&bar[XB_TOP], 1u);
            const unsigned tg = og / nx;
            if (og + 1u == (tg + 1u) * nx) xb_add(&bar[XB_TOPGEN], 1u);
            else XB_SPIN(xb_ld(&bar[XB_TOPGEN]) == tg, bar);
            __builtin_amdgcn_fence(__ATOMIC_ACQUIRE, "agent");
            xb_add(&bar[XB_XGEN(b.x)], 1u);
            asm volatile("s_waitcnt vmcnt(0)" ::: "memory");
        } else {
            XB_SPIN(xb_ld(&bar[XB_XGEN(b.x)]) == gen, bar);
            __builtin_amdgcn_fence(__ATOMIC_ACQUIRE, "agent");
            asm volatile("s_waitcnt vmcnt(0)" ::: "memory");
        }
    }
    __syncthreads();
}

__global__ void __launch_bounds__(NWAVES * 64, 2) mega_fwd(Args A) {
    extern __shared__ __attribute__((aligned(16))) unsigned char lds[];
    LAS unsigned char* ldsl = (LAS unsigned char*)lds;
    const int tid = threadIdx.x, lane = tid & 63, wave = __builtin_amdgcn_readfirstlane(tid >> 6);
    const int G = gridDim.x; const int bx = blockIdx.x; const int vcu = (G % 8 == 0) ? (bx % 8) * (G / 8) + bx / 8 : bx;
    unsigned char* ws = A.ws;
    const int gw = vcu * NWAVES + wave, NGW = G * NWAVES;
    volatile LAS unsigned* bar_st = (volatile LAS unsigned*)(ldsl + LDS_BYTES - 64);
    if (tid == 0) { bar_st[0] = 0u; bar_st[1] = 0u; }
    __syncthreads();
    const XcdBarrier xbar = xcd_barrier_post((unsigned*)ws, bar_st, wave);

    {
        for (int it = gw; it < 48 * 16; it += NGW) {
            const int cgp = it % 48, kc = it / 48, col = cgp * 64 + lane, k0 = kc * 64;
            float sv[6], ac[6];
#pragma unroll
            for (int b = 0; b < 6; ++b) { const float c = b < 4 ? A.c_prompt[b * DM + k0 + lane] : A.c_sample[(b - 4) * DM + k0 + lane]; sv[b] = silu_f(c); ac[b] = 0.f; }
            for (int kk = 0; kk < 64; ++kk) {
                const float w = A.w_ada[(size_t)(k0 + kk) * 3072 + col];
#pragma unroll
                for (int b = 0; b < 6; ++b) ac[b] += __shfl(sv[b], kk) * w;
            }
            float* modp = (float*)(ws + WS_MODP);
#pragma unroll
            for (int b = 0; b < 6; ++b) modp[(size_t)(kc * 6 + b) * 3072 + col] = ac[b];
        }
        {
            float am = 0.f;
            for (int i = gw * 64 + lane; i < DM * 384; i += NGW * 64) {
                const int row = i / 384, c4 = i - row * 384, col = c4 < 128 ? 4 * c4 : 1280 + 4 * (c4 - 128);
                const f32x4 v = *(const f32x4*)(A.w_in + (size_t)row * DIN + col);
                am = fmaxf(fmaxf(am, fmaxf(fabsf(v.x), fabsf(v.y))), fmaxf(fabsf(v.z), fabsf(v.w)));
            }
            float ag = 0.f;
            for (int i = gw * 64 + lane; i < DM * 512; i += NGW * 64) {
                const int row = i >> 9, col = 3328 + 4 * (i & 511);
                const f32x4 v = *(const f32x4*)(A.w_in + (size_t)row * DIN + col);
                ag = fmaxf(fmaxf(ag, fmaxf(fabsf(v.x), fabsf(v.y))), fmaxf(fabsf(v.z), fabsf(v.w)));
            }
#pragma unroll
            for (int o_ = 1; o_ < 64; o_ <<= 1) { am = fmaxf(am, __shfl_xor(am, o_)); ag = fmaxf(ag, __shfl_xor(ag, o_)); }
            LAS float* amw = (LAS float*)(ldsl + 1024);
            if (lane == 0) { amw[wave] = am; amw[8 + wave] = ag; }
            __syncthreads();
            if (tid == 0) { float m = amw[0], mg = amw[8];
#pragma unroll
                for (int w = 1; w < NWAVES; ++w) { m = fmaxf(m, amw[w]); mg = fmaxf(mg, amw[8 + w]); }
                ((float*)(ws + WS_AMAX))[bx] = m; ((float*)(ws + WS_AMAXG))[bx] = mg; }
        }
    }
    xcd_barrier(xbar);

    {
        LAS float* Gt = (LAS float*)(ldsl + 140 * 1024); LAS float* St = Gt + DM;
        const float* modp = (const float*)(ws + WS_MODP);
        if (vcu < NBATCH) {
            for (int c = tid; c < DM; c += NWAVES * 64) { float g = A.b_ada[2048 + c];
                for (int kc = 0; kc < 16; ++kc) g += modp[(size_t)(kc * 6 + vcu) * 3072 + 2048 + c];
                ((float*)(ws + WS_GATE))[vcu * DM + c] = g; }
        }
        const int rstart = (int)((long)TOK * vcu / G), rend = (int)((long)TOK * (vcu + 1) / G);
        const int b_lo = rstart >> 13, b_hi = (rend - 1) >> 13;
        for (int b = b_lo; b <= b_hi; ++b) {
            __syncthreads();
            for (int c = tid; c < DM; c += NWAVES * 64) { float sh = A.b_ada[c], scl = A.b_ada[1024 + c];
                for (int kc = 0; kc < 16; ++kc) { sh += modp[(size_t)(kc * 6 + b) * 3072 + c]; scl += modp[(size_t)(kc * 6 + b) * 3072 + 1024 + c]; }
                Gt[c] = A.norm_g[c] * (1.0f + scl); St[c] = sh; }
            __syncthreads();
            const int lo = rstart > b * SEQ ? rstart : b * SEQ, hi_ = rend < (b + 1) * SEQ ? rend : (b + 1) * SEQ;
            for (int r = lo + wave; r < hi_; r += NWAVES) {
                const float* xrow = r < TOKP ? A.x_prompt + (size_t)r * DM : A.x_sample + (size_t)(r - TOKP) * DM;
                const f32x4* xr = (const f32x4*)xrow + lane;
                f32x4 v[4]; float s = 0.f;
#pragma unroll
                for (int j = 0; j < 4; ++j) { v[j] = __builtin_nontemporal_load(xr + 64 * j); s += (v[j].x * v[j].x + v[j].y * v[j].y) + (v[j].z * v[j].z + v[j].w * v[j].w); }
                const float rstd = 1.0f / sqrtf(wave_sum(s) * (1.0f / DM) + EPS);
                u32x2* o8 = (u32x2*)((h16_t*)(ws + WS_XN) + (size_t)r * DM) + lane;
                unsigned* o8b = (unsigned*)(ws + WS_XN8 + (size_t)r * DM) + lane;
#pragma unroll
                for (int j = 0; j < 4; ++j) { const f32x4 gq = *(const LAS f32x4*)(Gt + 4 * lane + 256 * j), sq = *(const LAS f32x4*)(St + 4 * lane + 256 * j);
                    const f32x4 h = v[j] * rstd * gq + sq; u32x2 w; w.x = pk2h(h.x, h.y); w.y = pk2h(h.z, h.w); o8[64 * j] = w;
                    int w8 = 0; w8 = __builtin_amdgcn_cvt_pk_fp8_f32(__builtin_amdgcn_fmed3f(h.x, -448.f, 448.f), __builtin_amdgcn_fmed3f(h.y, -448.f, 448.f), w8, false);
                    w8 = __builtin_amdgcn_cvt_pk_fp8_f32(__builtin_amdgcn_fmed3f(h.z, -448.f, 448.f), __builtin_amdgcn_fmed3f(h.w, -448.f, 448.f), w8, true); o8b[64 * j] = (unsigned)w8; }
            }
        }
        __syncthreads();
        LAS float* scr = (LAS float*)(ldsl + wave * 16384);
        const float w8s = __uint_as_float((unsigned)(127 + w8_exp(amax_bits(ws, G))) << 23);
        const float w8g = -1.4426950408889634f * __uint_as_float((unsigned)(127 + w8_exp(amax_bits(ws, G, WS_AMAXG))) << 23);
        constexpr int I_IN = (DM / 64) * (DIN / 32), I_PA = (512 / 64) * (DM / 32), I_OUT = (DM / 64) * (DM / 32);
        constexpr int NITEMS = I_IN + 2 * I_PA + I_OUT;
        for (int it = gw; it < NITEMS; it += NGW) {
            int r = it;
            if (r < I_IN) { const int nblk = DIN / 32, kb = r / nblk, nb = r % nblk, wr_ = win_row(32 * nb), T_ = nb >> 3;
                const bool qk8 = T_ < 2 || (T_ >= 5 && T_ <= 8);
                transpose_item(A.w_in, DIN, (h16_t*)(ws + WS_WIN), DM, 0, 64 * kb, 32 * nb, -1, scr, lane, qk8 ? ws + WS_WIN8 : (T_ >= 13 ? ws + WS_WIN8G : nullptr), qk8 ? wr_ : -13 * 256, qk8 ? w8s : w8g, T_ >= 13 ? -1.4426950408889634f : 1.0f); continue; } r -= I_IN;
            if (r < I_PA) { const int nblk = DM / 32, kb = r / nblk, nb = r % nblk, n0 = 32 * nb; transpose_item(A.w_proj_a, DM, (h16_t*)(ws + WS_WAB), DM, 0, 64 * kb, n0, 256 * (n0 >> 7) + (n0 & 127), scr, lane); continue; } r -= I_PA;
            if (r < I_PA) { const int nblk = DM / 32, kb = r / nblk, nb = r % nblk, n0 = 32 * nb; transpose_item(A.w_proj_b, DM, (h16_t*)(ws + WS_WAB), DM, 512, 64 * kb, n0, 256 * (n0 >> 7) + 128 + (n0 & 127), scr, lane); continue; } r -= I_PA;
            { const int nblk = DM / 32, kb = r / nblk, nb = r % nblk; transpose_item(A.w_out, DM, (h16_t*)(ws + WS_WOUT), DM, 0, 64 * kb, 32 * nb, 32 * nb, scr, lane); }
        }
        for (int row = gw; row < 2048; row += NGW) {
            h16_t* p = (h16_t*)(ws + WS_WAB) + (size_t)row * DM + ((row & 128) ? 0 : 512) + lane * 8;
            *(u32x4*)p = (u32x4){0u, 0u, 0u, 0u};
        }
        if (vcu == 0) { float* nrm = (float*)(ws + WS_NRM);
            if (tid < 64) { nrm[tid] = A.qn_a[tid]; nrm[64 + tid] = A.kn_a[tid]; nrm[128 + tid] = A.qn_b[tid]; nrm[192 + tid] = A.kn_b[tid]; }
            if (tid < 128) nrm[256 + tid] = A.subln_g[tid]; }
        {
            const int gt = vcu * (NWAVES * 64) + tid, NGT = G * NWAVES * 64;
            for (int e = gt; e < 65536 + 2048 + 1024; e += NGT) {
                int pos, j, kind; if (e < 65536) { kind = 0; pos = e >> 3; j = e & 7; } else if (e < 65536 + 2048) { kind = 1; pos = (e - 65536) >> 4; j = e & 15; } else { kind = 2; pos = (e - 65536 - 2048) >> 4; j = e & 15; }
                const double inv = kind == 0 ? INV_B[j] : INV_A[j & 15];
                double rev = (double)pos * inv * 0.15915494309189533577; rev -= floor(rev);
                const double q4 = floor(rev * 4.0 + 0.5); const double xr = (rev - q4 * 0.25) * 6.283185307179586476925; const double x2 = xr * xr;
                const double sp = xr * (1.0 + x2 * (-1.0 / 6 + x2 * (1.0 / 120 + x2 * (-1.0 / 5040 + x2 * (1.0 / 362880 + x2 * (-1.0 / 39916800 + x2 * (1.0 / 6227020800.0)))))));
                const double cp = 1.0 + x2 * (-0.5 + x2 * (1.0 / 24 + x2 * (-1.0 / 720 + x2 * (1.0 / 40320 + x2 * (-1.0 / 3628800 + x2 * (1.0 / 479001600.0 + x2 * (-1.0 / 87178291200.0)))))));
                const int qd = ((int)q4) & 3;
                const double cd = qd == 0 ? cp : qd == 1 ? -sp : qd == 2 ? -cp : sp, sd = qd == 0 ? sp : qd == 1 ? cp : qd == 2 ? -sp : -cp;
                const float cs = (float)cd, sn = (float)sd;
                h16_t* tp; int stride, half;
                if (kind == 0) { tp = (h16_t*)(ws + WS_TB); stride = 16; half = 8; } else if (kind == 1) { tp = (h16_t*)(ws + WS_TAR); stride = 32; half = 16; } else { tp = (h16_t*)(ws + WS_TAC); stride = 32; half = 16; }
                tp[pos * stride + j] = f2h(cs);
                tp[pos * stride + half + j] = f2h(sn);
            }
        }
    }
    xcd_barrier(xbar);

    int p4_u8, p4_eg;
    {
        float bA_, bB_; score_bounds(A, bA_, bB_); const int u8 = use_fp8(bA_, bB_) ? 1 : 0;
        p4_u8 = __builtin_amdgcn_readfirstlane(u8); p4_eg = __builtin_amdgcn_readfirstlane(w8_exp(amax_bits(ws, G, WS_AMAXG)));
        if (u8) {
            const int eqk = w8_exp(amax_bits(ws, G));
            pg8::Gemm g{(const h16_t*)(ws + WS_XN8), (const h16_t*)(ws + WS_WIN8), TOK, 6 * 256, DM / 2, 0x7f00 | (127 - eqk)}; pg8::StaticOrder S; S.init(TOK, 6 * 256, G, bx);
            if (G == 256) { S.i2 = 3; S.G2 = 192; S.c2 = (bx >= 128 && bx < 192) ? -1 : (bx < 128 ? bx : bx - 64); }
            EpiInProj E{0, ws, 1, 0, 1.0f};
            pg8::gemm_phase<EpiInProj, false, true>(ldsl, g, S, E, wave);
        }
        {
            const int nt16 = u8 ? 3 : 9;
            pg8::Gemm g{(const h16_t*)(ws + WS_XN), (const h16_t*)(ws + WS_WIN) + (size_t)(9 - nt16) * 256 * DM, TOK, nt16 * 256, DM}; pg8::StaticOrder S; S.init(TOK, nt16 * 256, G, u8 ? (bx + G / 2) % G : bx);
            EpiInProj E{0, ws, u8, 9 - nt16, 1.0f};
            pg8::gemm_phase<EpiInProj>(ldsl, g, S, E, wave);
        }
    }
    xcd_barrier(xbar);

    {
        float lam;
        { int ln = lane_id(); asm volatile("" : "+v"(ln)); const float p1 = A.lq1[ln] * A.lk1[ln], p2 = A.lq2[ln] * A.lk2[ln]; lam = __uint_as_float(__builtin_amdgcn_readfirstlane(__float_as_uint(__expf(wave_sum(p1)) - __expf(wave_sum(p2)) + LAM_INIT))); }
        float boundA, boundB; score_bounds(A, boundA, boundB); const bool use8 = use_fp8(boundA, boundB);
        auto shift_of = [](float bound) -> int { const unsigned b = __float_as_uint(bound); const int e = (int)(b >> 23) - 127; const unsigned m = (b & 0x7fffffu) | 0x800000u;
            const int fx = e >= 13 ? (int)(m << (e - 13)) : (e >= -10 ? (int)(m >> (13 - e)) : 0);
            return (fx - 8960 + 1024) >> 10; };
        const int mIA = shift_of(boundA), mIB = shift_of(boundB);
        char* shm = (char*)lds;
        h16_t* OAB = (h16_t*)(ws + WS_OAB);
        auto first_dma = [&](int s_, int p_) {
            if (s_ < 768) { const int u = (s_ >> 8) * 32 + (s_ & 31), xg = (s_ & 255) >> 5, j = u >> 4, id = 3 * xg + (j >> 1), b = id >> 2, kvh = (id >> 1) & 1;
                att::attn_first_dma<2>((const unsigned char*)(ws + WS_KA) + (long)b * SEQ * 96 + kvh * 48, 96, (const unsigned char*)(ws + WS_VTA) + (long)((b * 2 + kvh) * 64) * SEQ, shm, wave);
            } else { const int a = s_ - 768, ii = a >> 8, vv = a & 255, xg = vv >> 5, id = 3 * xg + ii, b = id >> 2, h = id & 3;
                att::attn_first_dma<4>((const unsigned char*)(ws + WS_KB) + (long)b * SEQ * 384 + (2 * h + p_) * 48, 384, (const unsigned char*)(ws + WS_VTB) + (long)((b * 4 + h) * 128) * SEQ, shm, wave); }
        };
        if (use8 && vcu < 1536) first_dma(vcu, 0);
        for (int s = vcu; s < 1536; s += G) {
            const bool isB = s >= 768;
            if (!isB) {
                const int u = (s >> 8) * 32 + (s & 31), xg = (s & 255) >> 5, qb = u & 15, j = u >> 4, id = 3 * xg + (j >> 1), sel = j & 1, b = id >> 2;
                const long rowbase = (long)b * SEQ + qb * 512 + wave * 64;
                const int kvh = (id >> 1) & 1, h = 4 * kvh + 2 * (id & 1) + sel;
                const h16_t* Qw = (const h16_t*)(ws + WS_QA) + rowbase * 512 + h * 64;
                const h16_t* Kh = (const h16_t*)(ws + WS_KA) + (long)b * SEQ * 128 + kvh * 64;
                const h16_t* Vh = (const h16_t*)(ws + WS_VA) + (long)b * SEQ * 128 + kvh * 64;
                f32x16 oa[2], ob[2]; float la, lb;
                if (use8) att::attn_pass8_2x((const unsigned char*)(ws + WS_QA) + rowbase * 384 + h * 48, 384, (const unsigned char*)(ws + WS_KA) + (long)b * SEQ * 96 + kvh * 48, 96,
                                             (const unsigned char*)(ws + WS_VTA) + (long)((b * 2 + kvh) * 64) * SEQ, mIA, shm, oa, ob, la, lb, wave, true);
                if (use8 && s + G < 1536) first_dma(s + G, 0);
                auto epiA = [&](const f32x16 (&o)[2], float l, long rb) {
                    int tid2 = wave * 64 + lane_id(); asm volatile("" : "+v"(tid2));
                    const int lane = tid2 & 63, r32 = lane & 31, hi = lane >> 5;
                    float* wsf = (float*)(shm + att::LDS_WS) + wave * 64;
                    h16_t* stg = (h16_t*)(shm + att::LDS_OST + wave * att::OST_WAVE);
                    if (hi == 0) wsf[32 + r32] = l; asm volatile("s_waitcnt lgkmcnt(0)" ::: "memory");
                    float rli[16];
#pragma unroll
                    for (int r = 0; r < 16; ++r) rli[r] = __builtin_amdgcn_rcpf(wsf[32 + att::crow(r, hi)]);
#pragma unroll
                    for (int r = 0; r < 16; ++r) { const int orow = att::crow(r, hi);
#pragma unroll
                        for (int d0 = 0; d0 < 2; ++d0) stg[orow * 64 + d0 * 32 + r32] = f2h(o[d0][r] * rli[r]); }
                    asm volatile("s_waitcnt lgkmcnt(0)" ::: "memory");
                    h16_t* Ow = OAB + rb * 1024 + h * 64;
#pragma unroll
                    for (int i = 0; i < 4; ++i) { const int row = i * 8 + (lane >> 3), ch = lane & 7; const u32x4 v = *(const u32x4*)(stg + row * 64 + ch * 8); *(u32x4*)(Ow + (long)row * 1024 + ch * 8) = v; }
                    asm volatile("s_waitcnt lgkmcnt(0)" ::: "memory");
                };
                if (use8) { epiA(oa, la, rowbase); epiA(ob, lb, rowbase + 32); }
                else {
#pragma unroll 1
                    for (int sub = 0; sub < 2; ++sub) { att::attn_pass<8, false>(Qw + (long)sub * 32 * 512, 512, Kh, 128, Vh, 128, shm, oa, la, wave); epiA(oa, la, rowbase + 32 * sub); }
                }
            } else {
                const int a = s - 768, ii = a >> 8, vv = a & 255, xg = vv >> 5, qb = vv & 31, id = 3 * xg + ii, b = id >> 2, h = id & 3;
                const long rowbase = (long)b * SEQ + qb * 256 + wave * 32;
                const h16_t* Vh = (const h16_t*)(ws + WS_VB) + (long)b * SEQ * 512 + h * 128;
#pragma unroll 1
                for (int p = 0; p < 2; ++p) {
                    const h16_t* Qw = (const h16_t*)(ws + WS_QB) + rowbase * 512 + (2 * h + p) * 64;
                    const h16_t* Kh = (const h16_t*)(ws + WS_KB) + (long)b * SEQ * 512 + (2 * h + p) * 64;
                    f32x16 o[4]; float l;
                    if (use8) att::attn_pass8<4>((const unsigned char*)(ws + WS_QB) + rowbase * 384 + (2 * h + p) * 48, 384, (const unsigned char*)(ws + WS_KB) + (long)b * SEQ * 384 + (2 * h + p) * 48, 384,
                                                 (const unsigned char*)(ws + WS_VTB) + (long)((b * 4 + h) * 128) * SEQ, mIB, shm, o, l, wave, true);
                    else att::attn_pass128<8, false>(Qw, 512, Kh, 512, Vh, 512, shm, o, l, wave);
                    if (use8) { if (p == 0) first_dma(s, 1); else if (s + G < 1536) first_dma(s + G, 0); }
                    int tid2 = wave * 64 + lane_id(); asm volatile("" : "+v"(tid2));
                    const int lane = tid2 & 63, r32 = lane & 31, hi = lane >> 5;
                    float* wsf = (float*)(shm + att::LDS_WS) + wave * 64;
                    unsigned* stw = (unsigned*)(shm + att::LDS_OST + wave * att::OST_WAVE);
                    h16_t* stg = (h16_t*)stw;
                    if (hi == 0) wsf[32 + r32] = l; asm volatile("s_waitcnt lgkmcnt(0)" ::: "memory");
                    float rli[16];
#pragma unroll
                    for (int r = 0; r < 16; ++r) rli[r] = __builtin_amdgcn_rcpf(wsf[32 + att::crow(r, hi)]);
                    if (p == 0) {
#pragma unroll
                        for (int d0 = 0; d0 < 4; ++d0)
#pragma unroll
                            for (int r = 0; r < 16; r += 2) stw[(d0 * 8 + (r >> 1)) * 64 + lane] = pk2h(o[d0][r] * rli[r], o[d0][r + 1] * rli[r + 1]);
                        asm volatile("s_waitcnt lgkmcnt(0)" ::: "memory");
                    } else {
                        unsigned sv[32];
#pragma unroll
                        for (int i = 0; i < 32; ++i) sv[i] = stw[i * 64 + lane];
                        asm volatile("s_waitcnt lgkmcnt(0)" ::: "memory");
#pragma unroll
                        for (int d0 = 0; d0 < 4; ++d0)
#pragma unroll
                            for (int r = 0; r < 16; ++r) { const unsigned w = sv[d0 * 8 + (r >> 1)]; const float o0 = h2f((unsigned short)((r & 1) ? (w >> 16) : (w & 0xffffu)));
                                const float dv = o0 - lam * (o[d0][r] * rli[r]);
                                stg[att::crow(r, hi) * 128 + d0 * 32 + r32] = f2h(dv); }
                        asm volatile("s_waitcnt lgkmcnt(0)" ::: "memory");
                        const float* sg = A.subln_g;
                        h16_t* Ow = OAB + rowbase * 1024 + 512 + h * 128;
#pragma unroll
                        for (int i = 0; i < 8; ++i) { const int row = i * 4 + (lane >> 4), ch = lane & 15; const u32x4 v = *(const u32x4*)(stg + row * 128 + ch * 8);
                            float f[8]; float q = 0.f;
#pragma unroll
                            for (int e = 0; e < 4; ++e) { f[2 * e] = h2f((unsigned short)(v[e] & 0xffffu)); f[2 * e + 1] = h2f((unsigned short)(v[e] >> 16)); q += f[2 * e] * f[2 * e] + f[2 * e + 1] * f[2 * e + 1]; }
                            q += __shfl_xor(q, 1); q += __shfl_xor(q, 2); q += __shfl_xor(q, 4); q += __shfl_xor(q, 8);
                            const float rn = __builtin_amdgcn_rsqf(q * (1.0f / 128.0f) + EPS) * (1.0f - LAM_INIT);
                            const f32x4 g0 = *(const f32x4*)(sg + ch * 8), g1 = *(const f32x4*)(sg + ch * 8 + 4);
                            u32x4 w; w.x = pk2h(f[0] * rn * g0[0], f[1] * rn * g0[1]); w.y = pk2h(f[2] * rn * g0[2], f[3] * rn * g0[3]); w.z = pk2h(f[4] * rn * g1[0], f[5] * rn * g1[1]); w.w = pk2h(f[6] * rn * g1[2], f[7] * rn * g1[3]);
                            *(u32x4*)(Ow + (long)row * 1024 + ch * 8) = w; }
                        asm volatile("s_waitcnt lgkmcnt(0)" ::: "memory");
                    }
                }
            }
        }
    }
    xcd_barrier(xbar);

    {
        const int u8 = p4_u8;
        {
            const int nt16 = u8 ? 4 : 12;
            pg8::Gemm g{(const h16_t*)(ws + WS_XN), (const h16_t*)(ws + WS_WIN) + (size_t)9 * 256 * DM, TOK, nt16 * 256, DM}; pg8::StaticOrder S; S.init(TOK, nt16 * 256, G, bx);
            EpiInProj E{1, ws, 0, 0, 1.0f};
            pg8::gemm_phase<EpiInProj>(ldsl, g, S, E, wave);
        }
        if (u8) {
            pg8::Gemm g{(const h16_t*)(ws + WS_XN8), (const h16_t*)(ws + WS_WIN8G), TOK, 8 * 256, DM / 2, 0x7f00 | (127 - p4_eg)}; pg8::StaticOrder S; S.init(TOK, 8 * 256, G, bx);
            EpiInProj E{1, ws, 0, 4, 1.0f};
            pg8::gemm_phase<EpiInProj, false, true>(ldsl, g, S, E, wave);
        }
    }
    xcd_barrier(xbar);

    {
        pg8::Gemm g{(const h16_t*)(ws + WS_OAB), (const h16_t*)(ws + WS_WAB), TOK, 2048, DM}; pg8::StaticOrder S; S.init(TOK, 2048, G, bx);
        EpiMerge E{ws + WS_SGA, ws + WS_SGB, (h16_t*)(ws + WS_MG)};
        pg8::gemm_phase<EpiMerge, true>(ldsl, g, S, E, wave);
    }
    xcd_barrier(xbar);

    {
        pg8::Gemm g{(const h16_t*)(ws + WS_MG), (const h16_t*)(ws + WS_WOUT), TOK, DM, DM}; pg8::StaticOrder S; S.init(TOK, DM, G, bx);
        EpiOut E{A.x_prompt, (long)((const char*)A.x_sample - (const char*)A.x_prompt) - (long)TOKP * DM * 4, (const float*)(ws + WS_GATE), A.out};
        pg8::gemm_phase<EpiOut>(ldsl, g, S, E, wave);
    }
}

extern "C" void kernel_launch(void* const* d_in, const int* in_sizes, int n_in, void* d_out, int out_size, void* d_ws, size_t ws_size, hipStream_t stream) {
    static int grid = 0;
    if (grid == 0) {
        if (n_in != 20 || out_size != TOK * DM || ws_size < WS_END) { fprintf(stderr, "kernel_launch: unexpected shapes (n_in %d out %d ws %zu)\n", n_in, out_size, ws_size); grid = -1; return; }
        int dev = 0, cus = 0, per_cu = 0;
        hipGetDevice(&dev); hipDeviceGetAttribute(&cus, hipDeviceAttributeMultiprocessorCount, dev);
        hipFuncSetAttribute((const void*)mega_fwd, hipFuncAttributeMaxDynamicSharedMemorySize, LDS_BYTES);
        hipOccupancyMaxActiveBlocksPerMultiprocessor(&per_cu, (const void*)mega_fwd, NWAVES * 64, LDS_BYTES);
        (void)hipGetLastError();
        if (per_cu < 1) fprintf(stderr, "kernel_launch: occupancy query reports %d blocks per CU\n", per_cu);
        grid = cus > 0 ? cus : 256;
    }
    if (grid < 0) return;
    Args a{};
    a.x_prompt = (const float*)d_in[0]; a.x_sample = (const float*)d_in[1]; a.c_prompt = (const float*)d_in[2]; a.c_sample = (const float*)d_in[3];
    a.w_ada = (const float*)d_in[4]; a.b_ada = (const float*)d_in[5]; a.norm_g = (const float*)d_in[6]; a.w_in = (const float*)d_in[7];
    a.qn_a = (const float*)d_in[8]; a.kn_a = (const float*)d_in[9]; a.qn_b = (const float*)d_in[10]; a.kn_b = (const float*)d_in[11];
    a.lq1 = (const float*)d_in[12]; a.lk1 = (const float*)d_in[13]; a.lq2 = (const float*)d_in[14]; a.lk2 = (const float*)d_in[15]; a.subln_g = (const float*)d_in[16];
    a.w_proj_a = (const float*)d_in[17]; a.w_proj_b = (const float*)d_in[18]; a.w_out = (const float*)d_in[19];
    a.out = (float*)d_out; a.ws = (unsigned char*)d_ws;
    if (hipMemsetAsync(d_ws, 0, XCD_BAR_WORDS * 4, stream) != hipSuccess) { fprintf(stderr, "kernel_launch: hipMemsetAsync failed\n"); return; }
    void* args[] = {&a};
    hipError_t e = hipLaunchCooperativeKernel((const void*)mega_fwd, dim3(grid), dim3(NWAVES * 64), args, LDS_BYTES, stream);
    if (e != hipSuccess) fprintf(stderr, "kernel_launch: cooperative launch failed: %s (grid %d)\n", hipGetErrorString(e), grid);
}
```

```cpp
#include <hip/hip_runtime.h>
#include <cstdio>
#include <cstdint>
#include <cmath>

#define LAS __attribute__((address_space(3)))
#define GAS __attribute__((address_space(1)))
typedef unsigned short h16_t;
#ifndef LP_BF16
#define LP_BF16 1
#endif
#if LP_BF16
typedef __bf16 lp_t;
typedef short f16x8 __attribute__((ext_vector_type(8)));
#define MFMA16(a, b, c) __builtin_amdgcn_mfma_f32_16x16x32_bf16(a, b, c, 0, 0, 0)
#define MFMA32(a, b, c) __builtin_amdgcn_mfma_f32_32x32x16_bf16(a, b, c, 0, 0, 0)
#else
typedef _Float16 lp_t;
typedef _Float16 f16x8 __attribute__((ext_vector_type(8)));
#define MFMA16(a, b, c) __builtin_amdgcn_mfma_f32_16x16x32_f16(a, b, c, 0, 0, 0)
#endif
typedef lp_t f16x2 __attribute__((ext_vector_type(2)));
typedef float f32x2 __attribute__((ext_vector_type(2)));
typedef float f32x4 __attribute__((ext_vector_type(4)));
typedef float f32x8 __attribute__((ext_vector_type(8)));
typedef float f32x16 __attribute__((ext_vector_type(16)));
typedef unsigned u32x2 __attribute__((ext_vector_type(2)));
typedef unsigned u32x4 __attribute__((ext_vector_type(4)));
typedef short s16x4 __attribute__((ext_vector_type(4)));
typedef int i32x4 __attribute__((ext_vector_type(4)));
typedef int i32x8 __attribute__((ext_vector_type(8)));
typedef int i32x6 __attribute__((ext_vector_type(6)));
#define MFMA8S_G(a, b, c) __builtin_amdgcn_mfma_scale_f32_16x16x128_f8f6f4(a, b, c, 0, 0, 0, scv, 1, scv)

constexpr int DM = 1024, SEQ = 8192, NBATCH = 6, TOK = NBATCH * SEQ, TOKP = 4 * SEQ, DIN = 5376;
constexpr float EPS = 1e-6f;
constexpr float C2 = 0.125f * 1.4426950408889634f;
constexpr float SQK6 = 1.2011224087864498f;
constexpr float LAM_INIT = 0.2f;

constexpr size_t MiB = 1u << 20;
constexpr size_t WS_MODP = 1 * MiB;
constexpr size_t WS_GATE = 3 * MiB;
constexpr size_t WS_TAR = 3 * MiB + 65536;
constexpr size_t WS_TAC = WS_TAR + 8192;
constexpr size_t WS_TB = WS_TAC + 4096;
constexpr size_t WS_NRM = WS_GATE + 32768;
constexpr size_t WS_AMAX = WS_GATE + 32768 + 4096;
constexpr size_t WS_SSQ = 4 * MiB;
constexpr size_t WS_WIN = 6 * MiB;
constexpr size_t WS_WAB = 17 * MiB;
constexpr size_t WS_WOUT = 21 * MiB;
constexpr size_t WS_XN = 24 * MiB;
constexpr size_t WS_MG = WS_XN;
constexpr size_t WS_QA = 120 * MiB, WS_KA = 168 * MiB, WS_VA = 180 * MiB, WS_QB = 192 * MiB, WS_KB = 240 * MiB, WS_VB = 288 * MiB;
constexpr size_t WS_OAB = 336 * MiB;
constexpr size_t WS_SGA = 120 * MiB, WS_SGB = 216 * MiB;
constexpr size_t WS_VTA = 432 * MiB;
constexpr size_t WS_VTB = 438 * MiB;
constexpr size_t WS_XN8 = WS_VB;
constexpr size_t WS_WIN8G = WS_VA + 2 * MiB;
constexpr size_t WS_AMAXG = WS_AMAX + 1024;
constexpr size_t WS_WIN8 = WS_VA;
constexpr size_t WS_END = 462 * MiB;

__device__ __forceinline__ unsigned pk2h(float lo, float hi) { f32x2 v = {lo, hi}; f16x2 b = __builtin_convertvector(v, f16x2); return __builtin_bit_cast(unsigned, b); }
__device__ __forceinline__ float h2f(unsigned short u) { return (float)__builtin_bit_cast(lp_t, u); }
__device__ __forceinline__ unsigned short f2h(float v) { return __builtin_bit_cast(unsigned short, (lp_t)v); }
__device__ __forceinline__ int lane_id() { unsigned z = 0u; asm volatile("" : "+v"(z)); return (int)__builtin_amdgcn_mbcnt_hi(~0u, __builtin_amdgcn_mbcnt_lo(~0u, z)); }
__device__ __forceinline__ float wave_sum(float v) {
#pragma unroll
    for (int o = 1; o < 64; o <<= 1) v += __shfl_xor(v, o);
    return v;
}
__device__ __forceinline__ float silu_f(float v) { return v * __builtin_amdgcn_rcpf(1.0f + __expf(-v)); }
__device__ __forceinline__ float sigm_f(float v) { return __builtin_amdgcn_rcpf(1.0f + __expf(-v)); }

namespace pg8 {
constexpr int BM = 256, BK = 64, HALF = 128, HTB = HALF * BK * 2, STAGE_BYTES = 8 * HTB, NXCD = 8, WGM = 8;
__host__ __device__ __forceinline__ int lds_byte(int r, int c) { const int st = (r >> 4) * 2 + (c >> 5), rr = r & 15, cc = c & 31, ob = rr * 64 + cc * 2; return st * 1024 + (ob ^ (((ob >> 9) & 1) << 5)); }
__host__ __device__ __forceinline__ void stage_rc(int b, int& R, int& C) { const int st = b / 1024, sb = b % 1024, swz = sb ^ (((sb >> 9) & 1) << 5); R = (st >> 1) * 16 + swz / 64; C = (st & 1) * 32 + (swz % 64) / 2; }
__host__ __device__ __forceinline__ int perm32(int rho) { const int n = rho >> 4, i = rho & 15; return 8 * (i >> 2) + 4 * n + (i & 3); }
struct Unit { int pm, pn; };
struct Gemm { const h16_t* A; const h16_t* Bt; int M, N, K; int sc = 0x7f7f; };
struct StaticOrder {
    int nM, nN, nwg, G, c, i2, G2, c2;
    __device__ void init(int M, int N, int G_, int c_) { nM = M / BM; nN = N / BM; nwg = nM * nN; G = G_; c = c_; i2 = 1 << 20; G2 = G_; c2 = c_; }
    __device__ bool next(int i, Unit& u) const {
        long L;
        if (i < i2) L = (long)i * G + c; else { if (c2 < 0) return false; L = (long)i2 * G + (long)(i - i2) * G2 + c2; }
        if (L >= nwg) return false;
        int wgid = (int)L; { const int q = nwg / NXCD, r = nwg % NXCD, xcd = wgid % NXCD, off = wgid / NXCD; wgid = (xcd < r ? xcd * (q + 1) : r * (q + 1) + (xcd - r) * q) + off; }
        const int nig = WGM * nN, gid = wgid / nig, fm = gid * WGM, gsz = (nM - fm) < WGM ? (nM - fm) : WGM;
        u.pm = fm + ((wgid % nig) % gsz); u.pn = (wgid % nig) / gsz; return true;
    }
};
__device__ __forceinline__ i32x8 cat8(f16x8 a, f16x8 b) { const i32x4 x = __builtin_bit_cast(i32x4, a), y = __builtin_bit_cast(i32x4, b); return __builtin_shufflevector(x, y, 0, 1, 2, 3, 4, 5, 6, 7); }
template <class Epi, bool DIAG = false, bool F8 = false>
__device__ __forceinline__ void gemm_phase(LAS unsigned char* lds, const Gemm g, const StaticOrder& S, const Epi& E, int wave_in) {
    int tid = wave_in * 64 + lane_id(); asm volatile("" : "+v"(tid));
    const int wid = wave_in, lane = tid & 63, wr = wid >> 2, wc = wid & 3, fr = lane & 15, fq = lane >> 4;
    const int K = g.K, nt = K / BK;
    int scv = g.sc; asm volatile("" : "+v"(scv)); (void)scv;
    unsigned voffA[2], voffB[2];
#pragma unroll
    for (int i = 0; i < 2; ++i) { int R, C; stage_rc(tid * 16 + i * 8192, R, C); const int Rb = Epi::PERM ? ((R & ~31) + perm32(R & 31)) : R;
        voffA[i] = (unsigned)(R * K + C) * 2u; voffB[i] = (unsigned)(Rb * K + C) * 2u; }
    const size_t kstep = (size_t)(BK * 2);
    const size_t hstep = (size_t)HALF * K * 2;
    const size_t tstep = 2 * hstep;
    const unsigned ldsw = (unsigned)wid * 1024u;
    const int aoff = lds_byte(wr * 64 + fr, fq * 8), boff = lds_byte(wc * 32 + fr, fq * 8);
#define PG8_SA(b, h) (((b) * 2 + (h)) * HTB)
#define PG8_SB(b, h) ((4 + (b) * 2 + (h)) * HTB)
#define PG8_STAGE(bufoff, gbase, voff) do { _Pragma("unroll") for (int _i = 0; _i < 2; ++_i) \
        __builtin_amdgcn_global_load_lds((const unsigned*)((const char*)(gbase) + (voff)[_i]), (LAS unsigned*)(lds + (bufoff) + ldsw + _i * 8192), 16, 0, 0); } while (0)
#define PG8_LD8(p) ({ const i32x4 x_ = *(const LAS i32x4*)(p), y_ = *(const LAS i32x4*)((p) + 1024); (i32x8){x_[0], x_[1], x_[2], x_[3], y_[0], y_[1], y_[2], y_[3]}; })
#define PG8_LDA(dst, b, h) do { if constexpr (F8) { _Pragma("unroll") for (int m = 0; m < 4; ++m) dst##8[m] = PG8_LD8(lds + PG8_SA(b, h) + aoff + m * 2048); } else { \
        _Pragma("unroll") for (int m = 0; m < 4; ++m) _Pragma("unroll") for (int k = 0; k < 2; ++k) dst[m][k] = *(const LAS f16x8*)(lds + PG8_SA(b, h) + aoff + m * 2048 + k * 1024); } } while (0)
#define PG8_LDB(dst, b, h) do { if constexpr (F8) { _Pragma("unroll") for (int n = 0; n < 2; ++n) dst##8[n] = PG8_LD8(lds + PG8_SB(b, h) + boff + n * 2048); } else { \
        _Pragma("unroll") for (int n = 0; n < 2; ++n) _Pragma("unroll") for (int k = 0; k < 2; ++k) dst[n][k] = *(const LAS f16x8*)(lds + PG8_SB(b, h) + boff + n * 2048 + k * 1024); } } while (0)
#define PG8_MMA(ai, bj, At, Bt) do { __builtin_amdgcn_s_setprio(1); if constexpr (F8) { _Pragma("unroll") for (int m = 0; m < 4; ++m) _Pragma("unroll") for (int n = 0; n < 2; ++n) \
        { if (n == 0) acc8[ai][bj][m].lo = MFMA8S_G(Bt##8[n], At##8[m], acc8[ai][bj][m].lo); else acc8[ai][bj][m].hi = MFMA8S_G(Bt##8[n], At##8[m], acc8[ai][bj][m].hi); } \
        _Pragma("unroll") for (int m = 0; m < 4; ++m) asm volatile("" : "+v"(acc8[ai][bj][m])); } else { \
        _Pragma("unroll") for (int m = 0; m < 4; ++m) _Pragma("unroll") for (int n = 0; n < 2; ++n) _Pragma("unroll") for (int k = 0; k < 2; ++k) \
        acc[ai][bj][m][n] = MFMA16(Bt[n][k], At[m][k], acc[ai][bj][m][n]); } __builtin_amdgcn_s_setprio(0); } while (0)
#define PG8_WAIT_V(n) asm volatile("s_waitcnt vmcnt(" #n ")" ::: "memory")
#define PG8_WAIT_L(n) asm volatile("s_waitcnt lgkmcnt(" #n ")" ::: "memory")
#define PG8_BAR __builtin_amdgcn_s_barrier()
#define PG8_SCHED __builtin_amdgcn_sched_barrier(0)
    Unit cur, nxt; int ui = 0;
    if (!S.next(0, cur)) return;
    f32x4 acc[2][2][4][2];
    f32x8 acc8[2][2][4];
#pragma unroll
    for (int a = 0; a < 2; ++a)
#pragma unroll
        for (int b = 0; b < 2; ++b)
#pragma unroll
            for (int m = 0; m < 4; ++m) acc8[a][b][m] = (f32x8){0.f, 0.f, 0.f, 0.f, 0.f, 0.f, 0.f, 0.f};
#pragma unroll
    for (int a = 0; a < 2; ++a)
#pragma unroll
        for (int b = 0; b < 2; ++b)
#pragma unroll
            for (int m = 0; m < 4; ++m)
#pragma unroll
                for (int n = 0; n < 2; ++n) acc[a][b][m][n] = (f32x4){0.f, 0.f, 0.f, 0.f};
    f16x8 At[4][2], B0[2][2], B1[2][2]; i32x8 At8[4], B08[2], B18[2];
    const char* cA = (const char*)g.A + (size_t)cur.pm * tstep; const char* cB = (const char*)g.Bt + (size_t)cur.pn * tstep;
    PG8_STAGE(PG8_SB(0, 0), cB, voffB); if (!DIAG) PG8_STAGE(PG8_SB(0, 1), cB + hstep, voffB); PG8_STAGE(PG8_SA(0, 0), cA, voffA); PG8_STAGE(PG8_SA(0, 1), cA + hstep, voffA);
    if (wr == 1) PG8_BAR;
    PG8_WAIT_V(2); PG8_BAR;
    PG8_STAGE(PG8_SB(1, 0), cB + kstep, voffB); PG8_STAGE(PG8_SA(1, 0), cA + kstep, voffA); if (!DIAG) PG8_STAGE(PG8_SB(1, 1), cB + hstep + kstep, voffB);
    if (DIAG) { PG8_WAIT_V(4); } else { PG8_WAIT_V(6); } PG8_BAR;
    for (;;) {
        const bool has_next = S.next(ui + 1, nxt);
        const char* nA = has_next ? (const char*)g.A + (size_t)nxt.pm * tstep : cA; const char* nB = has_next ? (const char*)g.Bt + (size_t)nxt.pn * tstep : cB;
#pragma unroll 1
        for (int t = 0; t < nt; t += 2) {
            const bool last = (t == nt - 2); const bool lo_half = (2 * t < nt); (void)lo_half;
            const char* a1 = cA + (size_t)(t + 1) * kstep;
            const char* a2 = last ? nA : cA + (size_t)(t + 2) * kstep; const char* b2 = last ? nB : cB + (size_t)(t + 2) * kstep;
            const char* a3 = a2 + kstep; const char* b3 = b2 + kstep;
            const bool lo2 = last || (2 * (t + 2) < nt), lo3 = last || (2 * (t + 3) < nt); (void)lo2; (void)lo3;
#define PG8_WV() do { if (DIAG) { PG8_WAIT_V(6); } else { PG8_WAIT_V(8); } } while (0)
            if (!DIAG || lo_half) PG8_LDB(B0, 0, 0); if (!DIAG || !lo_half) PG8_LDB(B1, 0, 1); PG8_SCHED; PG8_LDA(At, 0, 0); PG8_STAGE(PG8_SA(1, 1), a1 + hstep, voffA);
            PG8_WV(); PG8_WAIT_L(0); PG8_BAR; if (!DIAG || lo_half) PG8_MMA(0, 0, At, B0); if (!DIAG || !lo_half) PG8_MMA(0, 1, At, B1); PG8_BAR; PG8_SCHED;
            PG8_LDA(At, 0, 1); if (!DIAG || lo2) PG8_STAGE(PG8_SB(0, 0), b2, voffB); if (!DIAG || !lo2) PG8_STAGE(PG8_SB(0, 1), b2 + hstep, voffB); PG8_STAGE(PG8_SA(0, 0), a2, voffA);
            PG8_WV(); PG8_WAIT_L(0); PG8_BAR; if (!DIAG || lo_half) PG8_MMA(1, 0, At, B0); if (!DIAG || !lo_half) PG8_MMA(1, 1, At, B1); PG8_BAR; PG8_SCHED;
            if (!DIAG || lo_half) PG8_LDB(B0, 1, 0); if (!DIAG || !lo_half) PG8_LDB(B1, 1, 1); PG8_SCHED; PG8_LDA(At, 1, 0); PG8_STAGE(PG8_SA(0, 1), a2 + hstep, voffA);
            PG8_WV(); PG8_WAIT_L(0); PG8_BAR; if (!DIAG || lo_half) PG8_MMA(0, 0, At, B0); if (!DIAG || !lo_half) PG8_MMA(0, 1, At, B1); PG8_BAR; PG8_SCHED;
            PG8_LDA(At, 1, 1); if (!DIAG || lo3) PG8_STAGE(PG8_SB(1, 0), b3, voffB); if (!DIAG || !lo3) PG8_STAGE(PG8_SB(1, 1), b3 + hstep, voffB); PG8_STAGE(PG8_SA(1, 0), a3, voffA);
            PG8_WV(); PG8_WAIT_L(0); PG8_BAR; if (!DIAG || lo_half) PG8_MMA(1, 0, At, B0); if (!DIAG || !lo_half) PG8_MMA(1, 1, At, B1); PG8_BAR; PG8_SCHED;
#undef PG8_WV
        }
        if (wr == 0) PG8_BAR;
        if constexpr (F8) {
#pragma unroll
            for (int a = 0; a < 2; ++a)
#pragma unroll
                for (int b = 0; b < 2; ++b)
#pragma unroll
                    for (int m = 0; m < 4; ++m) { acc[a][b][m][0] = acc8[a][b][m].lo; acc[a][b][m][1] = acc8[a][b][m].hi; acc8[a][b][m] = (f32x8){0.f, 0.f, 0.f, 0.f, 0.f, 0.f, 0.f, 0.f}; }
        }
        { int l2 = lane_id(); asm volatile("" : "+v"(l2)); E(acc, cur, wr, wc, l2 & 15, l2 >> 4); }
        if (!has_next) break;
#pragma unroll
        for (int a = 0; a < 2; ++a)
#pragma unroll
            for (int b = 0; b < 2; ++b)
#pragma unroll
                for (int m = 0; m < 4; ++m)
#pragma unroll
                    for (int n = 0; n < 2; ++n) acc[a][b][m][n] = (f32x4){0.f, 0.f, 0.f, 0.f};
        cur = nxt; cA = nA; cB = nB; ++ui;
        if (wr == 1) PG8_BAR;
    }
    PG8_WAIT_V(0);
    PG8_BAR;
#undef PG8_SA
#undef PG8_SB
#undef PG8_STAGE
#undef PG8_LDA
#undef PG8_LDB
#undef PG8_MMA
#undef PG8_WAIT_V
#undef PG8_WAIT_L
#undef PG8_BAR
#undef PG8_SCHED
}
}

__device__ __forceinline__ float xsum16(float x) { const auto r = __builtin_amdgcn_permlane16_swap(__float_as_uint(x), __float_as_uint(x), false, false); return __uint_as_float(r[0]) + __uint_as_float(r[1]); }
__device__ __forceinline__ float xsum32(float x) { const auto r = __builtin_amdgcn_permlane32_swap(__float_as_uint(x), __float_as_uint(x), false, false); return __uint_as_float(r[0]) + __uint_as_float(r[1]); }
struct EpiInProj {
    static constexpr bool PERM = true;
    int part; unsigned char* ws; int use8; int pnoff; float wsc;
    __device__ __forceinline__ void operator()(const f32x4 (&acc)[2][2][4][2], const pg8::Unit& u, int wr, int wc, int fr, int fq) const {
        asm volatile("" : "+v"(fr), "+v"(fq));
        const int row0 = u.pm * 256 + wr * 64 + fr;
        const int pi = u.pn + pnoff;
        const int T = part == 0 ? (pi < 2 ? pi : (pi < 6 ? pi + 3 : (pi == 6 ? 2 : pi + 2))) : (pi < 2 ? pi + 3 : pi + 9);
        if (part == 0) {
            const bool normed = (T <= 1) || (T == 2 && wc < 2) || (T >= 5 && T <= 8);
            if (normed) {
                const bool isA = (T <= 2), isQ = (T <= 1) || (T == 5) || (T == 6);
                const float* gw = (const float*)(ws + WS_NRM) + 64 * ((isA ? 0 : 2) + (isQ ? 0 : 1));
                h16_t* dst; int pitch, colbase;
                if (T <= 1) { dst = (h16_t*)(ws + WS_QA); pitch = 512; colbase = 256 * T + 64 * wc; }
                else if (T == 2) { dst = (h16_t*)(ws + WS_KA); pitch = 128; colbase = 64 * wc; }
                else if (T <= 6) { dst = (h16_t*)(ws + WS_QB); pitch = 512; colbase = 256 * (T - 5) + 64 * wc; }
                else { dst = (h16_t*)(ws + WS_KB); pitch = 512; colbase = 256 * (T - 7) + 64 * wc; }
                f32x4 gv[2][2];
#pragma unroll
                for (int bj = 0; bj < 2; ++bj)
#pragma unroll
                    for (int n = 0; n < 2; ++n) gv[bj][n] = *(const f32x4*)(gw + 32 * bj + 8 * fq + 4 * n) * (use8 ? SQK6 : 1.0f);
                const float sc = isQ ? C2 : 1.0f;
                const int pidx32 = ((fr | (fq << 4)) ^ 32) << 2, pidx16 = ((fr | (fq << 4)) ^ 16) << 2;
                const h16_t* tar = (const h16_t*)(ws + WS_TAR); const h16_t* tac = (const h16_t*)(ws + WS_TAC); const h16_t* tb = (const h16_t*)(ws + WS_TB);
                const int pitch6 = (pitch >> 6) * 48, hoff6 = (colbase >> 6) * 48;
                f32x4 ysv[4][2][2];
                extern __shared__ __attribute__((aligned(16))) unsigned char epi_lds_[];
                LAS unsigned char* stl = (LAS unsigned char*)epi_lds_ + pg8::STAGE_BYTES + (wr * 4 + wc) * 3072;
#pragma unroll
                for (int ai = 0; ai < 2; ++ai) {
#pragma unroll
                    for (int m = 0; m < 4; ++m) {
                        const int r = row0 + ai * 128 + m * 16, t = r & (SEQ - 1);
                        float ss = 0.f;
#pragma unroll
                        for (int bj = 0; bj < 2; ++bj)
#pragma unroll
                            for (int n = 0; n < 2; ++n) { const f32x4 v = acc[ai][bj][m][n]; ss += (v[0] * v[0] + v[1] * v[1]) + (v[2] * v[2] + v[3] * v[3]); }
                        ss = xsum16(ss); ss = xsum32(ss);
                        const float rs = __builtin_amdgcn_rsqf(ss * (wsc * wsc * (1.0f / 64.0f)) + EPS) * wsc;
                        f32x4 y[2][2];
#pragma unroll
                        for (int bj = 0; bj < 2; ++bj)
#pragma unroll
                            for (int n = 0; n < 2; ++n) y[bj][n] = acc[ai][bj][m][n] * rs * gv[bj][n];
                        if (isA) {
#pragma unroll
                            for (int bj = 0; bj < 2; ++bj) {
                                const int pos = bj == 0 ? (t >> 6) : (t & 63);
                                const h16_t* tp = (bj == 0 ? tar : tac) + pos * 32 + 8 * (fq & 1);
                                const u32x4 cw = *(const u32x4*)tp, sw = *(const u32x4*)(tp + 16);
                                const float sgn = fq < 2 ? -1.0f : 1.0f;
#pragma unroll
                                for (int n = 0; n < 2; ++n)
#pragma unroll
                                    for (int i = 0; i < 4; ++i) {
                                        const int e = 4 * n + i; const unsigned cwe = cw[e >> 1], swe = sw[e >> 1];
                                        const float cs = h2f((unsigned short)((e & 1) ? (cwe >> 16) : (cwe & 0xffffu))), sn = h2f((unsigned short)((e & 1) ? (swe >> 16) : (swe & 0xffffu)));
                                        const float yv = y[bj][n][i], pv = __uint_as_float((unsigned)__builtin_amdgcn_ds_bpermute(pidx32, (int)__float_as_uint(yv)));
                                        y[bj][n][i] = yv * cs + sgn * pv * sn;
                                    }
                            }
                        } else {
                            const h16_t* tp = tb + t * 16;
                            const u32x4 cw = *(const u32x4*)tp, sw = *(const u32x4*)(tp + 8);
                            const float sgn = fq == 0 ? -1.0f : 1.0f;
#pragma unroll
                            for (int n = 0; n < 2; ++n)
#pragma unroll
                                for (int i = 0; i < 4; ++i) {
                                    const int e = 4 * n + i; const unsigned cwe = cw[e >> 1], swe = sw[e >> 1];
                                    const float cs = h2f((unsigned short)((e & 1) ? (cwe >> 16) : (cwe & 0xffffu))), sn = h2f((unsigned short)((e & 1) ? (swe >> 16) : (swe & 0xffffu)));
                                    const float yv = y[0][n][i], pv = __uint_as_float((unsigned)__builtin_amdgcn_ds_bpermute(pidx16, (int)__float_as_uint(yv)));
                                    y[0][n][i] = fq < 2 ? (yv * cs + sgn * pv * sn) : yv;
                                }
                        }
#pragma unroll
                        for (int bj = 0; bj < 2; ++bj) {
                            if (use8) { ysv[m][bj][0] = y[bj][0]; ysv[m][bj][1] = y[bj][1];
                            } else {
                            u32x4 w; w.x = pk2h(y[bj][0][0] * sc, y[bj][0][1] * sc); w.y = pk2h(y[bj][0][2] * sc, y[bj][0][3] * sc); w.z = pk2h(y[bj][1][0] * sc, y[bj][1][1] * sc); w.w = pk2h(y[bj][1][2] * sc, y[bj][1][3] * sc);
                            *(u32x4*)(dst + (size_t)r * pitch + colbase + 32 * bj + 8 * fq) = w; }
                        }
                    }
                    if (use8) {
#pragma unroll
                        for (int bj = 0; bj < 2; ++bj) {
                            f32x16 s0, s1;
#pragma unroll
                            for (int i = 0; i < 16; ++i) { const int m_ = i >> 2, c0 = 2 * (i & 3); s0[i] = ysv[m_][bj][c0 >> 2][c0 & 3]; s1[i] = ysv[m_][bj][(c0 + 1) >> 2][(c0 + 1) & 3]; }
                            const i32x6 d6 = __builtin_amdgcn_cvt_scalef32_2xpk16_fp6_f32(s0, s1, 1.0f);
                            const int dwoff = fq == 0 ? 16 * bj : (fq == 1 ? 16 * bj + 8 : (fq == 2 ? 16 * bj + 12 : 36 + 8 * bj));
                            const int shoff = fq == 0 ? 16 * bj + 4 : (fq == 1 ? 16 * bj + 6 : (fq == 2 ? 32 + 8 * bj : 34 + 8 * bj));
#pragma unroll
                            for (int m = 0; m < 4; ++m) {
                                const unsigned a0 = (unsigned)d6[3 * (m >> 1)], a1 = (unsigned)d6[3 * (m >> 1) + 1], a2 = (unsigned)d6[3 * (m >> 1) + 2];
                                const unsigned lo = (m & 1) ? ((a1 >> 16) | (a2 << 16)) : a0, hi16 = (m & 1) ? (a2 >> 16) : (a1 & 0xffffu);
                                const unsigned dwv = (fq & 1) ? ((lo >> 16) | (hi16 << 16)) : lo, shv = (fq & 1) ? (lo & 0xffffu) : hi16;
                                LAS unsigned char* p6 = stl + (m * 16 + fr) * 48;
                                *(LAS unsigned*)(p6 + dwoff) = dwv; *(LAS unsigned short*)(p6 + shoff) = (unsigned short)shv;
                            }
                        }
                        asm volatile("s_waitcnt lgkmcnt(0)" ::: "memory");
                        {   const int lrow = fr + 16 * fq;
                            unsigned char* g6 = (unsigned char*)dst + (size_t)(u.pm * 256 + wr * 64 + ai * 128 + lrow) * pitch6 + hoff6;
#pragma unroll
                            for (int j = 0; j < 3; ++j) { const u32x4 v = *(const LAS u32x4*)(stl + lrow * 48 + 16 * j); *(u32x4*)(g6 + 16 * j) = v; }
                        }
                        asm volatile("s_waitcnt lgkmcnt(0)" ::: "memory");
                    }
                }
            } else if (use8) {
                unsigned char* vt; int drow0;
                if (T == 2) { vt = ws + WS_VTA; drow0 = (wc - 2) * 64; } else { vt = ws + WS_VTB; drow0 = (2 * (T - 9) + (wc >> 1)) * 128 + (wc & 1) * 64; }
                const int rows_per_b = (T == 2) ? 128 : 512;
                extern __shared__ __attribute__((aligned(16))) unsigned char epi_lds_[];
                LAS unsigned char* stl = (LAS unsigned char*)epi_lds_ + pg8::STAGE_BYTES + (wr * 4 + wc) * 3072;
#pragma unroll
                for (int ai = 0; ai < 2; ++ai) {
                    const int rt = u.pm * 256 + wr * 64 + ai * 128, b = rt >> 13, tk0 = rt & (SEQ - 1);
#pragma unroll
                    for (int bj = 0; bj < 2; ++bj) {
#pragma unroll
                        for (int m = 0; m < 4; ++m) {
                            const int tau = 16 * m + fr;
                            const int pos = 32 * ((tau >> 2) & 1) + 16 * (tau >> 5) + 4 * ((tau >> 3) & 3) + (tau & 3);
#pragma unroll
                            for (int n = 0; n < 2; ++n) { const f32x4 v = acc[ai][bj][m][n];
                                int w0 = 0; w0 = __builtin_amdgcn_cvt_pk_fp8_f32(v[0], v[1], w0, false); w0 = __builtin_amdgcn_cvt_pk_fp8_f32(v[2], v[3], w0, true);
#pragma unroll
                                for (int i = 0; i < 4; ++i) stl[(8 * fq + 4 * n + i) * 64 + pos] = (unsigned char)((unsigned)w0 >> (8 * i)); }
                        }
                        asm volatile("s_waitcnt lgkmcnt(0)" ::: "memory");
                        const int ln_ = fr + 16 * fq;
#pragma unroll
                        for (int j = 0; j < 2; ++j) { const int id = ln_ + 64 * j, dl = id >> 2, c16 = id & 3;
                            const u32x4 v = *(const LAS u32x4*)(stl + dl * 64 + 16 * c16);
                            *(u32x4*)(vt + ((size_t)(b * rows_per_b + drow0 + 32 * bj + dl)) * SEQ + tk0 + 16 * c16) = v; }
                        asm volatile("s_waitcnt lgkmcnt(0)" ::: "memory");
                    }
                }
            } else {
                h16_t* dst; int pitch, colbase;
                if (T == 2) { dst = (h16_t*)(ws + WS_VA); pitch = 128; colbase = 64 * (wc - 2); }
                else { dst = (h16_t*)(ws + WS_VB); pitch = 512; colbase = 256 * (T - 9) + 64 * wc; }
#pragma unroll
                for (int ai = 0; ai < 2; ++ai)
#pragma unroll
                    for (int m = 0; m < 4; ++m) {
                        const int r = row0 + ai * 128 + m * 16;
#pragma unroll
                        for (int bj = 0; bj < 2; ++bj) {
                            const f32x4 v0 = acc[ai][bj][m][0], v1 = acc[ai][bj][m][1];
                            u32x4 w; w.x = pk2h(v0[0], v0[1]); w.y = pk2h(v0[2], v0[3]); w.z = pk2h(v1[0], v1[1]); w.w = pk2h(v1[2], v1[3]);
                            *(u32x4*)(dst + (size_t)r * pitch + colbase + 32 * bj + 8 * fq) = w;
                        }
                    }
            }
        } else {
            if (T <= 12) {
                h16_t* oab = (h16_t*)(ws + WS_OAB);
                const int colt = (T >= 11 ? 512 + 256 * (T - 11) : 256 * (T - 3)) + 64 * wc;
#pragma unroll
                for (int aim = 0; aim < 4; ++aim) { const int ai = aim >> 1, m0 = (aim & 1) * 2;
                    u32x4 ovs[2][4][2];
#pragma unroll
                    for (int m = m0; m < m0 + 2; ++m)
#pragma unroll
                        for (int bj = 0; bj < 2; ++bj) ovs[ai][m][bj] = *(const u32x4*)(oab + (size_t)(row0 + ai * 128 + m * 16) * 1024 + colt + 16 * fq + 8 * bj);
                    __builtin_amdgcn_sched_barrier(0);
#pragma unroll
                    for (int m = m0; m < m0 + 2; ++m) {
                        const int r = row0 + ai * 128 + m * 16;
#pragma unroll
                        for (int bj = 0; bj < 2; ++bj) {
                            h16_t* p = oab + (size_t)r * 1024 + colt + 16 * fq + 8 * bj;
                            const u32x4 ov = ovs[ai][m][bj];
                            float o[8];
#pragma unroll
                            for (int e = 0; e < 4; ++e) { o[2 * e] = h2f((unsigned short)(ov[e] & 0xffffu)); o[2 * e + 1] = h2f((unsigned short)(ov[e] >> 16)); }
                            float q[8];
#pragma unroll
                            for (int n = 0; n < 2; ++n)
#pragma unroll
                                for (int i = 0; i < 4; ++i) q[4 * n + i] = o[4 * n + i] * silu_f(acc[ai][bj][m][n][i]);
                            u32x4 w; w.x = pk2h(q[0], q[1]); w.y = pk2h(q[2], q[3]); w.z = pk2h(q[4], q[5]); w.w = pk2h(q[6], q[7]);
                            *(u32x4*)p = w;
                        }
                    }
                    __builtin_amdgcn_sched_barrier(0);
                }
            } else {
                unsigned char* dst = ws + (T <= 16 ? WS_SGA : WS_SGB);
                const int colt = 256 * (T <= 16 ? T - 13 : T - 17) + 64 * wc;
#pragma unroll
                for (int ai = 0; ai < 2; ++ai)
#pragma unroll
                    for (int m = 0; m < 4; ++m) {
                        const int r = row0 + ai * 128 + m * 16;
                        u32x4 w;
#pragma unroll
                        for (int bj = 0; bj < 2; ++bj) {
                            const f32x4 v0 = acc[ai][bj][m][0], v1 = acc[ai][bj][m][1];
                            unsigned w0 = 0u, w1 = 0u;
#pragma unroll
                            for (int i = 0; i < 4; ++i) {
                                w0 = __builtin_amdgcn_cvt_pk_u8_f32(__builtin_amdgcn_rcpf(__builtin_fmaf(__builtin_amdgcn_exp2f(v0[i] * wsc), 1.0f / 255.0f, 1.0f / 255.0f)), i, w0);
                                w1 = __builtin_amdgcn_cvt_pk_u8_f32(__builtin_amdgcn_rcpf(__builtin_fmaf(__builtin_amdgcn_exp2f(v1[i] * wsc), 1.0f / 255.0f, 1.0f / 255.0f)), i, w1); }
                            w[2 * bj] = w0; w[2 * bj + 1] = w1;
                        }
                        *(u32x4*)(dst + (size_t)r * 1024 + colt + 16 * fq) = w;
                    }
            }
        }
    }
};
struct EpiMerge {
    static constexpr bool PERM = true;
    const unsigned char* SGA; const unsigned char* SGB; h16_t* MG;
    __device__ __forceinline__ void operator()(const f32x4 (&acc)[2][2][4][2], const pg8::Unit& u, int wr, int wc, int fr, int fq) const {
        asm volatile("" : "+v"(fr), "+v"(fq));
        const int row0 = u.pm * 256 + wr * 64 + fr, col0 = u.pn * 128 + wc * 32 + 8 * fq;
#pragma unroll
        for (int ai = 0; ai < 2; ++ai) {
            u32x2 gas[2][4], gbs[2][4];
#pragma unroll
            for (int m = 0; m < 4; ++m) { const size_t off = (size_t)(row0 + ai * 128 + m * 16) * 1024 + col0; gas[ai][m] = *(const u32x2*)(SGA + off); gbs[ai][m] = *(const u32x2*)(SGB + off); }
            __builtin_amdgcn_sched_barrier(0);
#pragma unroll
            for (int m = 0; m < 4; ++m) {
                const size_t off = (size_t)(row0 + ai * 128 + m * 16) * 1024 + col0;
                const u32x2 ga = gas[ai][m], gb = gbs[ai][m];
                float q[8];
#pragma unroll
                for (int e = 0; e < 8; ++e) {
                    const float a = (float)((ga[e >> 2] >> (8 * (e & 3))) & 0xffu), b = (float)((gb[e >> 2] >> (8 * (e & 3))) & 0xffu);
                    q[e] = (a * acc[ai][0][m][e >> 2][e & 3] + b * acc[ai][1][m][e >> 2][e & 3]) * (1.0f / 255.0f);
                }
                u32x4 w; w.x = pk2h(q[0], q[1]); w.y = pk2h(q[2], q[3]); w.z = pk2h(q[4], q[5]); w.w = pk2h(q[6], q[7]);
                *(u32x4*)(MG + off) = w;
            }
            __builtin_amdgcn_sched_barrier(0);
        }
    }
};
struct EpiOut {
    static constexpr bool PERM = false;
    const float* xp; long xs_delta; const float* gate; float* out;
    __device__ __forceinline__ void operator()(const f32x4 (&acc)[2][2][4][2], const pg8::Unit& u, int wr, int wc, int fr, int fq) const {
        asm volatile("" : "+v"(fr), "+v"(fq));
        const int row0 = u.pm * 256 + wr * 64 + fr, col0 = u.pn * 256 + wc * 32 + 4 * fq;
        const float* grow = gate + ((u.pm * 256) >> 13) * DM;
        f32x4 gvs[2][2];
#pragma unroll
        for (int bj = 0; bj < 2; ++bj)
#pragma unroll
            for (int n = 0; n < 2; ++n) gvs[bj][n] = *(const f32x4*)(grow + col0 + bj * 128 + n * 16);
#pragma unroll
        for (int aim = 0; aim < 4; ++aim) { const int ai = aim >> 1, m0 = (aim & 1) * 2;
            f32x4 xvs[4][2][2];
#pragma unroll
            for (int m = m0; m < m0 + 2; ++m) {
                const int r = row0 + ai * 128 + m * 16;
                const float* xrow = (const float*)((const char*)(xp + (size_t)r * DM) + (r >= TOKP ? xs_delta : 0l));
#pragma unroll
                for (int bj = 0; bj < 2; ++bj)
#pragma unroll
                    for (int n = 0; n < 2; ++n) xvs[m][bj][n] = *(const f32x4*)(xrow + col0 + bj * 128 + n * 16);
            }
            __builtin_amdgcn_sched_barrier(0);
#pragma unroll
            for (int m = m0; m < m0 + 2; ++m) {
                const int r = row0 + ai * 128 + m * 16;
#pragma unroll
                for (int bj = 0; bj < 2; ++bj)
#pragma unroll
                    for (int n = 0; n < 2; ++n) {
                        const int c = col0 + bj * 128 + n * 16;
                        *(f32x4*)(out + (size_t)r * DM + c) = xvs[m][bj][n] + gvs[bj][n] * acc[ai][bj][m][n];
                    }
            }
            __builtin_amdgcn_sched_barrier(0);
        }
    }
};

namespace att {
constexpr int NW = 8, QBLK = 32, QB = QBLK * NW, KVBLK = 64, NT = SEQ / KVBLK;
constexpr int NSLOT = 3, SLOTB = 8192;
constexpr int LDS_K = 0, LDS_V = NSLOT * SLOTB, LDS_WS = LDS_V + NSLOT * 2 * SLOTB, LDS_OST = LDS_WS + NW * 64 * 4, OST_WAVE = 8192, LDS_BYTES = LDS_OST + NW * OST_WAVE;
__device__ __forceinline__ int crow(int r, int hi) { return (r & 3) + 8 * (r >> 2) + 4 * hi; }
#define SBAR() __builtin_amdgcn_sched_barrier(0)
__device__ __forceinline__ void glds16(const void* gsrc, unsigned lds_dst) { unsigned keep;
    asm volatile("s_mov_b32 %0, m0\n\ts_mov_b32 m0, %2\n\ts_nop 0\n\tglobal_load_lds_dwordx4 %1, off\n\ts_mov_b32 m0, %0" : "=&s"(keep) : "v"(gsrc), "s"(lds_dst) : "memory"); }
__device__ __forceinline__ float max3f(float a, float b, float c) { float r; asm("v_max3_f32 %0, %1, %2, %3" : "=v"(r) : "v"(a), "v"(b), "v"(c)); return r; }
__device__ __forceinline__ float max2f(float a, float b) { float r; asm("v_max_f32_e32 %0, %1, %2" : "=v"(r) : "v"(a), "v"(b)); return r; }
__device__ __forceinline__ float fadd_s(float a, float b) { float r; asm("v_add_f32_e32 %0, %1, %2" : "=v"(r) : "v"(a), "v"(b)); return r; }
__device__ __forceinline__ float fsub_s(float a, float b) { float r; asm("v_sub_f32_e32 %0, %1, %2" : "=v"(r) : "v"(a), "v"(b)); return r; }
#define WAIT_BAR(N) asm volatile("s_waitcnt vmcnt(" #N ") lgkmcnt(0)\n\ts_barrier" ::: "memory")
__device__ __forceinline__ void qkt(f32x16& p0, f32x16& p1, const char* Kslot, const f16x8* qr, const f32x16& negm, int r32, int hi) {
    const char* kb = Kslot + hi * 1024 + r32 * 16;
#pragma unroll
    for (int d0 = 0; d0 < 4; ++d0) {
        const f16x8 b0 = *reinterpret_cast<const f16x8*>(kb + d0 * 2048);
        const f16x8 b1 = *reinterpret_cast<const f16x8*>(kb + d0 * 2048 + 512);
        if (d0 == 0) { p0 = MFMA32(b0, qr[0], negm); p1 = MFMA32(b1, qr[0], negm); }
        else { p0 = MFMA32(b0, qr[d0], p0); p1 = MFMA32(b1, qr[d0], p1); } }
}
typedef LAS const char* lds_cptr;
typedef short v4i16_t __attribute__((ext_vector_type(4)));
__device__ __forceinline__ void kload8(f16x8* kf, lds_cptr kp) {
    kf[0] = *(const LAS f16x8*)(kp);        kf[1] = *(const LAS f16x8*)(kp + 512);
    kf[2] = *(const LAS f16x8*)(kp + 2048); kf[3] = *(const LAS f16x8*)(kp + 2560);
    kf[4] = *(const LAS f16x8*)(kp + 4096); kf[5] = *(const LAS f16x8*)(kp + 4608);
    kf[6] = *(const LAS f16x8*)(kp + 6144); kf[7] = *(const LAS f16x8*)(kp + 6656);
}
__device__ __forceinline__ void kload2(f16x8* kf, lds_cptr kp, int j) { kf[2 * j] = *(const LAS f16x8*)(kp + j * 2048); kf[2 * j + 1] = *(const LAS f16x8*)(kp + j * 2048 + 512); }
__device__ __forceinline__ s16x4 vtr(lds_cptr p) { return __builtin_bit_cast(s16x4, __builtin_amdgcn_ds_read_tr16_b64_v4i16((LAS v4i16_t*)p)); }
__device__ __forceinline__ float rowmax(const f32x16& p0, const f32x16& p1) {
    float a = max3f(p0[0], p0[1], p1[0]), b = max3f(p0[2], p0[3], p1[1]); a = max3f(a, p1[2], p1[3]);
#pragma unroll
    for (int r = 4; r < 16; r += 4) { a = max3f(a, p0[r], p0[r + 1]); b = max3f(b, p0[r + 2], p0[r + 3]); a = max3f(a, p1[r], p1[r + 1]); b = max3f(b, p1[r + 2], p1[r + 3]); }
    const float m = max2f(a, b);
    auto rr = __builtin_amdgcn_permlane32_swap(__float_as_uint(m), __float_as_uint(m), false, false);
    return max2f(__uint_as_float(rr[0]), __uint_as_float(rr[1]));
}
__device__ __forceinline__ f16x8 mk8(s16x4 lo, s16x4 hi) { typedef short s16x8 __attribute__((ext_vector_type(8))); s16x8 v = {lo[0], lo[1], lo[2], lo[3], hi[0], hi[1], hi[2], hi[3]}; return __builtin_bit_cast(f16x8, v); }
__device__ __forceinline__ void pv(f32x16* o, int vb, f16x8 pa0, f16x8 pa1, f16x8 pa2, f16x8 pa3) {
#pragma unroll
    for (int d0 = 0; d0 < 2; ++d0) { s16x4 lo[4], hi[4];
#pragma unroll
        for (int ks = 0; ks < 4; ++ks) {
            asm volatile("ds_read_b64_tr_b16 %0,%1 offset:%c2" : "=&v"(lo[ks]) : "v"(vb), "i"(d0 * 4096 + ks * 1024) : "memory");
            asm volatile("ds_read_b64_tr_b16 %0,%1 offset:%c2" : "=&v"(hi[ks]) : "v"(vb), "i"(d0 * 4096 + ks * 1024 + 512) : "memory"); }
        asm volatile("s_waitcnt lgkmcnt(0)" ::: "memory"); SBAR();
        o[d0] = MFMA32(pa0, mk8(lo[0], hi[0]), o[d0]);
        o[d0] = MFMA32(pa1, mk8(lo[1], hi[1]), o[d0]);
        o[d0] = MFMA32(pa2, mk8(lo[2], hi[2]), o[d0]);
        o[d0] = MFMA32(pa3, mk8(lo[3], hi[3]), o[d0]);
    }
}
template <int THRL, bool FAST> __device__ __forceinline__ void attn_pass(const h16_t* Qw, int QP, const h16_t* Kh, int KP, const h16_t* Vh, int VP, char* shm, f32x16 (&o)[2], float& l_out, int wave_in) {
    int tid = wave_in * 64 + lane_id(); asm volatile("" : "+v"(tid));
    const int lane = tid & 63, r32 = lane & 31, hi = lane >> 5; const int wid = wave_in;
    const unsigned lds0 = (unsigned)(uintptr_t)shm;
    float* wsf = (float*)(shm + LDS_WS) + wid * 64;
    const h16_t* ksrc = Kh + (long)lane * KP + wid * 8;
    const h16_t* vsrc = Vh + (long)(16 * (wid & 3) + (lane >> 2)) * VP + (wid >> 2) * 32 + (lane & 3) * 8;
    const unsigned kdst = lds0 + LDS_K + wid * 1024, vdst = lds0 + LDS_V + wid * 1024;
#define DMA_K(t, slot) glds16(ksrc + (long)(t) * KVBLK * KP, (unsigned)__builtin_amdgcn_readfirstlane(kdst + (slot)))
#define DMA_V(t, slot) glds16(vsrc + (long)(t) * KVBLK * VP, (unsigned)__builtin_amdgcn_readfirstlane(vdst + (slot)))
    const int vb0 = (int)(lds0 + LDS_V) + ((lane >> 4) & 1) * 32 + (lane & 3) * 8 + (4 * hi + ((lane & 15) >> 2)) * 64;
    const char* Kbase = shm + LDS_K; f16x8 kf[8];
    const lds_cptr shm3 = (lds_cptr)shm; const lds_cptr kp0 = shm3 + LDS_K + hi * 1024 + r32 * 16; const lds_cptr vp0 = shm3 + LDS_V + ((lane >> 4) & 1) * 32 + (lane & 3) * 8 + (4 * hi + ((lane & 15) >> 2)) * 64;
    DMA_K(0, 0); DMA_V(0, 0); DMA_K(1, SLOTB);
    f16x8 qr[4];
#pragma unroll
    for (int d0 = 0; d0 < 4; ++d0) qr[d0] = *reinterpret_cast<const f16x8*>(&Qw[(long)r32 * QP + d0 * 16 + hi * 8]);
    float mhat = 0.f, l_reg = 0.f; o[0] = f32x16{}; o[1] = f32x16{}; f32x16 negm = f32x16{}; if constexpr (!FAST) asm volatile("" : "+v"(negm));
    bool resc = false;
#define NEGM (FAST ? f32x16{} : negm)
#define START(P0, P1) do { if constexpr (!FAST) { const float rm = rowmax(P0, P1); resc = false; \
    { const float dl = rm; mhat = fadd_s(mhat, dl); \
      _Pragma("unroll") for (int r = 0; r < 16; ++r) { P0[r] = fsub_s(P0[r], dl); P1[r] = fsub_s(P1[r], dl); } \
      _Pragma("unroll") for (int r = 0; r < 16; ++r) negm[r] = -mhat; asm volatile("" : "+v"(negm)); } } \
    _Pragma("unroll") for (int r = 0; r < 16; ++r) P0[r] = __builtin_amdgcn_exp2f(P0[r]); } while (0)
#define RESC() do { if constexpr (!FAST) { if (resc) { asm volatile("s_waitcnt lgkmcnt(0)" ::: "memory"); \
      _Pragma("unroll") for (int d_ = 0; d_ < 2; ++d_) _Pragma("unroll") for (int r = 0; r < 16; ++r) o[d_][r] *= wsf[crow(r, hi)]; } } } while (0)
    f32x16 pA0, pA1, pB0, pB1;
    int sl_prev = 0, sl_cur = 0, sl_next = SLOTB;
#define ROT() do { sl_prev = sl_cur; sl_cur = sl_next; sl_next = (sl_next == (NSLOT - 1) * SLOTB) ? 0 : sl_next + SLOTB; } while (0)
    DMA_K(2, 2 * SLOTB);
    WAIT_BAR(3);
    qkt(pA0, pA1, Kbase, qr, NEGM, r32, hi); asm volatile("s_nop 15\n\ts_nop 7" : "+v"(pA0), "+v"(pA1));
    START(pA0, pA1);
    _Pragma("unroll") for (int r = 0; r < 16; ++r) pA1[r] = __builtin_amdgcn_exp2f(pA1[r]);
    WAIT_BAR(0);
    DMA_K(3, 0); DMA_V(1, SLOTB);
    ROT();
    kload8(kf, kp0 + sl_cur);
    WAIT_BAR(2);
    s16x4 vlo[8], vhi[8]; u32x4 pw0, pw1, pw2, pw3;
#define PKW(P, B) pk2h(P[B], P[B + 1])
#define PAF(k) __builtin_bit_cast(f16x8, pw##k)
#define VFR(i) mk8(vlo[i], vhi[i])
#define PIN(x) asm volatile("" : "+v"(x))
#define MX3(a, b, c) __builtin_fmaxf(__builtin_fmaxf((a), (b)), (c))
#define GAPA(MF, A0, A1, A2, A3, W0, W1, PW) do { MF; sacc += A0; sacc += A1; sacc += A2; sacc += A3; PIN(sacc); W0; W1; PIN(PW); SBAR(); } while (0)
#define EX(v) __builtin_amdgcn_exp2f(v)
#define GAPB(MF, X, B) do { MF; X[B] = EX(X[B]); X[B + 1] = EX(X[B + 1]); X[B + 2] = EX(X[B + 2]); X[B + 3] = EX(X[B + 3]); PIN(X); SBAR(); } while (0)
#define VRD(i) do { vlo[i] = vtr(vp_ + (((i) >> 2) * 4096 + ((i) & 3) * 1024)); vhi[i] = vtr(vp_ + (((i) >> 2) * 4096 + ((i) & 3) * 1024 + 512)); } while (0)
#define KRD(G, j) do { if (G) { kload2(kf, kp0 + sl_next, j); SBAR(); } } while (0)
#define STEP(C0, C1, P0, P1, t, GK, GV, GL) do { SBAR(); \
    const lds_cptr vp_ = vp0 + sl_prev; \
    if constexpr (FAST) { if (GK) { DMA_K((t) + 3, sl_cur); } } \
    VRD(0); SBAR(); float sacc = (P0[0] + P0[1]); \
    GAPA(C0 = MFMA32(kf[0], qr[0], NEGM), P0[2], P0[3], P0[4], P0[5],     pw0[0] = PKW(P0, 0), pw0[1] = PKW(P0, 2), pw0); \
    if constexpr (FAST) { if (GV) { DMA_V((t) + 1, sl_next); } } \
    VRD(4); SBAR(); GAPA(C1 = MFMA32(kf[1], qr[0], NEGM), P0[6], P0[7], P0[8], P0[9],     pw0[2] = PKW(P0, 4), pw0[3] = PKW(P0, 6), pw0); \
    VRD(1); SBAR(); GAPA(C0 = MFMA32(kf[2], qr[1], C0),   P0[10], P0[11], P0[12], P0[13], pw1[0] = PKW(P0, 8), pw1[1] = PKW(P0, 10), pw1); \
    VRD(5); SBAR(); GAPA(C1 = MFMA32(kf[3], qr[1], C1),   P0[14], P0[15], P1[0], P1[1],   pw1[2] = PKW(P0, 12), pw1[3] = PKW(P0, 14), pw1); \
    VRD(2); SBAR(); GAPA(C0 = MFMA32(kf[4], qr[2], C0),   P1[2], P1[3], P1[4], P1[5],     pw2[0] = PKW(P1, 0), pw2[1] = PKW(P1, 2), pw2); \
    VRD(6); SBAR(); GAPA(C1 = MFMA32(kf[5], qr[2], C1),   P1[6], P1[7], P1[8], P1[9],     pw2[2] = PKW(P1, 4), pw2[3] = PKW(P1, 6), pw2); \
    VRD(3); SBAR(); GAPA(C0 = MFMA32(kf[6], qr[3], C0),   P1[10], P1[11], P1[12], P1[13], pw3[0] = PKW(P1, 8), pw3[1] = PKW(P1, 10), pw3); \
    VRD(7); SBAR(); GAPA(C1 = MFMA32(kf[7], qr[3], C1),   P1[14], P1[15], 0.f, 0.f,       pw3[2] = PKW(P1, 12), pw3[3] = PKW(P1, 14), pw3); \
    l_reg += sacc; \
    if constexpr (!FAST) { \
    if (GK) { DMA_K((t) + 3, sl_cur); } if (GV) { DMA_V((t) + 1, sl_next); } \
    { float a = MX3(C0[0], C0[1], C1[0]), b = MX3(C0[2], C0[3], C1[1]); a = MX3(a, C1[2], C1[3]); \
      _Pragma("unroll") for (int r = 4; r < 16; r += 4) { a = MX3(a, C0[r], C0[r + 1]); b = MX3(b, C0[r + 2], C0[r + 3]); a = MX3(a, C1[r], C1[r + 1]); b = MX3(b, C1[r + 2], C1[r + 3]); } \
      float rm = __builtin_fmaxf(a, b); { auto rr = __builtin_amdgcn_permlane32_swap(__float_as_uint(rm), __float_as_uint(rm), false, false); rm = __builtin_fmaxf(__uint_as_float(rr[0]), __uint_as_float(rr[1])); } \
      resc = false; \
      if (__builtin_expect(__any(rm > (float)THRL), 0)) { const float dl = __builtin_fmaxf(rm, 0.f); mhat += dl; \
        _Pragma("unroll") for (int r = 0; r < 16; ++r) { C0[r] -= dl; C1[r] -= dl; } \
        _Pragma("unroll") for (int r = 0; r < 16; ++r) negm[r] = -mhat; asm volatile("" : "+v"(negm)); \
        const float f = __builtin_amdgcn_exp2f(-dl); l_reg *= f; if (hi == 0) wsf[r32] = f; resc = true; } } } \
    SBAR(); \
    GAPB(o[0] = MFMA32(PAF(0), VFR(0), o[0]), C0, 0); \
    GAPB(o[1] = MFMA32(PAF(0), VFR(4), o[1]), C0, 4); \
    KRD(GL, 0); GAPB(o[0] = MFMA32(PAF(1), VFR(1), o[0]), C0, 8); \
    KRD(GL, 1); GAPB(o[1] = MFMA32(PAF(1), VFR(5), o[1]), C0, 12); \
    KRD(GL, 2); GAPB(o[0] = MFMA32(PAF(2), VFR(2), o[0]), C1, 0); \
    KRD(GL, 3); GAPB(o[1] = MFMA32(PAF(2), VFR(6), o[1]), C1, 4); \
    GAPB(o[0] = MFMA32(PAF(3), VFR(3), o[0]), C1, 8); \
    GAPB(o[1] = MFMA32(PAF(3), VFR(7), o[1]), C1, 12); \
    } while (0)
    int t = 1;
    for (; t + 5 < NT; t += 2) {
        STEP(pB0, pB1, pA0, pA1, t, true, true, true);     WAIT_BAR(2); RESC(); ROT();
        STEP(pA0, pA1, pB0, pB1, t + 1, true, true, true); WAIT_BAR(2); RESC(); ROT();
    }
#define ENDW(tt) do { if ((tt) + 3 < NT) { WAIT_BAR(2); } else if ((tt) + 2 < NT) { WAIT_BAR(1); } else { WAIT_BAR(0); } } while (0)
    for (; t + 1 < NT; t += 2) {
        STEP(pB0, pB1, pA0, pA1, t, (t + 3 < NT), (t + 1 < NT), (t + 1 < NT));         ENDW(t);     RESC(); ROT();
        STEP(pA0, pA1, pB0, pB1, t + 1, (t + 4 < NT), (t + 2 < NT), (t + 2 < NT));     ENDW(t + 1); RESC(); ROT();
    }
    STEP(pB0, pB1, pA0, pA1, NT - 1, false, false, false); RESC();
    { float sacc = pB0[0] + pB0[1]; _Pragma("unroll") for (int r = 2; r < 16; ++r) sacc += pB0[r]; _Pragma("unroll") for (int r = 0; r < 16; ++r) sacc += pB1[r]; l_reg += sacc;
      pw0 = (u32x4){PKW(pB0, 0), PKW(pB0, 2), PKW(pB0, 4), PKW(pB0, 6)}; pw1 = (u32x4){PKW(pB0, 8), PKW(pB0, 10), PKW(pB0, 12), PKW(pB0, 14)}; pw2 = (u32x4){PKW(pB1, 0), PKW(pB1, 2), PKW(pB1, 4), PKW(pB1, 6)}; pw3 = (u32x4){PKW(pB1, 8), PKW(pB1, 10), PKW(pB1, 12), PKW(pB1, 14)};
      SBAR(); pv(o, vb0 + sl_cur, PAF(0), PAF(1), PAF(2), PAF(3)); }
#undef PKW
#undef PAF
#undef VFR
#undef PIN
#undef MX3
#undef GAPA
#undef GAPB
#undef EX
#undef VRD
#undef KRD
#undef STEP
#undef ENDW
    { auto rr = __builtin_amdgcn_permlane32_swap(__float_as_uint(l_reg), __float_as_uint(l_reg), false, false); l_reg = __uint_as_float(rr[0]) + __uint_as_float(rr[1]); }
    l_out = l_reg;
    asm volatile("s_waitcnt lgkmcnt(0)\n\ts_barrier" ::: "memory");
#undef DMA_K
#undef DMA_V
#undef START
#undef NEGM
#undef RESC
#undef ROT
}

__device__ __forceinline__ void pv128(f32x16* o, int vb, f16x8 pa0, f16x8 pa1, f16x8 pa2, f16x8 pa3) {
#pragma unroll
    for (int d0 = 0; d0 < 4; ++d0) { s16x4 lo[4], hi[4];
#pragma unroll
        for (int ks = 0; ks < 4; ++ks) {
            asm volatile("ds_read_b64_tr_b16 %0,%1 offset:%c2" : "=&v"(lo[ks]) : "v"(vb), "i"(d0 * 4096 + ks * 1024) : "memory");
            asm volatile("ds_read_b64_tr_b16 %0,%1 offset:%c2" : "=&v"(hi[ks]) : "v"(vb), "i"(d0 * 4096 + ks * 1024 + 512) : "memory"); }
        asm volatile("s_waitcnt lgkmcnt(0)" ::: "memory"); SBAR();
        o[d0] = MFMA32(pa0, mk8(lo[0], hi[0]), o[d0]);
        o[d0] = MFMA32(pa1, mk8(lo[1], hi[1]), o[d0]);
        o[d0] = MFMA32(pa2, mk8(lo[2], hi[2]), o[d0]);
        o[d0] = MFMA32(pa3, mk8(lo[3], hi[3]), o[d0]);
    }
}
template <int THRL, bool FAST> __device__ __forceinline__ void attn_pass128(const h16_t* Qw, int QP, const h16_t* Kh, int KP, const h16_t* Vh, int VP, char* shm, f32x16 (&o)[4], float& l_out, int wave_in) {
    int tid = wave_in * 64 + lane_id(); asm volatile("" : "+v"(tid));
    const int lane = tid & 63, r32 = lane & 31, hi = lane >> 5; const int wid = wave_in;
    const unsigned lds0 = (unsigned)(uintptr_t)shm;
    float* wsf = (float*)(shm + LDS_WS) + wid * 64;
    const h16_t* ksrc = Kh + (long)lane * KP + wid * 8;
    const h16_t* vsrc = Vh + (long)(16 * (wid & 3) + (lane >> 2)) * VP + (wid >> 2) * 32 + (lane & 3) * 8;
    const unsigned kdst = lds0 + LDS_K + wid * 1024, vdst = lds0 + LDS_V + wid * 1024;
#define DMA_K(t, slot) glds16(ksrc + (long)(t) * KVBLK * KP, (unsigned)__builtin_amdgcn_readfirstlane(kdst + (slot)))
#define DMA_V(t, slot) do { glds16(vsrc + (long)(t) * KVBLK * VP, (unsigned)__builtin_amdgcn_readfirstlane(vdst + (slot))); glds16(vsrc + (long)(t) * KVBLK * VP + 64, (unsigned)__builtin_amdgcn_readfirstlane(vdst + (slot) + 8192)); } while (0)
    const int vb0 = (int)(lds0 + LDS_V) + ((lane >> 4) & 1) * 32 + (lane & 3) * 8 + (4 * hi + ((lane & 15) >> 2)) * 64;
    const char* Kbase = shm + LDS_K; f16x8 kf[8];
    const lds_cptr shm3 = (lds_cptr)shm; const lds_cptr kp0 = shm3 + LDS_K + hi * 1024 + r32 * 16; const lds_cptr vp0 = shm3 + LDS_V + ((lane >> 4) & 1) * 32 + (lane & 3) * 8 + (4 * hi + ((lane & 15) >> 2)) * 64;
    DMA_K(0, 0); DMA_V(0, 0); DMA_K(1, SLOTB);
    f16x8 qr[4];
#pragma unroll
    for (int d0 = 0; d0 < 4; ++d0) qr[d0] = *reinterpret_cast<const f16x8*>(&Qw[(long)r32 * QP + d0 * 16 + hi * 8]);
    float mhat = 0.f, l_reg = 0.f; o[0] = f32x16{}; o[1] = f32x16{}; o[2] = f32x16{}; o[3] = f32x16{}; f32x16 negm = f32x16{}; if constexpr (!FAST) asm volatile("" : "+v"(negm));
    bool resc = false;
#define NEGM (FAST ? f32x16{} : negm)
#define RESC() do { if constexpr (!FAST) if (resc) { asm volatile("s_waitcnt lgkmcnt(0)" ::: "memory"); \
      _Pragma("unroll") for (int d_ = 0; d_ < 4; ++d_) _Pragma("unroll") for (int r = 0; r < 16; ++r) o[d_][r] *= wsf[crow(r, hi)]; } } while (0)
    f32x16 C0, C1; u32x4 pA0, pA1, pA2, pA3, pB0, pB1, pB2, pB3;
    int sl_prev = 0, sl_cur = 0, sl_next = SLOTB;
#define ROT() do { sl_prev = sl_cur; sl_cur = sl_next; sl_next = (sl_next == (NSLOT - 1) * SLOTB) ? 0 : sl_next + SLOTB; } while (0)
    DMA_K(2, 2 * SLOTB);
    WAIT_BAR(3);
    qkt(C0, C1, Kbase, qr, NEGM, r32, hi); asm volatile("s_nop 15\n\ts_nop 7" : "+v"(C0), "+v"(C1));
    { float rm = 0.f; if constexpr (!FAST) { rm = rowmax(C0, C1); mhat = rm; }
      _Pragma("unroll") for (int r = 0; r < 16; ++r) { C0[r] = __builtin_amdgcn_exp2f(C0[r] - rm); C1[r] = __builtin_amdgcn_exp2f(C1[r] - rm); }
      if constexpr (!FAST) { _Pragma("unroll") for (int r = 0; r < 16; ++r) negm[r] = -mhat; asm volatile("" : "+v"(negm)); }
      float sacc = 0.f; _Pragma("unroll") for (int r = 0; r < 16; ++r) sacc += C0[r] + C1[r]; l_reg = sacc;
      pA0 = (u32x4){pk2h(C0[0], C0[1]), pk2h(C0[2], C0[3]), pk2h(C0[4], C0[5]), pk2h(C0[6], C0[7])}; pA1 = (u32x4){pk2h(C0[8], C0[9]), pk2h(C0[10], C0[11]), pk2h(C0[12], C0[13]), pk2h(C0[14], C0[15])};
      pA2 = (u32x4){pk2h(C1[0], C1[1]), pk2h(C1[2], C1[3]), pk2h(C1[4], C1[5]), pk2h(C1[6], C1[7])}; pA3 = (u32x4){pk2h(C1[8], C1[9]), pk2h(C1[10], C1[11]), pk2h(C1[12], C1[13]), pk2h(C1[14], C1[15])}; }
    WAIT_BAR(0);
    DMA_K(3, 0); DMA_V(1, 2 * SLOTB);
    ROT();
    kload8(kf, kp0 + sl_cur);
    WAIT_BAR(3);
    s16x4 vlo[16], vhi[16];
#define PAFW(w) __builtin_bit_cast(f16x8, w)
#define VFR(i) mk8(vlo[i], vhi[i])
#define PIN(x) asm volatile("" : "+v"(x))
#define MX3(a, b, c) __builtin_fmaxf(__builtin_fmaxf((a), (b)), (c))
#define EX(v) __builtin_amdgcn_exp2f(v)
#define VRD(i) do { vlo[i] = vtr(vp_ + (((i) >> 2) * 4096 + ((i) & 3) * 1024)); vhi[i] = vtr(vp_ + (((i) >> 2) * 4096 + ((i) & 3) * 1024 + 512)); } while (0)
#define KRD(G, j) do { if (G) { kload2(kf, kp0 + sl_next, j); } } while (0)
#define QK1(PRE, CC, KF, QR, CI) do { PRE; SBAR(); CC = MFMA32(KF, QR, CI); SBAR(); } while (0)
#define NOP_ do { } while (0)
#define GB0(PRE, OA, PW, FI, X, B) do { PRE; SBAR(); OA = MFMA32(PAFW(PW), VFR(FI), OA); X[B] = EX(X[B]); X[B + 1] = EX(X[B + 1]); PIN(X); SBAR(); } while (0)
#define GB(PRE, OA, PW, FI, X, B, Y, YB, PN, W) do { PRE; SBAR(); OA = MFMA32(PAFW(PW), VFR(FI), OA); X[B] = EX(X[B]); X[B + 1] = EX(X[B + 1]); PIN(X); \
    sacc += Y[YB]; sacc += Y[YB + 1]; PN[W] = pk2h(Y[YB], Y[YB + 1]); PIN(sacc); PIN(PN); SBAR(); } while (0)
#define STEP128(PC0, PC1, PC2, PC3, PN0, PN1, PN2, PN3, t, GK, GV, GL) do { SBAR(); \
    const lds_cptr vp_ = vp0 + 2 * sl_prev; \
    QK1(if constexpr (FAST) { if (GK) { DMA_K((t) + 3, sl_cur); } }, C0, kf[0], qr[0], NEGM); \
    QK1(if constexpr (FAST) { if (GV) { DMA_V((t) + 1, 2 * sl_next); } }, C1, kf[1], qr[0], NEGM); \
    QK1(NOP_,    C0, kf[2], qr[1], C0); \
    QK1(NOP_,    C1, kf[3], qr[1], C1); \
    QK1(VRD(0),  C0, kf[4], qr[2], C0); \
    QK1(VRD(4),  C1, kf[5], qr[2], C1); \
    QK1(VRD(8),  C0, kf[6], qr[3], C0); \
    QK1(VRD(12), C1, kf[7], qr[3], C1); \
    if constexpr (!FAST) { \
    if (GK) { DMA_K((t) + 3, sl_cur); } if (GV) { DMA_V((t) + 1, 2 * sl_next); } \
    { float a = MX3(C0[0], C0[1], C1[0]), b = MX3(C0[2], C0[3], C1[1]); a = MX3(a, C1[2], C1[3]); \
      _Pragma("unroll") for (int r = 4; r < 16; r += 4) { a = MX3(a, C0[r], C0[r + 1]); b = MX3(b, C0[r + 2], C0[r + 3]); a = MX3(a, C1[r], C1[r + 1]); b = MX3(b, C1[r + 2], C1[r + 3]); } \
      float rm = __builtin_fmaxf(a, b); { auto rr = __builtin_amdgcn_permlane32_swap(__float_as_uint(rm), __float_as_uint(rm), false, false); rm = __builtin_fmaxf(__uint_as_float(rr[0]), __uint_as_float(rr[1])); } \
      resc = false; \
      if (__builtin_expect(__any(rm > (float)THRL), 0)) { const float dl = __builtin_fmaxf(rm, 0.f); mhat += dl; \
        _Pragma("unroll") for (int r = 0; r < 16; ++r) { C0[r] -= dl; C1[r] -= dl; } \
        _Pragma("unroll") for (int r = 0; r < 16; ++r) negm[r] = -mhat; asm volatile("" : "+v"(negm)); \
        const float f = __builtin_amdgcn_exp2f(-dl); l_reg *= f; if (hi == 0) wsf[r32] = f; resc = true; } } } \
    SBAR(); float sacc = 0.f; \
    GB0(VRD(1),  o[0], PC0, 0,  C0, 0); \
    GB(VRD(5),   o[1], PC0, 4,  C0, 2,  C0, 0,  PN0, 0); \
    GB(VRD(9),   o[2], PC0, 8,  C0, 4,  C0, 2,  PN0, 1); \
    GB(VRD(13),  o[3], PC0, 12, C0, 6,  C0, 4,  PN0, 2); \
    GB(VRD(2),   o[0], PC1, 1,  C0, 8,  C0, 6,  PN0, 3); \
    GB(VRD(6),   o[1], PC1, 5,  C0, 10, C0, 8,  PN1, 0); \
    GB(VRD(10),  o[2], PC1, 9,  C0, 12, C0, 10, PN1, 1); \
    GB(VRD(14),  o[3], PC1, 13, C0, 14, C0, 12, PN1, 2); \
    GB(VRD(3),   o[0], PC2, 2,  C1, 0,  C0, 14, PN1, 3); \
    GB(VRD(7),   o[1], PC2, 6,  C1, 2,  C1, 0,  PN2, 0); \
    GB(VRD(11),  o[2], PC2, 10, C1, 4,  C1, 2,  PN2, 1); \
    GB(VRD(15),  o[3], PC2, 14, C1, 6,  C1, 4,  PN2, 2); \
    GB(KRD(GL, 0), o[0], PC3, 3,  C1, 8,  C1, 6,  PN2, 3); \
    GB(KRD(GL, 1), o[1], PC3, 7,  C1, 10, C1, 8,  PN3, 0); \
    GB(KRD(GL, 2), o[2], PC3, 11, C1, 12, C1, 10, PN3, 1); \
    GB(KRD(GL, 3), o[3], PC3, 15, C1, 14, C1, 12, PN3, 2); \
    sacc += C1[14]; sacc += C1[15]; PN3[3] = pk2h(C1[14], C1[15]); l_reg += sacc; \
    } while (0)
    int t = 1;
    for (; t + 5 < NT; t += 2) {
        STEP128(pA0, pA1, pA2, pA3, pB0, pB1, pB2, pB3, t, true, true, true);     WAIT_BAR(3); RESC(); ROT();
        STEP128(pB0, pB1, pB2, pB3, pA0, pA1, pA2, pA3, t + 1, true, true, true); WAIT_BAR(3); RESC(); ROT();
    }
#define ENDW(tt) do { if ((tt) + 3 < NT) { WAIT_BAR(3); } else if ((tt) + 2 < NT) { WAIT_BAR(2); } else { WAIT_BAR(0); } } while (0)
    for (; t + 1 < NT; t += 2) {
        STEP128(pA0, pA1, pA2, pA3, pB0, pB1, pB2, pB3, t, (t + 3 < NT), (t + 1 < NT), (t + 1 < NT));         ENDW(t);     RESC(); ROT();
        STEP128(pB0, pB1, pB2, pB3, pA0, pA1, pA2, pA3, t + 1, (t + 4 < NT), (t + 2 < NT), (t + 2 < NT));     ENDW(t + 1); RESC(); ROT();
    }
    STEP128(pA0, pA1, pA2, pA3, pB0, pB1, pB2, pB3, NT - 1, false, false, false); RESC();
    SBAR(); pv128(o, vb0 + 2 * sl_cur, PAFW(pB0), PAFW(pB1), PAFW(pB2), PAFW(pB3));
#undef PAFW
#undef VFR
#undef PIN
#undef MX3
#undef EX
#undef VRD
#undef KRD
#undef QK1
#undef NOP_
#undef GB0
#undef GB
#undef STEP128
#undef ENDW
    { auto rr = __builtin_amdgcn_permlane32_swap(__float_as_uint(l_reg), __float_as_uint(l_reg), false, false); l_reg = __uint_as_float(rr[0]) + __uint_as_float(rr[1]); }
    l_out = l_reg;
    asm volatile("s_waitcnt lgkmcnt(0)\n\ts_barrier" ::: "memory");
#undef DMA_K
#undef DMA_V
#undef NEGM
#undef RESC
#undef ROT
}

typedef int v8i __attribute__((ext_vector_type(8)));
#define MFMA8(a, b, c) __builtin_amdgcn_mfma_scale_f32_32x32x64_f8f6f4(a, b, c, 0, 0, 0, 0, 0, 0)
#define MFMA8S(a, b, c) __builtin_amdgcn_mfma_scale_f32_16x16x128_f8f6f4(a, b, c, 0, 0, 0, 0, 0, 0)
#define MFMA6(a, b, c) __builtin_amdgcn_mfma_scale_f32_32x32x64_f8f6f4(a, b, c, 2, 2, 0, sc6, 0, sc6)
__device__ __forceinline__ v8i ld24(lds_cptr p16, lds_cptr p8) { const u32x4 a = *(const LAS u32x4*)p16; const u32x2 b = *(const LAS u32x2*)p8; return (v8i){(int)a.x, (int)a.y, (int)a.z, (int)a.w, (int)b.x, (int)b.y, 0, 0}; }
__device__ __forceinline__ v8i ld32(lds_cptr p0, lds_cptr p1) { const u32x4 a = *(const LAS u32x4*)p0, b = *(const LAS u32x4*)p1; return (v8i){(int)a.x, (int)a.y, (int)a.z, (int)a.w, (int)b.x, (int)b.y, (int)b.z, (int)b.w}; }
template <int NV> __device__ __forceinline__ void attn_first_dma(const unsigned char* Kh8, int KP, const unsigned char* VT, char* shm, int wave_in) {
    int tid = wave_in * 64 + lane_id(); asm volatile("" : "+v"(tid));
    const int lane = tid & 63, wid = wave_in; const bool kw = wid < 4, kwk = wid < 3;
    const unsigned lds0 = (unsigned)(uintptr_t)shm; constexpr int VCH = NV * 512;
    const unsigned char* ksrc = Kh8 + (long)lane * KP + (wid & 3) * 16;
    const unsigned char* vsrc = VT + (long)(lane + ((kw && NV == 4) ? 64 : 0)) * SEQ + (wid & 3) * 16;
    const unsigned kdst = lds0 + LDS_K + (wid & 3) * 1024, vdst = lds0 + LDS_V + (wid & 3) * VCH + ((kw && NV == 4) ? 1024 : 0);
    if (kwk) glds16(ksrc, (unsigned)__builtin_amdgcn_readfirstlane(kdst));
    if (!kw || NV == 4) glds16(vsrc, (unsigned)__builtin_amdgcn_readfirstlane(vdst));
    if (kwk) { glds16(ksrc + (long)KVBLK * KP, (unsigned)__builtin_amdgcn_readfirstlane(kdst + SLOTB)); glds16(ksrc + (long)2 * KVBLK * KP, (unsigned)__builtin_amdgcn_readfirstlane(kdst + 2 * SLOTB)); }
}
template <int NV> __device__ __forceinline__ void attn_pass8(const unsigned char* Qw8, int QP, const unsigned char* Kh8, int KP, const unsigned char* VT, int mI, char* shm, f32x16 (&o)[NV], float& l_out, int wave_in, bool pre = false) {
    int tid = wave_in * 64 + lane_id(); asm volatile("" : "+v"(tid));
    const int lane = tid & 63, r32 = lane & 31, hi = lane >> 5; const int wid = wave_in;
    const unsigned lds0 = (unsigned)(uintptr_t)shm;
    constexpr int VCH = NV * 512;
    const bool kw = wid < 4, kwk = wid < 3;
    const unsigned char* ksrc = Kh8 + (long)lane * KP + (wid & 3) * 16;
    const unsigned char* vsrc = VT + (long)(lane + ((kw && NV == 4) ? 64 : 0)) * SEQ + (wid & 3) * 16;
    const unsigned kdst = lds0 + LDS_K + (wid & 3) * 1024, vdst = lds0 + LDS_V + (wid & 3) * VCH + ((kw && NV == 4) ? 1024 : 0);
#define DMA_K8(t, slot) do { if (kwk) glds16(ksrc + (long)(t) * KVBLK * KP, (unsigned)__builtin_amdgcn_readfirstlane(kdst + (slot))); } while (0)
#define DMA_V8(t, slot) do { if (!kw || NV == 4) glds16(vsrc + (t) * KVBLK, (unsigned)__builtin_amdgcn_readfirstlane(vdst + (slot))); } while (0)
#define OWN_BAR() do { if (kwk && NV == 4) { WAIT_BAR(2); } else { WAIT_BAR(1); } } while (0)
    const lds_cptr shm3 = (lds_cptr)shm;
    const lds_cptr kp0 = shm3 + LDS_K + hi * 1024 + r32 * 16, kq0 = shm3 + LDS_K + 2048 + r32 * 16 + 8 * hi;
    const lds_cptr vp0 = shm3 + LDS_V + (2 * hi) * VCH + r32 * 16;
    if (!pre) { DMA_K8(0, 0); DMA_V8(0, 0); DMA_K8(1, SLOTB); DMA_K8(2, 2 * SLOTB); }
    v8i q8; { const u32x4 a = *(const u32x4*)(Qw8 + (long)r32 * QP + 16 * hi); const u32x2 b = *(const u32x2*)(Qw8 + (long)r32 * QP + 32 + 8 * hi); q8 = (v8i){(int)a.x, (int)a.y, (int)a.z, (int)a.w, (int)b.x, (int)b.y, 0, 0}; }
    float l_reg = 0.f;
#pragma unroll
    for (int d = 0; d < NV; ++d) o[d] = f32x16{};
    f32x16 cinit; { int mI_ = mI; asm volatile("" : "+s"(mI_)); float cv = 8.0f * (float)(7 - mI_) * (1.0f / 65536.0f); asm volatile("" : "+v"(cv));
#pragma unroll
        for (int r = 0; r < 16; ++r) cinit[r] = cv; }
    asm volatile("" : "+v"(cinit));
    int sc6 = 0x77; asm volatile("" : "+v"(sc6));
    f32x16 C0, C1; v8i pA, pB, kf0, kf1;
    v8i ones8; { int one4 = ((lane & 15) == ((lane >> 4) & 1)) ? 0x38383838 : 0; asm volatile("" : "+v"(one4));
#pragma unroll
        for (int w = 0; w < 8; ++w) ones8[w] = one4; }
    f32x4 lsum = f32x4{};
    int sl_prev = 0, sl_cur = 0, sl_next = SLOTB;
#define ROT() do { sl_prev = sl_cur; sl_cur = sl_next; sl_next = (sl_next == (NSLOT - 1) * SLOTB) ? 0 : sl_next + SLOTB; } while (0)
#define KLD(sl) do { kf0 = ld24(kp0 + (sl), kq0 + (sl)); kf1 = ld24(kp0 + (sl) + 512, kq0 + (sl) + 512); } while (0)
#define CODES(PW, w0, w1) do { _Pragma("unroll") for (int w_ = (w0); w_ < (w1); ++w_) { \
      const float c0_ = w_ < 4 ? C0[4 * w_] : C1[4 * (w_ - 4)], c1_ = w_ < 4 ? C0[4 * w_ + 1] : C1[4 * (w_ - 4) + 1], c2_ = w_ < 4 ? C0[4 * w_ + 2] : C1[4 * (w_ - 4) + 2], c3_ = w_ < 4 ? C0[4 * w_ + 3] : C1[4 * (w_ - 4) + 3]; \
      const unsigned x_ = __builtin_bit_cast(unsigned, __builtin_amdgcn_cvt_pknorm_u16(c0_, c1_)), y_ = __builtin_bit_cast(unsigned, __builtin_amdgcn_cvt_pknorm_u16(c2_, c3_));     \
      PW[w_] = (int)__builtin_amdgcn_perm(y_, x_, 0x06040200u); } } while (0)
    asm volatile("s_waitcnt vmcnt(0) lgkmcnt(0)\n\ts_barrier" ::: "memory");
    KLD(0);
    C0 = MFMA6(kf0, q8, cinit); C1 = MFMA6(kf1, q8, cinit);
    CODES(pA, 0, 8);
    asm volatile("s_waitcnt lgkmcnt(0)\n\ts_barrier" ::: "memory");
    DMA_K8(3, 0); DMA_V8(1, 2 * SLOTB);
    ROT();
    KLD(sl_cur);
    OWN_BAR();
#define VLD(db) ld32(vp_ + (db) * 512, vp_ + (db) * 512 + VCH)
#define PINV(x) asm volatile("" : "+v"(x))
#define STEP8(PC, PN, t, GK, GV, GL) do { SBAR(); \
    const lds_cptr vp_ = vp0 + 2 * sl_prev; \
    v8i vfa = VLD(0), vfb = VLD(1); SBAR(); \
    C0 = MFMA6(kf0, q8, cinit); C1 = MFMA6(kf1, q8, cinit); PINV(C0); PINV(C1); SBAR(); \
    if (GK) { DMA_K8((t) + 3, sl_cur); } if (GV) { DMA_V8((t) + 1, 2 * sl_next); } \
    if (GL) { KLD(sl_next); } SBAR(); \
    o[0] = MFMA8(PC, vfa, o[0]); PINV(o[0]); SBAR(); if constexpr (NV == 4) { vfa = VLD(2); } CODES(PN, 0, 8 / NV); PINV(PN); SBAR(); \
    o[1] = MFMA8(PC, vfb, o[1]); PINV(o[1]); SBAR(); if constexpr (NV == 4) { vfb = VLD(3); } CODES(PN, 8 / NV, 16 / NV); PINV(PN); SBAR(); \
    if constexpr (NV == 4) { \
    o[2] = MFMA8(PC, vfa, o[2]); PINV(o[2]); SBAR(); CODES(PN, 4, 6); PINV(PN); SBAR(); \
    o[3] = MFMA8(PC, vfb, o[3]); PINV(o[3]); SBAR(); CODES(PN, 6, 8); PINV(PN); SBAR(); } \
    lsum = MFMA8S(PC, ones8, lsum); PINV(lsum); SBAR(); \
    } while (0)
#define ENDW8(tt) do { if ((tt) + 3 < NT) { OWN_BAR(); } else if ((tt) + 2 < NT) { if (kw && NV != 4) { WAIT_BAR(0); } else { WAIT_BAR(1); } } else { WAIT_BAR(0); } } while (0)
    int t = 1;
    if (wid >= 4) __builtin_amdgcn_s_setprio(1);
#pragma unroll 1
    for (; t + 1 < NT; t += 2) {
        STEP8(pA, pB, t, (t + 3 < NT), (t + 1 < NT), (t + 1 < NT));         ENDW8(t);     ROT();
        STEP8(pB, pA, t + 1, (t + 4 < NT), (t + 2 < NT), (t + 2 < NT));     ENDW8(t + 1); ROT();
    }
    STEP8(pA, pB, NT - 1, false, false, false);
    { const lds_cptr vp_ = vp0 + 2 * sl_cur;
#pragma unroll
      for (int db = 0; db < NV; ++db) { const v8i vf = ld32(vp_ + db * 512, vp_ + db * 512 + VCH); o[db] = MFMA8(pB, vf, o[db]); } }
    lsum = MFMA8S(pB, ones8, lsum);
    __builtin_amdgcn_s_setprio(0);
    { float* wsf = (float*)(shm + LDS_WS) + wid * 64;
#pragma unroll
      for (int r = 0; r < 4; ++r) if ((lane & 15) < 2) wsf[16 * (lane & 15) + 4 * (lane >> 4) + r] = lsum[r];
      asm volatile("s_waitcnt lgkmcnt(0)" ::: "memory");
      l_reg = wsf[r32]; asm volatile("s_waitcnt lgkmcnt(0)" ::: "memory"); }
    l_out = l_reg;
    asm volatile("s_waitcnt lgkmcnt(0)\n\ts_barrier" ::: "memory");
#undef DMA_K8
#undef DMA_V8
#undef OWN_BAR
#undef ROT
#undef KLD
#undef CODES
#undef STEP8
#undef PINV
#undef VLD
#undef ENDW8
}
__device__ __forceinline__ void attn_pass8_2x(const unsigned char* Qw8, int QP, const unsigned char* Kh8, int KP, const unsigned char* VT, int mI, char* shm, f32x16 (&oa)[2], f32x16 (&ob)[2], float& la_out, float& lb_out, int wave_in, bool pre = false) {
    constexpr int NV = 2;
    int tid = wave_in * 64 + lane_id(); asm volatile("" : "+v"(tid));
    const int lane = tid & 63, r32 = lane & 31, hi = lane >> 5; const int wid = wave_in;
    const unsigned lds0 = (unsigned)(uintptr_t)shm;
    constexpr int VCH = NV * 512;
    const bool kw = wid < 4, kwk = wid < 3;
    const unsigned char* ksrc = Kh8 + (long)lane * KP + (wid & 3) * 16;
    const unsigned char* vsrc = VT + (long)lane * SEQ + (wid & 3) * 16;
    const unsigned kdst = lds0 + LDS_K + (wid & 3) * 1024, vdst = lds0 + LDS_V + (wid & 3) * VCH;
#define DMA_K8(t, slot) do { if (kwk) glds16(ksrc + (long)(t) * KVBLK * KP, (unsigned)__builtin_amdgcn_readfirstlane(kdst + (slot))); } while (0)
#define DMA_V8(t, slot) do { if (!kw) glds16(vsrc + (t) * KVBLK, (unsigned)__builtin_amdgcn_readfirstlane(vdst + (slot))); } while (0)
#define OWN_BAR() WAIT_BAR(1)
    const lds_cptr shm3 = (lds_cptr)shm;
    const lds_cptr kp0 = shm3 + LDS_K + hi * 1024 + r32 * 16, kq0 = shm3 + LDS_K + 2048 + r32 * 16 + 8 * hi;
    const lds_cptr vp0 = shm3 + LDS_V + (2 * hi) * VCH + r32 * 16;
    if (!pre) { DMA_K8(0, 0); DMA_V8(0, 0); DMA_K8(1, SLOTB); DMA_K8(2, 2 * SLOTB); }
    v8i q8a, q8b;
    { const u32x4 a = *(const u32x4*)(Qw8 + (long)r32 * QP + 16 * hi); const u32x2 b = *(const u32x2*)(Qw8 + (long)r32 * QP + 32 + 8 * hi); q8a = (v8i){(int)a.x, (int)a.y, (int)a.z, (int)a.w, (int)b.x, (int)b.y, 0, 0}; }
    { const u32x4 a = *(const u32x4*)(Qw8 + (long)(32 + r32) * QP + 16 * hi); const u32x2 b = *(const u32x2*)(Qw8 + (long)(32 + r32) * QP + 32 + 8 * hi); q8b = (v8i){(int)a.x, (int)a.y, (int)a.z, (int)a.w, (int)b.x, (int)b.y, 0, 0}; }
#pragma unroll
    for (int d = 0; d < NV; ++d) { oa[d] = f32x16{}; ob[d] = f32x16{}; }
    f32x16 cinit; { int mI_ = mI; asm volatile("" : "+s"(mI_)); float cv = 8.0f * (float)(7 - mI_) * (1.0f / 65536.0f); asm volatile("" : "+v"(cv));
#pragma unroll
        for (int r = 0; r < 16; ++r) cinit[r] = cv; }
    asm volatile("" : "+v"(cinit));
    int sc6 = 0x77; asm volatile("" : "+v"(sc6));
    f32x16 C0, C1; v8i pAa, pBa, pAb, pBb, kf0, kf1;
    v8i ones8; { int one4 = ((lane & 15) == ((lane >> 4) & 1)) ? 0x38383838 : 0; asm volatile("" : "+v"(one4));
#pragma unroll
        for (int w = 0; w < 8; ++w) ones8[w] = one4; }
    f32x4 lsa = f32x4{}, lsb = f32x4{};
    int sl_prev = 0, sl_cur = 0, sl_next = SLOTB;
#define ROT() do { sl_prev = sl_cur; sl_cur = sl_next; sl_next = (sl_next == (NSLOT - 1) * SLOTB) ? 0 : sl_next + SLOTB; } while (0)
#define KLD(sl) do { kf0 = ld24(kp0 + (sl), kq0 + (sl)); kf1 = ld24(kp0 + (sl) + 512, kq0 + (sl) + 512); } while (0)
#define CODES(PW, w0, w1) do { _Pragma("unroll") for (int w_ = (w0); w_ < (w1); ++w_) { \
      const float c0_ = w_ < 4 ? C0[4 * w_] : C1[4 * (w_ - 4)], c1_ = w_ < 4 ? C0[4 * w_ + 1] : C1[4 * (w_ - 4) + 1], c2_ = w_ < 4 ? C0[4 * w_ + 2] : C1[4 * (w_ - 4) + 2], c3_ = w_ < 4 ? C0[4 * w_ + 3] : C1[4 * (w_ - 4) + 3]; \
      const unsigned x_ = __builtin_bit_cast(unsigned, __builtin_amdgcn_cvt_pknorm_u16(c0_, c1_)), y_ = __builtin_bit_cast(unsigned, __builtin_amdgcn_cvt_pknorm_u16(c2_, c3_));     \
      PW[w_] = (int)__builtin_amdgcn_perm(y_, x_, 0x06040200u); } } while (0)
    asm volatile("s_waitcnt vmcnt(0) lgkmcnt(0)\n\ts_barrier" ::: "memory");
    KLD(0);
    C0 = MFMA6(kf0, q8a, cinit); C1 = MFMA6(kf1, q8a, cinit);
    CODES(pAa, 0, 8);
    C0 = MFMA6(kf0, q8b, cinit); C1 = MFMA6(kf1, q8b, cinit);
    CODES(pAb, 0, 8);
    asm volatile("s_waitcnt lgkmcnt(0)\n\ts_barrier" ::: "memory");
    DMA_K8(3, 0); DMA_V8(1, 2 * SLOTB);
    ROT();
    KLD(sl_cur);
    OWN_BAR();
#define VLD(db) ld32(vp_ + (db) * 512, vp_ + (db) * 512 + VCH)
#define PINV(x) asm volatile("" : "+v"(x))
#define STEP2(PCa, PNa, PCb, PNb, t, GK, GV, GL) do { SBAR(); \
    const lds_cptr vp_ = vp0 + 2 * sl_prev; \
    v8i vfa = VLD(0), vfb = VLD(1); SBAR(); \
    C0 = MFMA6(kf0, q8a, cinit); C1 = MFMA6(kf1, q8a, cinit); PINV(C0); PINV(C1); SBAR(); \
    if (GK) { DMA_K8((t) + 3, sl_cur); } if (GV) { DMA_V8((t) + 1, 2 * sl_next); } SBAR(); \
    oa[0] = MFMA8(PCa, vfa, oa[0]); PINV(oa[0]); SBAR(); CODES(PNa, 0, 4); PINV(PNa); SBAR(); \
    oa[1] = MFMA8(PCa, vfb, oa[1]); PINV(oa[1]); SBAR(); CODES(PNa, 4, 8); PINV(PNa); SBAR(); \
    C0 = MFMA6(kf0, q8b, cinit); C1 = MFMA6(kf1, q8b, cinit); PINV(C0); PINV(C1); SBAR(); \
    if (GL) { KLD(sl_next); } SBAR(); \
    ob[0] = MFMA8(PCb, vfa, ob[0]); PINV(ob[0]); SBAR(); CODES(PNb, 0, 4); PINV(PNb); SBAR(); \
    ob[1] = MFMA8(PCb, vfb, ob[1]); PINV(ob[1]); SBAR(); CODES(PNb, 4, 8); PINV(PNb); SBAR(); \
    lsa = MFMA8S(PCa, ones8, lsa); PINV(lsa); lsb = MFMA8S(PCb, ones8, lsb); PINV(lsb); SBAR(); \
    } while (0)
#define ENDW8(tt) do { if ((tt) + 3 < NT) { OWN_BAR(); } else if ((tt) + 2 < NT) { if (kw) { WAIT_BAR(0); } else { WAIT_BAR(1); } } else { WAIT_BAR(0); } } while (0)
    int t = 1;
    if (wid >= 4) __builtin_amdgcn_s_setprio(1);
#pragma unroll 1
    for (; t + 1 < NT; t += 2) {
        STEP2(pAa, pBa, pAb, pBb, t, (t + 3 < NT), (t + 1 < NT), (t + 1 < NT));         ENDW8(t);     ROT();
        STEP2(pBa, pAa, pBb, pAb, t + 1, (t + 4 < NT), (t + 2 < NT), (t + 2 < NT));     ENDW8(t + 1); ROT();
    }
    STEP2(pAa, pBa, pAb, pBb, NT - 1, false, false, false);
    { const lds_cptr vp_ = vp0 + 2 * sl_cur;
#pragma unroll
      for (int db = 0; db < NV; ++db) { const v8i vf = ld32(vp_ + db * 512, vp_ + db * 512 + VCH); oa[db] = MFMA8(pBa, vf, oa[db]); ob[db] = MFMA8(pBb, vf, ob[db]); } }
    lsa = MFMA8S(pBa, ones8, lsa); lsb = MFMA8S(pBb, ones8, lsb);
    __builtin_amdgcn_s_setprio(0);
    { float* wsf = (float*)(shm + LDS_WS) + wid * 64;
#pragma unroll
      for (int r = 0; r < 4; ++r) if ((lane & 15) < 2) { wsf[16 * (lane & 15) + 4 * (lane >> 4) + r] = lsa[r]; wsf[32 + 16 * (lane & 15) + 4 * (lane >> 4) + r] = lsb[r]; }
      asm volatile("s_waitcnt lgkmcnt(0)" ::: "memory");
      la_out = wsf[r32]; lb_out = wsf[32 + r32]; asm volatile("s_waitcnt lgkmcnt(0)" ::: "memory"); }
    asm volatile("s_waitcnt lgkmcnt(0)\n\ts_barrier" ::: "memory");
#undef DMA_K8
#undef DMA_V8
#undef OWN_BAR
#undef ROT
#undef KLD
#undef CODES
#undef STEP2
#undef PINV
#undef VLD
#undef ENDW8
}
#undef SBAR
#undef WAIT_BAR
}

constexpr int LDS_BYTES = 156 * 1024;
static_assert(att::LDS_BYTES <= LDS_BYTES && pg8::STAGE_BYTES <= LDS_BYTES, "LDS map");
constexpr int NWAVES = 8;

struct Args {
    const float* x_prompt; const float* x_sample; const float* c_prompt; const float* c_sample;
    const float* w_ada; const float* b_ada; const float* norm_g; const float* w_in;
    const float* qn_a; const float* kn_a; const float* qn_b; const float* kn_b;
    const float* lq1; const float* lk1; const float* lq2; const float* lk2; const float* subln_g;
    const float* w_proj_a; const float* w_proj_b; const float* w_out;
    float* out; unsigned char* ws;
};
__constant__ double INV_A[16] = {1.0, 0.5623413251903491, 0.31622776601683794, 0.1778279410038923, 0.1, 0.05623413251903491, 0.03162277660168379, 0.01778279410038923, 0.01, 0.005623413251903491, 0.0031622776601683794, 0.0017782794100389228, 0.001, 0.0005623413251903491, 0.00031622776601683794, 0.00017782794100389227};
__constant__ double INV_B[8] = {1.0, 0.19392274474868576, 0.03760603093086393, 0.007292664737217109, 0.001414213562373095, 0.0002742481756762073, 5.318295896944988e-05, 1.031338537721246e-05};

__device__ __forceinline__ int win_row(int n) {
    const int T = n >> 8, o = n & 255;
    int base;
    if (T < 2) base = T * 256; else if (T == 2) base = 6 * 256; else if (T < 5) base = (9 + (T - 3)) * 256; else if (T < 9) base = (T - 3) * 256; else if (T < 11) base = (T - 2) * 256; else base = T * 256;
    if (T == 3 || T == 4 || T >= 11) return base + 128 * ((o >> 3) & 1) + 32 * (o >> 6) + 8 * ((o >> 4) & 3) + (o & 7);
    return base + 128 * ((o >> 5) & 1) + 32 * (o >> 6) + (o & 31);
}
__device__ __forceinline__ void transpose_item(const float* W, int N, h16_t* WT, int KD, int kofs, int k0, int n0, int drow0, LAS float* scr, int lane, unsigned char* WT8 = nullptr, int drow8 = 0, float sc8 = 1.0f, float wmul = 1.0f) {
#pragma unroll 8
    for (int i = 0; i < 32; ++i) { const int kk = 2 * i + (lane >> 5); scr[kk * 33 + (lane & 31)] = W[(size_t)(k0 + kk) * N + n0 + (lane & 31)]; }
    asm volatile("s_waitcnt lgkmcnt(0)" ::: "memory");
    const int c = lane & 7;
#pragma unroll
    for (int j = 0; j < 4; ++j) { const int n = (lane >> 3) + 8 * j; const LAS float* s = scr + (8 * c) * 33 + n;
        u32x4 o; o.x = pk2h(s[0 * 33] * wmul, s[1 * 33] * wmul); o.y = pk2h(s[2 * 33] * wmul, s[3 * 33] * wmul); o.z = pk2h(s[4 * 33] * wmul, s[5 * 33] * wmul); o.w = pk2h(s[6 * 33] * wmul, s[7 * 33] * wmul);
        *(u32x4*)(WT + (size_t)(drow0 >= 0 ? drow0 + n : win_row(n0 + n)) * KD + kofs + k0 + 8 * c) = o;
        if (WT8) { int w0 = 0, w1 = 0;
            w0 = __builtin_amdgcn_cvt_pk_fp8_f32(s[0 * 33] * sc8, s[1 * 33] * sc8, w0, false); w0 = __builtin_amdgcn_cvt_pk_fp8_f32(s[2 * 33] * sc8, s[3 * 33] * sc8, w0, true);
            w1 = __builtin_amdgcn_cvt_pk_fp8_f32(s[4 * 33] * sc8, s[5 * 33] * sc8, w1, false); w1 = __builtin_amdgcn_cvt_pk_fp8_f32(s[6 * 33] * sc8, s[7 * 33] * sc8, w1, true);
            *(u32x2*)(WT8 + (size_t)(drow8 >= 0 ? drow8 + n : win_row(n0 + n) + drow8) * 1024 + k0 + 8 * c) = (u32x2){(unsigned)w0, (unsigned)w1}; } }
    asm volatile("s_waitcnt lgkmcnt(0)" ::: "memory");
}
__device__ __forceinline__ unsigned amax_bits(const unsigned char* ws, int G, size_t off = WS_AMAX) {
    int ln = lane_id(); asm volatile("" : "+v"(ln));
    float m = 0.f; for (int i = ln; i < G; i += 64) m = fmaxf(m, ((const float*)(ws + off))[i]);
#pragma unroll
    for (int o_ = 1; o_ < 64; o_ <<= 1) m = fmaxf(m, __shfl_xor(m, o_));
    return (unsigned)__builtin_amdgcn_readfirstlane((int)__float_as_uint(m));
}
__device__ __forceinline__ int w8_exp(unsigned amax_bits) {
    const float am = __uint_as_float(amax_bits);
    if (!(am > 1e-30f) || !(am < 1e30f)) return 0;
    const float r = 224.0f / am; return (int)((__float_as_uint(r) >> 23) & 255u) - 127;
}


__device__ __forceinline__ void score_bounds(const Args& A, float& boundA, float& boundB) {
    int ln = lane_id(); asm volatile("" : "+v"(ln));
    float qa = fabsf(A.qn_a[ln]), ka = fabsf(A.kn_a[ln]), qb_ = fabsf(A.qn_b[ln]), kb_ = fabsf(A.kn_b[ln]);
#pragma unroll
    for (int o_ = 1; o_ < 64; o_ <<= 1) { qa = fmaxf(qa, __shfl_xor(qa, o_)); ka = fmaxf(ka, __shfl_xor(ka, o_)); qb_ = fmaxf(qb_, __shfl_xor(qb_, o_)); kb_ = fmaxf(kb_, __shfl_xor(kb_, o_)); }
    boundA = __uint_as_float(__builtin_amdgcn_readfirstlane(__float_as_uint(C2 * 64.0f * 1.01f * qa * ka))); boundB = __uint_as_float(__builtin_amdgcn_readfirstlane(__float_as_uint(C2 * 64.0f * 1.01f * qb_ * kb_)));
}
__device__ __forceinline__ bool use_fp8(float boundA, float boundB) { return (boundA <= 13.7f) && (boundB <= 13.7f); }

#define XB_TMO      128
#define XB_XCNT(j)  (256  + 64 * (j))
#define XB_XSUB(j)  (1280 + 64 * (j))
#define XB_XGEN(j)  (2304 + 64 * (j))
#define XB_TOP      3328
#define XB_TOPGEN   3392
#define XB_AMAX      3456
#define XCD_BAR_WORDS 3472
#define XB_SPIN_CAP (1u << 18)
__device__ __forceinline__ unsigned xb_ld(unsigned* p)              { return __hip_atomic_load(p, __ATOMIC_RELAXED, __HIP_MEMORY_SCOPE_AGENT); }
__device__ __forceinline__ unsigned xb_add(unsigned* p, unsigned v) { return __hip_atomic_fetch_add(p, v, __ATOMIC_RELAXED, __HIP_MEMORY_SCOPE_AGENT); }
__device__ __forceinline__ unsigned xb_xcc_id() { return (unsigned)__builtin_amdgcn_s_getreg((3 << 11) | 20) & 0xFu; }
#define XB_SPIN(cond, bar) do { unsigned _sp = 0; while (cond) { __builtin_amdgcn_s_sleep(1); \
    if ((++_sp & 255u) == 0u) { if (xb_ld(&(bar)[XB_TMO])) break; if (_sp > XB_SPIN_CAP) { atomicAdd(&(bar)[XB_TMO], 1u); break; } } } } while (0)
struct XcdBarrier { unsigned* bar; unsigned x; volatile LAS unsigned* st; int wave; };
__device__ __forceinline__ XcdBarrier xcd_barrier_post(unsigned* bar, volatile LAS unsigned* st, int wave) {
    XcdBarrier b; b.bar = bar; b.x = xb_xcc_id(); b.st = st; b.wave = wave;
    if (wave == 0 && lane_id() == 0) (void)xb_add(&bar[XB_XCNT(b.x)], 1u);
    return b;
}
__device__ __forceinline__ void xcd_barrier_complete(unsigned* bar, unsigned x, unsigned& nloc, unsigned& nx) {
    const unsigned G = gridDim.x * gridDim.y * gridDim.z;
    unsigned sum, cnt, mine, sp = 0u;
    for (;;) {
        sum = 0u; cnt = 0u; mine = 0u;
#pragma unroll
        for (unsigned j = 0; j < 16; ++j) { const unsigned c = xb_ld(&bar[XB_XCNT(j)]); sum += c; cnt += (c > 0u) ? 1u : 0u; mine = (j == x) ? c : mine; }
        if (sum == G) break;
        __builtin_amdgcn_s_sleep(1);
        if ((++sp & 255u) == 0u) { if (xb_ld(&bar[XB_TMO])) break; if (sp > XB_SPIN_CAP) { atomicAdd(&bar[XB_TMO], 1u); break; } }
    }
    nloc = mine > 0u ? mine : 1u; nx = cnt > 0u ? cnt : 1u;
}
__device__ __forceinline__ void xcd_barrier(const XcdBarrier& b) {
    asm volatile("s_waitcnt vmcnt(0)" ::: "memory");
    __syncthreads();
    if (b.wave == 0 && lane_id() == 0) {
        unsigned* bar = b.bar;
        __builtin_amdgcn_s_waitcnt(0);
        unsigned nloc = b.st[0], nx = b.st[1];
        if (nloc == 0u) { xcd_barrier_complete(bar, b.x, nloc, nx); b.st[0] = nloc; b.st[1] = nx; }
        const unsigned old = xb_add(&bar[XB_XSUB(b.x)], 1u);
        const unsigned gen = old / nloc;
        if (old + 1u == (gen + 1u) * nloc) {
            __builtin_amdgcn_fence(__ATOMIC_RELEASE, "agent");
            asm volatile("s_waitcnt vmcnt(0)" ::: "memory");
            const unsigned og = xb_add(&bar[XB_TOP], 1u);
            const unsigned tg = og / nx;
            if (og + 1u == (tg + 1u) * nx) xb_add(&bar[XB_TOPGEN], 1u);
            else XB_SPIN(xb_ld(&bar[XB_TOPGEN]) == tg, bar);
            __builtin_amdgcn_fence(__ATOMIC_ACQUIRE, "agent");
            xb_add(&bar[XB_XGEN(b.x)], 1u);
            asm volatile("s_waitcnt vmcnt(0)" ::: "memory");
        } else {
            XB_SPIN(xb_ld(&bar[XB_XGEN(b.x)]) == gen, bar);
            __builtin_amdgcn_fence(__ATOMIC_ACQUIRE, "agent");
            asm volatile("s_waitcnt vmcnt(0)" ::: "memory");
        }
    }
    __syncthreads();
}

__global__ void __launch_bounds__(NWAVES * 64, 2) mega_fwd(Args A) {
    extern __shared__ __attribute__((aligned(16))) unsigned char lds[];
    LAS unsigned char* ldsl = (LAS unsigned char*)lds;
    const int tid = threadIdx.x, lane = tid & 63, wave = __builtin_amdgcn_readfirstlane(tid >> 6);
    const int G = gridDim.x; const int bx = blockIdx.x; const int vcu = (G % 8 == 0) ? (bx % 8) * (G / 8) + bx / 8 : bx;
    unsigned char* ws = A.ws;
    const int gw = vcu * NWAVES + wave, NGW = G * NWAVES;
    volatile LAS unsigned* bar_st = (volatile LAS unsigned*)(ldsl + LDS_BYTES - 64);
    if (tid == 0) { bar_st[0] = 0u; bar_st[1] = 0u; }
    __syncthreads();
    const XcdBarrier xbar = xcd_barrier_post((unsigned*)ws, bar_st, wave);

    {
        for (int it = gw; it < 48 * 16; it += NGW) {
            const int cgp = it % 48, kc = it / 48, col = cgp * 64 + lane, k0 = kc * 64;
            float sv[6], ac[6];
#pragma unroll
            for (int b = 0; b < 6; ++b) { const float c = b < 4 ? A.c_prompt[b * DM + k0 + lane] : A.c_sample[(b - 4) * DM + k0 + lane]; sv[b] = silu_f(c); ac[b] = 0.f; }
            for (int kk = 0; kk < 64; ++kk) {
                const float w = A.w_ada[(size_t)(k0 + kk) * 3072 + col];
#pragma unroll
                for (int b = 0; b < 6; ++b) ac[b] += __shfl(sv[b], kk) * w;
            }
            float* modp = (float*)(ws + WS_MODP);
#pragma unroll
            for (int b = 0; b < 6; ++b) modp[(size_t)(kc * 6 + b) * 3072 + col] = ac[b];
        }
        {
            float am = 0.f;
            for (int i = gw * 64 + lane; i < DM * 384; i += NGW * 64) {
                const int row = i / 384, c4 = i - row * 384, col = c4 < 128 ? 4 * c4 : 1280 + 4 * (c4 - 128);
                const f32x4 v = *(const f32x4*)(A.w_in + (size_t)row * DIN + col);
                am = fmaxf(fmaxf(am, fmaxf(fabsf(v.x), fabsf(v.y))), fmaxf(fabsf(v.z), fabsf(v.w)));
            }
            float ag = 0.f;
            for (int i = gw * 64 + lane; i < DM * 512; i += NGW * 64) {
                const int row = i >> 9, col = 3328 + 4 * (i & 511);
                const f32x4 v = *(const f32x4*)(A.w_in + (size_t)row * DIN + col);
                ag = fmaxf(fmaxf(ag, fmaxf(fabsf(v.x), fabsf(v.y))), fmaxf(fabsf(v.z), fabsf(v.w)));
            }
#pragma unroll
            for (int o_ = 1; o_ < 64; o_ <<= 1) { am = fmaxf(am, __shfl_xor(am, o_)); ag = fmaxf(ag, __shfl_xor(ag, o_)); }
            LAS float* amw = (LAS float*)(ldsl + 1024);
            if (lane == 0) { amw[wave] = am; amw[8 + wave] = ag; }
            __syncthreads();
            if (tid == 0) { float m = amw[0], mg = amw[8];
#pragma unroll
                for (int w = 1; w < NWAVES; ++w) { m = fmaxf(m, amw[w]); mg = fmaxf(mg, amw[8 + w]); }
                ((float*)(ws + WS_AMAX))[bx] = m; ((float*)(ws + WS_AMAXG))[bx] = mg; }
        }
    }
    xcd_barrier(xbar);

    {
        LAS float* Gt = (LAS float*)(ldsl + 140 * 1024); LAS float* St = Gt + DM;
        const float* modp = (const float*)(ws + WS_MODP);
        if (vcu < NBATCH) {
            for (int c = tid; c < DM; c += NWAVES * 64) { float g = A.b_ada[2048 + c];
                for (int kc = 0; kc < 16; ++kc) g += modp[(size_t)(kc * 6 + vcu) * 3072 + 2048 + c];
                ((float*)(ws + WS_GATE))[vcu * DM + c] = g; }
        }
        const int rstart = (int)((long)TOK * vcu / G), rend = (int)((long)TOK * (vcu + 1) / G);
        const int b_lo = rstart >> 13, b_hi = (rend - 1) >> 13;
        for (int b = b_lo; b <= b_hi; ++b) {
            __syncthreads();
            for (int c = tid; c < DM; c += NWAVES * 64) { float sh = A.b_ada[c], scl = A.b_ada[1024 + c];
                for (int kc = 0; kc < 16; ++kc) { sh += modp[(size_t)(kc * 6 + b) * 3072 + c]; scl += modp[(size_t)(kc * 6 + b) * 3072 + 1024 + c]; }
                Gt[c] = A.norm_g[c] * (1.0f + scl); St[c] = sh; }
            __syncthreads();
            const int lo = rstart > b * SEQ ? rstart : b * SEQ, hi_ = rend < (b + 1) * SEQ ? rend : (b + 1) * SEQ;
            for (int r = lo + wave; r < hi_; r += NWAVES) {
                const float* xrow = r < TOKP ? A.x_prompt + (size_t)r * DM : A.x_sample + (size_t)(r - TOKP) * DM;
                const f32x4* xr = (const f32x4*)xrow + lane;
                f32x4 v[4]; float s = 0.f;
#pragma unroll
                for (int j = 0; j < 4; ++j) { v[j] = __builtin_nontemporal_load(xr + 64 * j); s += (v[j].x * v[j].x + v[j].y * v[j].y) + (v[j].z * v[j].z + v[j].w * v[j].w); }
                const float rstd = 1.0f / sqrtf(wave_sum(s) * (1.0f / DM) + EPS);
                u32x2* o8 = (u32x2*)((h16_t*)(ws + WS_XN) + (size_t)r * DM) + lane;
                unsigned* o8b = (unsigned*)(ws + WS_XN8 + (size_t)r * DM) + lane;
#pragma unroll
                for (int j = 0; j < 4; ++j) { const f32x4 gq = *(const LAS f32x4*)(Gt + 4 * lane + 256 * j), sq = *(const LAS f32x4*)(St + 4 * lane + 256 * j);
                    const f32x4 h = v[j] * rstd * gq + sq; u32x2 w; w.x = pk2h(h.x, h.y); w.y = pk2h(h.z, h.w); o8[64 * j] = w;
                    int w8 = 0; w8 = __builtin_amdgcn_cvt_pk_fp8_f32(__builtin_amdgcn_fmed3f(h.x, -448.f, 448.f), __builtin_amdgcn_fmed3f(h.y, -448.f, 448.f), w8, false);
                    w8 = __builtin_amdgcn_cvt_pk_fp8_f32(__builtin_amdgcn_fmed3f(h.z, -448.f, 448.f), __builtin_amdgcn_fmed3f(h.w, -448.f, 448.f), w8, true); o8b[64 * j] = (unsigned)w8; }
            }
        }
        __syncthreads();
        LAS float* scr = (LAS float*)(ldsl + wave * 16384);
        const float w8s = __uint_as_float((unsigned)(127 + w8_exp(amax_bits(ws, G))) << 23);
        const float w8g = -1.4426950408889634f * __uint_as_float((unsigned)(127 + w8_exp(amax_bits(ws, G, WS_AMAXG))) << 23);
        constexpr int I_IN = (DM / 64) * (DIN / 32), I_PA = (512 / 64) * (DM / 32), I_OUT = (DM / 64) * (DM / 32);
        constexpr int NITEMS = I_IN + 2 * I_PA + I_OUT;
        for (int it = gw; it < NITEMS; it += NGW) {
            int r = it;
            if (r < I_IN) { const int nblk = DIN / 32, kb = r / nblk, nb = r % nblk, wr_ = win_row(32 * nb), T_ = nb >> 3;
                const bool qk8 = T_ < 2 || (T_ >= 5 && T_ <= 8);
                transpose_item(A.w_in, DIN, (h16_t*)(ws + WS_WIN), DM, 0, 64 * kb, 32 * nb, -1, scr, lane, qk8 ? ws + WS_WIN8 : (T_ >= 13 ? ws + WS_WIN8G : nullptr), qk8 ? wr_ : -13 * 256, qk8 ? w8s : w8g, T_ >= 13 ? -1.4426950408889634f : 1.0f); continue; } r -= I_IN;
            if (r < I_PA) { const int nblk = DM / 32, kb = r / nblk, nb = r % nblk, n0 = 32 * nb; transpose_item(A.w_proj_a, DM, (h16_t*)(ws + WS_WAB), DM, 0, 64 * kb, n0, 256 * (n0 >> 7) + (n0 & 127), scr, lane); continue; } r -= I_PA;
            if (r < I_PA) { const int nblk = DM / 32, kb = r / nblk, nb = r % nblk, n0 = 32 * nb; transpose_item(A.w_proj_b, DM, (h16_t*)(ws + WS_WAB), DM, 512, 64 * kb, n0, 256 * (n0 >> 7) + 128 + (n0 & 127), scr, lane); continue; } r -= I_PA;
            { const int nblk = DM / 32, kb = r / nblk, nb = r % nblk; transpose_item(A.w_out, DM, (h16_t*)(ws + WS_WOUT), DM, 0, 64 * kb, 32 * nb, 32 * nb, scr, lane); }
        }
        for (int row = gw; row < 2048; row += NGW) {
            h16_t* p = (h16_t*)(ws + WS_WAB) + (size_t)row * DM + ((row & 128) ? 0 : 512) + lane * 8;
            *(u32x4*)p = (u32x4){0u, 0u, 0u, 0u};
        }
        if (vcu == 0) { float* nrm = (float*)(ws + WS_NRM);
            if (tid < 64) { nrm[tid] = A.qn_a[tid]; nrm[64 + tid] = A.kn_a[tid]; nrm[128 + tid] = A.qn_b[tid]; nrm[192 + tid] = A.kn_b[tid]; }
            if (tid < 128) nrm[256 + tid] = A.subln_g[tid]; }
        {
            const int gt = vcu * (NWAVES * 64) + tid, NGT = G * NWAVES * 64;
            for (int e = gt; e < 65536 + 2048 + 1024; e += NGT) {
                int pos, j, kind; if (e < 65536) { kind = 0; pos = e >> 3; j = e & 7; } else if (e < 65536 + 2048) { kind = 1; pos = (e - 65536) >> 4; j = e & 15; } else { kind = 2; pos = (e - 65536 - 2048) >> 4; j = e & 15; }
                const double inv = kind == 0 ? INV_B[j] : INV_A[j & 15];
                double rev = (double)pos * inv * 0.15915494309189533577; rev -= floor(rev);
                const double q4 = floor(rev * 4.0 + 0.5); const double xr = (rev - q4 * 0.25) * 6.283185307179586476925; const double x2 = xr * xr;
                const double sp = xr * (1.0 + x2 * (-1.0 / 6 + x2 * (1.0 / 120 + x2 * (-1.0 / 5040 + x2 * (1.0 / 362880 + x2 * (-1.0 / 39916800 + x2 * (1.0 / 6227020800.0)))))));
                const double cp = 1.0 + x2 * (-0.5 + x2 * (1.0 / 24 + x2 * (-1.0 / 720 + x2 * (1.0 / 40320 + x2 * (-1.0 / 3628800 + x2 * (1.0 / 479001600.0 + x2 * (-1.0 / 87178291200.0)))))));
                const int qd = ((int)q4) & 3;
                const double cd = qd == 0 ? cp : qd == 1 ? -sp : qd == 2 ? -cp : sp, sd = qd == 0 ? sp : qd == 1 ? cp : qd == 2 ? -sp : -cp;
                const float cs = (float)cd, sn = (float)sd;
                h16_t* tp; int stride, half;
                if (kind == 0) { tp = (h16_t*)(ws + WS_TB); stride = 16; half = 8; } else if (kind == 1) { tp = (h16_t*)(ws + WS_TAR); stride = 32; half = 16; } else { tp = (h16_t*)(ws + WS_TAC); stride = 32; half = 16; }
                tp[pos * stride + j] = f2h(cs);
                tp[pos * stride + half + j] = f2h(sn);
            }
        }
    }
    xcd_barrier(xbar);

    int p4_u8, p4_eg;
    {
        float bA_, bB_; score_bounds(A, bA_, bB_); const int u8 = use_fp8(bA_, bB_) ? 1 : 0;
        p4_u8 = __builtin_amdgcn_readfirstlane(u8); p4_eg = __builtin_amdgcn_readfirstlane(w8_exp(amax_bits(ws, G, WS_AMAXG)));
        if (u8) {
            const int eqk = w8_exp(amax_bits(ws, G));
            pg8::Gemm g{(const h16_t*)(ws + WS_XN8), (const h16_t*)(ws + WS_WIN8), TOK, 6 * 256, DM / 2, 0x7f00 | (127 - eqk)}; pg8::StaticOrder S; S.init(TOK, 6 * 256, G, bx);
            if (G == 256) { S.i2 = 3; S.G2 = 192; S.c2 = (bx >= 128 && bx < 192) ? -1 : (bx < 128 ? bx : bx - 64); }
            EpiInProj E{0, ws, 1, 0, 1.0f};
            pg8::gemm_phase<EpiInProj, false, true>(ldsl, g, S, E, wave);
        }
        {
            const int nt16 = u8 ? 3 : 9;
            pg8::Gemm g{(const h16_t*)(ws + WS_XN), (const h16_t*)(ws + WS_WIN) + (size_t)(9 - nt16) * 256 * DM, TOK, nt16 * 256, DM}; pg8::StaticOrder S; S.init(TOK, nt16 * 256, G, u8 ? (bx + G / 2) % G : bx);
            EpiInProj E{0, ws, u8, 9 - nt16, 1.0f};
            pg8::gemm_phase<EpiInProj>(ldsl, g, S, E, wave);
        }
    }
    xcd_barrier(xbar);

    {
        float lam;
        { int ln = lane_id(); asm volatile("" : "+v"(ln)); const float p1 = A.lq1[ln] * A.lk1[ln], p2 = A.lq2[ln] * A.lk2[ln]; lam = __uint_as_float(__builtin_amdgcn_readfirstlane(__float_as_uint(__expf(wave_sum(p1)) - __expf(wave_sum(p2)) + LAM_INIT))); }
        float boundA, boundB; score_bounds(A, boundA, boundB); const bool use8 = use_fp8(boundA, boundB);
        auto shift_of = [](float bound) -> int { const unsigned b = __float_as_uint(bound); const int e = (int)(b >> 23) - 127; const unsigned m = (b & 0x7fffffu) | 0x800000u;
            const int fx = e >= 13 ? (int)(m << (e - 13)) : (e >= -10 ? (int)(m >> (13 - e)) : 0);
            return (fx - 8960 + 1024) >> 10; };
        const int mIA = shift_of(boundA), mIB = shift_of(boundB);
        char* shm = (char*)lds;
        h16_t* OAB = (h16_t*)(ws + WS_OAB);
        auto first_dma = [&](int s_, int p_) {
            if (s_ < 768) { const int u = (s_ >> 8) * 32 + (s_ & 31), xg = (s_ & 255) >> 5, j = u >> 4, id = 3 * xg + (j >> 1), b = id >> 2, kvh = (id >> 1) & 1;
                att::attn_first_dma<2>((const unsigned char*)(ws + WS_KA) + (long)b * SEQ * 96 + kvh * 48, 96, (const unsigned char*)(ws + WS_VTA) + (long)((b * 2 + kvh) * 64) * SEQ, shm, wave);
            } else { const int a = s_ - 768, ii = a >> 8, vv = a & 255, xg = vv >> 5, id = 3 * xg + ii, b = id >> 2, h = id & 3;
                att::attn_first_dma<4>((const unsigned char*)(ws + WS_KB) + (long)b * SEQ * 384 + (2 * h + p_) * 48, 384, (const unsigned char*)(ws + WS_VTB) + (long)((b * 4 + h) * 128) * SEQ, shm, wave); }
        };
        if (use8 && vcu < 1536) first_dma(vcu, 0);
        for (int s = vcu; s < 1536; s += G) {
            const bool isB = s >= 768;
            if (!isB) {
                const int u = (s >> 8) * 32 + (s & 31), xg = (s & 255) >> 5, qb = u & 15, j = u >> 4, id = 3 * xg + (j >> 1), sel = j & 1, b = id >> 2;
                const long rowbase = (long)b * SEQ + qb * 512 + wave * 64;
                const int kvh = (id >> 1) & 1, h = 4 * kvh + 2 * (id & 1) + sel;
                const h16_t* Qw = (const h16_t*)(ws + WS_QA) + rowbase * 512 + h * 64;
                const h16_t* Kh = (const h16_t*)(ws + WS_KA) + (long)b * SEQ * 128 + kvh * 64;
                const h16_t* Vh = (const h16_t*)(ws + WS_VA) + (long)b * SEQ * 128 + kvh * 64;
                f32x16 oa[2], ob[2]; float la, lb;
                if (use8) att::attn_pass8_2x((const unsigned char*)(ws + WS_QA) + rowbase * 384 + h * 48, 384, (const unsigned char*)(ws + WS_KA) + (long)b * SEQ * 96 + kvh * 48, 96,
                                             (const unsigned char*)(ws + WS_VTA) + (long)((b * 2 + kvh) * 64) * SEQ, mIA, shm, oa, ob, la, lb, wave, true);
                if (use8 && s + G < 1536) first_dma(s + G, 0);
                auto epiA = [&](const f32x16 (&o)[2], float l, long rb) {
                    int tid2 = wave * 64 + lane_id(); asm volatile("" : "+v"(tid2));
                    const int lane = tid2 & 63, r32 = lane & 31, hi = lane >> 5;
                    float* wsf = (float*)(shm + att::LDS_WS) + wave * 64;
                    h16_t* stg = (h16_t*)(shm + att::LDS_OST + wave * att::OST_WAVE);
                    if (hi == 0) wsf[32 + r32] = l; asm volatile("s_waitcnt lgkmcnt(0)" ::: "memory");
                    float rli[16];
#pragma unroll
                    for (int r = 0; r < 16; ++r) rli[r] = __builtin_amdgcn_rcpf(wsf[32 + att::crow(r, hi)]);
#pragma unroll
                    for (int r = 0; r < 16; ++r) { const int orow = att::crow(r, hi);
#pragma unroll
                        for (int d0 = 0; d0 < 2; ++d0) stg[orow * 64 + d0 * 32 + r32] = f2h(o[d0][r] * rli[r]); }
                    asm volatile("s_waitcnt lgkmcnt(0)" ::: "memory");
                    h16_t* Ow = OAB + rb * 1024 + h * 64;
#pragma unroll
                    for (int i = 0; i < 4; ++i) { const int row = i * 8 + (lane >> 3), ch = lane & 7; const u32x4 v = *(const u32x4*)(stg + row * 64 + ch * 8); *(u32x4*)(Ow + (long)row * 1024 + ch * 8) = v; }
                    asm volatile("s_waitcnt lgkmcnt(0)" ::: "memory");
                };
                if (use8) { epiA(oa, la, rowbase); epiA(ob, lb, rowbase + 32); }
                else {
#pragma unroll 1
                    for (int sub = 0; sub < 2; ++sub) { att::attn_pass<8, false>(Qw + (long)sub * 32 * 512, 512, Kh, 128, Vh, 128, shm, oa, la, wave); epiA(oa, la, rowbase + 32 * sub); }
                }
            } else {
                const int a = s - 768, ii = a >> 8, vv = a & 255, xg = vv >> 5, qb = vv & 31, id = 3 * xg + ii, b = id >> 2, h = id & 3;
                const long rowbase = (long)b * SEQ + qb * 256 + wave * 32;
                const h16_t* Vh = (const h16_t*)(ws + WS_VB) + (long)b * SEQ * 512 + h * 128;
#pragma unroll 1
                for (int p = 0; p < 2; ++p) {
                    const h16_t* Qw = (const h16_t*)(ws + WS_QB) + rowbase * 512 + (2 * h + p) * 64;
                    const h16_t* Kh = (const h16_t*)(ws + WS_KB) + (long)b * SEQ * 512 + (2 * h + p) * 64;
                    f32x16 o[4]; float l;
                    if (use8) att::attn_pass8<4>((const unsigned char*)(ws + WS_QB) + rowbase * 384 + (2 * h + p) * 48, 384, (const unsigned char*)(ws + WS_KB) + (long)b * SEQ * 384 + (2 * h + p) * 48, 384,
                                                 (const unsigned char*)(ws + WS_VTB) + (long)((b * 4 + h) * 128) * SEQ, mIB, shm, o, l, wave, true);
                    else att::attn_pass128<8, false>(Qw, 512, Kh, 512, Vh, 512, shm, o, l, wave);
                    if (use8) { if (p == 0) first_dma(s, 1); else if (s + G < 1536) first_dma(s + G, 0); }
                    int tid2 = wave * 64 + lane_id(); asm volatile("" : "+v"(tid2));
                    const int lane = tid2 & 63, r32 = lane & 31, hi = lane >> 5;
                    float* wsf = (float*)(shm + att::LDS_WS) + wave * 64;
                    unsigned* stw = (unsigned*)(shm + att::LDS_OST + wave * att::OST_WAVE);
                    h16_t* stg = (h16_t*)stw;
                    if (hi == 0) wsf[32 + r32] = l; asm volatile("s_waitcnt lgkmcnt(0)" ::: "memory");
                    float rli[16];
#pragma unroll
                    for (int r = 0; r < 16; ++r) rli[r] = __builtin_amdgcn_rcpf(wsf[32 + att::crow(r, hi)]);
                    if (p == 0) {
#pragma unroll
                        for (int d0 = 0; d0 < 4; ++d0)
#pragma unroll
                            for (int r = 0; r < 16; r += 2) stw[(d0 * 8 + (r >> 1)) * 64 + lane] = pk2h(o[d0][r] * rli[r], o[d0][r + 1] * rli[r + 1]);
                        asm volatile("s_waitcnt lgkmcnt(0)" ::: "memory");
                    } else {
                        unsigned sv[32];
#pragma unroll
                        for (int i = 0; i < 32; ++i) sv[i] = stw[i * 64 + lane];
                        asm volatile("s_waitcnt lgkmcnt(0)" ::: "memory");
#pragma unroll
                        for (int d0 = 0; d0 < 4; ++d0)
#pragma unroll
                            for (int r = 0; r < 16; ++r) { const unsigned w = sv[d0 * 8 + (r >> 1)]; const float o0 = h2f((unsigned short)((r & 1) ? (w >> 16) : (w & 0xffffu)));
                                const float dv = o0 - lam * (o[d0][r] * rli[r]);
                                stg[att::crow(r, hi) * 128 + d0 * 32 + r32] = f2h(dv); }
                        asm volatile("s_waitcnt lgkmcnt(0)" ::: "memory");
                        const float* sg = A.subln_g;
                        h16_t* Ow = OAB + rowbase * 1024 + 512 + h * 128;
#pragma unroll
                        for (int i = 0; i < 8; ++i) { const int row = i * 4 + (lane >> 4), ch = lane & 15; const u32x4 v = *(const u32x4*)(stg + row * 128 + ch * 8);
                            float f[8]; float q = 0.f;
#pragma unroll
                            for (int e = 0; e < 4; ++e) { f[2 * e] = h2f((unsigned short)(v[e] & 0xffffu)); f[2 * e + 1] = h2f((unsigned short)(v[e] >> 16)); q += f[2 * e] * f[2 * e] + f[2 * e + 1] * f[2 * e + 1]; }
                            q += __shfl_xor(q, 1); q += __shfl_xor(q, 2); q += __shfl_xor(q, 4); q += __shfl_xor(q, 8);
                            const float rn = __builtin_amdgcn_rsqf(q * (1.0f / 128.0f) + EPS) * (1.0f - LAM_INIT);
                            const f32x4 g0 = *(const f32x4*)(sg + ch * 8), g1 = *(const f32x4*)(sg + ch * 8 + 4);
                            u32x4 w; w.x = pk2h(f[0] * rn * g0[0], f[1] * rn * g0[1]); w.y = pk2h(f[2] * rn * g0[2], f[3] * rn * g0[3]); w.z = pk2h(f[4] * rn * g1[0], f[5] * rn * g1[1]); w.w = pk2h(f[6] * rn * g1[2], f[7] * rn * g1[3]);
                            *(u32x4*)(Ow + (long)row * 1024 + ch * 8) = w; }
                        asm volatile("s_waitcnt lgkmcnt(0)" ::: "memory");
                    }
                }
            }
        }
    }
    xcd_barrier(xbar);

    {
        const int u8 = p4_u8;
        {
            const int nt16 = u8 ? 4 : 12;
            pg8::Gemm g{(const h16_t*)(ws + WS_XN), (const h16_t*)(ws + WS_WIN) + (size_t)9 * 256 * DM, TOK, nt16 * 256, DM}; pg8::StaticOrder S; S.init(TOK, nt16 * 256, G, bx);
            EpiInProj E{1, ws, 0, 0, 1.0f};
            pg8::gemm_phase<EpiInProj>(ldsl, g, S, E, wave);
        }
        if (u8) {
            pg8::Gemm g{(const h16_t*)(ws + WS_XN8), (const h16_t*)(ws + WS_WIN8G), TOK, 8 * 256, DM / 2, 0x7f00 | (127 - p4_eg)}; pg8::StaticOrder S; S.init(TOK, 8 * 256, G, bx);
            EpiInProj E{1, ws, 0, 4, 1.0f};
            pg8::gemm_phase<EpiInProj, false, true>(ldsl, g, S, E, wave);
        }
    }
    xcd_barrier(xbar);

    {
        pg8::Gemm g{(const h16_t*)(ws + WS_OAB), (const h16_t*)(ws + WS_WAB), TOK, 2048, DM}; pg8::StaticOrder S; S.init(TOK, 2048, G, bx);
        EpiMerge E{ws + WS_SGA, ws + WS_SGB, (h16_t*)(ws + WS_MG)};
        pg8::gemm_phase<EpiMerge, true>(ldsl, g, S, E, wave);
    }
    xcd_barrier(xbar);

    {
        pg8::Gemm g{(const h16_t*)(ws + WS_MG), (const h16_t*)(ws + WS_WOUT), TOK, DM, DM}; pg8::StaticOrder S; S.init(TOK, DM, G, bx);
        EpiOut E{A.x_prompt, (long)((const char*)A.x_sample - (const char*)A.x_prompt) - (long)TOKP * DM * 4, (const float*)(ws + WS_GATE), A.out};
        pg8::gemm_phase<EpiOut>(ldsl, g, S, E, wave);
    }
}

extern "C" void kernel_launch(void* const* d_in, const int* in_sizes, int n_in, void* d_out, int out_size, void* d_ws, size_t ws_size, hipStream_t stream) {
    static int grid = 0;
    if (grid == 0) {
        if (n_in != 20 || out_size != TOK * DM || ws_size < WS_END) { fprintf(stderr, "kernel_launch: unexpected shapes (n_in %d out %d ws %zu)\n", n_in, out_size, ws_size); grid = -1; return; }
        int dev = 0, cus = 0, per_cu = 0;
        hipGetDevice(&dev); hipDeviceGetAttribute(&cus, hipDeviceAttributeMultiprocessorCount, dev);
        hipFuncSetAttribute((const void*)mega_fwd, hipFuncAttributeMaxDynamicSharedMemorySize, LDS_BYTES);
        hipOccupancyMaxActiveBlocksPerMultiprocessor(&per_cu, (const void*)mega_fwd, NWAVES * 64, LDS_BYTES);
        (void)hipGetLastError();
        if (per_cu < 1) fprintf(stderr, "kernel_launch: occupancy query reports %d blocks per CU\n", per_cu);
        grid = cus > 0 ? cus : 256;
    }
    if (grid < 0) return;
    Args a{};
    a.x_prompt = (const float*)d_in[0]; a.x_sample = (const float*)d_in[1]; a.c_prompt = (const float*)d_in[2]; a.c_sample = (const float*)d_in[3];
    a.w_ada = (const float*)d_in[4]; a.b_ada = (const float*)d_in[5]; a.norm_g = (const float*)d_in[6]; a.w_in = (const float*)d_in[7];
    a.qn_a = (const float*)d_in[8]; a.kn_a = (const float*)d_in[9]; a.qn_b = (const float*)d_in[10]; a.kn_b = (const float*)d_in[11];
    a.lq1 = (const float*)d_in[12]; a.lk1 = (const float*)d_in[13]; a.lq2 = (const float*)d_in[14]; a.lk2 = (const float*)d_in[15]; a.subln_g = (const float*)d_in[16];
    a.w_proj_a = (const float*)d_in[17]; a.w_proj_b = (const float*)d_in[18]; a.w_out = (const float*)d_in[19];
    a.out = (float*)d_out; a.ws = (unsigned char*)d_ws;
    if (hipMemsetAsync(d_ws, 0, XCD_BAR_WORDS * 4, stream) != hipSuccess) { fprintf(stderr, "kernel_launch: hipMemsetAsync failed\n"); return; }
    void* args[] = {&a};
    hipError_t e = hipLaunchCooperativeKernel((const void*)mega_fwd, dim3(grid), dim3(NWAVES * 64), args, LDS_BYTES, stream);
    if (e != hipSuccess) fprintf(stderr, "kernel_launch: cooperative launch failed: %s (grid %d)\n", hipGetErrorString(e), grid);
}
```

```cpp
#include <hip/hip_runtime.h>
#include <cstdio>
#include <cstdint>
#include <cmath>

#define LAS __attribute__((address_space(3)))
#define GAS __attribute__((address_space(1)))
typedef unsigned short h16_t;
#ifndef LP_BF16
#define LP_BF16 1
#endif
#if LP_BF16
typedef __bf16 lp_t;
typedef short f16x8 __attribute__((ext_vector_type(8)));
#define MFMA16(a, b, c) __builtin_amdgcn_mfma_f32_16x16x32_bf16(a, b, c, 0, 0, 0)
#define MFMA32(a, b, c) __builtin_amdgcn_mfma_f32_32x32x16_bf16(a, b, c, 0, 0, 0)
#else
typedef _Float16 lp_t;
typedef _Float16 f16x8 __attribute__((ext_vector_type(8)));
#define MFMA16(a, b, c) __builtin_amdgcn_mfma_f32_16x16x32_f16(a, b, c, 0, 0, 0)
#endif
typedef lp_t f16x2 __attribute__((ext_vector_type(2)));
typedef float f32x2 __attribute__((ext_vector_type(2)));
typedef float f32x4 __attribute__((ext_vector_type(4)));
typedef float f32x8 __attribute__((ext_vector_type(8)));
typedef float f32x16 __attribute__((ext_vector_type(16)));
typedef unsigned u32x2 __attribute__((ext_vector_type(2)));
typedef unsigned u32x4 __attribute__((ext_vector_type(4)));
typedef short s16x4 __attribute__((ext_vector_type(4)));
typedef int i32x4 __attribute__((ext_vector_type(4)));
typedef int i32x8 __attribute__((ext_vector_type(8)));
typedef int i32x6 __attribute__((ext_vector_type(6)));
#define MFMA8S_G(a, b, c) __builtin_amdgcn_mfma_scale_f32_16x16x128_f8f6f4(a, b, c, 0, 0, 0, scv, 1, scv)

constexpr int DM = 1024, SEQ = 8192, NBATCH = 6, TOK = NBATCH * SEQ, TOKP = 4 * SEQ, DIN = 5376;
constexpr float EPS = 1e-6f;
constexpr float C2 = 0.125f * 1.4426950408889634f;
constexpr float SQK6 = 1.2011224087864498f;
constexpr float LAM_INIT = 0.2f;

constexpr size_t MiB = 1u << 20;
constexpr size_t WS_MODP = 1 * MiB;
constexpr size_t WS_GATE = 3 * MiB;
constexpr size_t WS_TAR = 3 * MiB + 65536;
constexpr size_t WS_TAC = WS_TAR + 8192;
constexpr size_t WS_TB = WS_TAC + 4096;
constexpr size_t WS_NRM = WS_GATE + 32768;
constexpr size_t WS_AMAX = WS_GATE + 32768 + 4096;
constexpr size_t WS_SSQ = 4 * MiB;
constexpr size_t WS_WIN = 6 * MiB;
constexpr size_t WS_WAB = 17 * MiB;
constexpr size_t WS_WOUT = 21 * MiB;
constexpr size_t WS_XN = 24 * MiB;
constexpr size_t WS_MG = WS_XN;
constexpr size_t WS_QA = 120 * MiB, WS_KA = 168 * MiB, WS_VA = 180 * MiB, WS_QB = 192 * MiB, WS_KB = 240 * MiB, WS_VB = 288 * MiB;
constexpr size_t WS_OAB = 336 * MiB;
constexpr size_t WS_SGA = 120 * MiB, WS_SGB = 216 * MiB;
constexpr size_t WS_VTA = 432 * MiB;
constexpr size_t WS_VTB = 438 * MiB;
constexpr size_t WS_XN8 = WS_VB;
constexpr size_t WS_WIN8G = WS_VA + 2 * MiB;
constexpr size_t WS_AMAXG = WS_AMAX + 1024;
constexpr size_t WS_WIN8 = WS_VA;
constexpr size_t WS_END = 462 * MiB;

__device__ __forceinline__ unsigned pk2h(float lo, float hi) { f32x2 v = {lo, hi}; f16x2 b = __builtin_convertvector(v, f16x2); return __builtin_bit_cast(unsigned, b); }
__device__ __forceinline__ float h2f(unsigned short u) { return (float)__builtin_bit_cast(lp_t, u); }
__device__ __forceinline__ unsigned short f2h(float v) { return __builtin_bit_cast(unsigned short, (lp_t)v); }
__device__ __forceinline__ int lane_id() { unsigned z = 0u; asm volatile("" : "+v"(z)); return (int)__builtin_amdgcn_mbcnt_hi(~0u, __builtin_amdgcn_mbcnt_lo(~0u, z)); }
__device__ __forceinline__ float wave_sum(float v) {
#pragma unroll
    for (int o = 1; o < 64; o <<= 1) v += __shfl_xor(v, o);
    return v;
}
__device__ __forceinline__ float silu_f(float v) { return v * __builtin_amdgcn_rcpf(1.0f + __expf(-v)); }
__device__ __forceinline__ float sigm_f(float v) { return __builtin_amdgcn_rcpf(1.0f + __expf(-v)); }

namespace pg8 {
constexpr int BM = 256, BK = 64, HALF = 128, HTB = HALF * BK * 2, STAGE_BYTES = 8 * HTB, NXCD = 8, WGM = 8;
__host__ __device__ __forceinline__ int lds_byte(int r, int c) { const int st = (r >> 4) * 2 + (c >> 5), rr = r & 15, cc = c & 31, ob = rr * 64 + cc * 2; return st * 1024 + (ob ^ (((ob >> 9) & 1) << 5)); }
__host__ __device__ __forceinline__ void stage_rc(int b, int& R, int& C) { const int st = b / 1024, sb = b % 1024, swz = sb ^ (((sb >> 9) & 1) << 5); R = (st >> 1) * 16 + swz / 64; C = (st & 1) * 32 + (swz % 64) / 2; }
__host__ __device__ __forceinline__ int perm32(int rho) { const int n = rho >> 4, i = rho & 15; return 8 * (i >> 2) + 4 * n + (i & 3); }
struct Unit { int pm, pn; };
struct Gemm { const h16_t* A; const h16_t* Bt; int M, N, K; int sc = 0x7f7f; };
struct StaticOrder {
    int nM, nN, nwg, G, c, i2, G2, c2;
    __device__ void init(int M, int N, int G_, int c_) { nM = M / BM; nN = N / BM; nwg = nM * nN; G = G_; c = c_; i2 = 1 << 20; G2 = G_; c2 = c_; }
    __device__ bool next(int i, Unit& u) const {
        long L;
        if (i < i2) L = (long)i * G + c; else { if (c2 < 0) return false; L = (long)i2 * G + (long)(i - i2) * G2 + c2; }
        if (L >= nwg) return false;
        int wgid = (int)L; { const int q = nwg / NXCD, r = nwg % NXCD, xcd = wgid % NXCD, off = wgid / NXCD; wgid = (xcd < r ? xcd * (q + 1) : r * (q + 1) + (xcd - r) * q) + off; }
        const int nig = WGM * nN, gid = wgid / nig, fm = gid * WGM, gsz = (nM - fm) < WGM ? (nM - fm) : WGM;
        u.pm = fm + ((wgid % nig) % gsz); u.pn = (wgid % nig) / gsz; return true;
    }
};
__device__ __forceinline__ i32x8 cat8(f16x8 a, f16x8 b) { const i32x4 x = __builtin_bit_cast(i32x4, a), y = __builtin_bit_cast(i32x4, b); return __builtin_shufflevector(x, y, 0, 1, 2, 3, 4, 5, 6, 7); }
template <class Epi, bool DIAG = false, bool F8 = false>
__device__ __forceinline__ void gemm_phase(LAS unsigned char* lds, const Gemm g, const StaticOrder& S, const Epi& E, int wave_in) {
    int tid = wave_in * 64 + lane_id(); asm volatile("" : "+v"(tid));
    const int wid = wave_in, lane = tid & 63, wr = wid >> 2, wc = wid & 3, fr = lane & 15, fq = lane >> 4;
    const int K = g.K, nt = K / BK;
    int scv = g.sc; asm volatile("" : "+v"(scv)); (void)scv;
    unsigned voffA[2], voffB[2];
#pragma unroll
    for (int i = 0; i < 2; ++i) { int R, C; stage_rc(tid * 16 + i * 8192, R, C); const int Rb = Epi::PERM ? ((R & ~31) + perm32(R & 31)) : R;
        voffA[i] = (unsigned)(R * K + C) * 2u; voffB[i] = (unsigned)(Rb * K + C) * 2u; }
    const size_t kstep = (size_t)(BK * 2);
    const size_t hstep = (size_t)HALF * K * 2;
    const size_t tstep = 2 * hstep;
    const unsigned ldsw = (unsigned)wid * 1024u;
    const int aoff = lds_byte(wr * 64 + fr, fq * 8), boff = lds_byte(wc * 32 + fr, fq * 8);
#define PG8_SA(b, h) (((b) * 2 + (h)) * HTB)
#define PG8_SB(b, h) ((4 + (b) * 2 + (h)) * HTB)
#define PG8_STAGE(bufoff, gbase, voff) do { _Pragma("unroll") for (int _i = 0; _i < 2; ++_i) \
        __builtin_amdgcn_global_load_lds((const unsigned*)((const char*)(gbase) + (voff)[_i]), (LAS unsigned*)(lds + (bufoff) + ldsw + _i * 8192), 16, 0, 0); } while (0)
#define PG8_LD8(p) ({ const i32x4 x_ = *(const LAS i32x4*)(p), y_ = *(const LAS i32x4*)((p) + 1024); (i32x8){x_[0], x_[1], x_[2], x_[3], y_[0], y_[1], y_[2], y_[3]}; })
#define PG8_LDA(dst, b, h) do { if constexpr (F8) { _Pragma("unroll") for (int m = 0; m < 4; ++m) dst##8[m] = PG8_LD8(lds + PG8_SA(b, h) + aoff + m * 2048); } else { \
        _Pragma("unroll") for (int m = 0; m < 4; ++m) _Pragma("unroll") for (int k = 0; k < 2; ++k) dst[m][k] = *(const LAS f16x8*)(lds + PG8_SA(b, h) + aoff + m * 2048 + k * 1024); } } while (0)
#define PG8_LDB(dst, b, h) do { if constexpr (F8) { _Pragma("unroll") for (int n = 0; n < 2; ++n) dst##8[n] = PG8_LD8(lds + PG8_SB(b, h) + boff + n * 2048); } else { \
        _Pragma("unroll") for (int n = 0; n < 2; ++n) _Pragma("unroll") for (int k = 0; k < 2; ++k) dst[n][k] = *(const LAS f16x8*)(lds + PG8_SB(b, h) + boff + n * 2048 + k * 1024); } } while (0)
#define PG8_MMA(ai, bj, At, Bt) do { __builtin_amdgcn_s_setprio(1); if constexpr (F8) { _Pragma("unroll") for (int m = 0; m < 4; ++m) _Pragma("unroll") for (int n = 0; n < 2; ++n) \
        { if (n == 0) acc8[ai][bj][m].lo = MFMA8S_G(Bt##8[n], At##8[m], acc8[ai][bj][m].lo); else acc8[ai][bj][m].hi = MFMA8S_G(Bt##8[n], At##8[m], acc8[ai][bj][m].hi); } \
        _Pragma("unroll") for (int m = 0; m < 4; ++m) asm volatile("" : "+v"(acc8[ai][bj][m])); } else { \
        _Pragma("unroll") for (int m = 0; m < 4; ++m) _Pragma("unroll") for (int n = 0; n < 2; ++n) _Pragma("unroll") for (int k = 0; k < 2; ++k) \
        acc[ai][bj][m][n] = MFMA16(Bt[n][k], At[m][k], acc[ai][bj][m][n]); } __builtin_amdgcn_s_setprio(0); } while (0)
#define PG8_WAIT_V(n) asm volatile("s_waitcnt vmcnt(" #n ")" ::: "memory")
#define PG8_WAIT_L(n) asm volatile("s_waitcnt lgkmcnt(" #n ")" ::: "memory")
#define PG8_BAR __builtin_amdgcn_s_barrier()
#define PG8_SCHED __builtin_amdgcn_sched_barrier(0)
    Unit cur, nxt; int ui = 0;
    if (!S.next(0, cur)) return;
    f32x4 acc[2][2][4][2];
    f32x8 acc8[2][2][4];
#pragma unroll
    for (int a = 0; a < 2; ++a)
#pragma unroll
        for (int b = 0; b < 2; ++b)
#pragma unroll
            for (int m = 0; m < 4; ++m) acc8[a][b][m] = (f32x8){0.f, 0.f, 0.f, 0.f, 0.f, 0.f, 0.f, 0.f};
#pragma unroll
    for (int a = 0; a < 2; ++a)
#pragma unroll
        for (int b = 0; b < 2; ++b)
#pragma unroll
            for (int m = 0; m < 4; ++m)
#pragma unroll
                for (int n = 0; n < 2; ++n) acc[a][b][m][n] = (f32x4){0.f, 0.f, 0.f, 0.f};
    f16x8 At[4][2], B0[2][2], B1[2][2]; i32x8 At8[4], B08[2], B18[2];
    const char* cA = (const char*)g.A + (size_t)cur.pm * tstep; const char* cB = (const char*)g.Bt + (size_t)cur.pn * tstep;
    PG8_STAGE(PG8_SB(0, 0), cB, voffB); if (!DIAG) PG8_STAGE(PG8_SB(0, 1), cB + hstep, voffB); PG8_STAGE(PG8_SA(0, 0), cA, voffA); PG8_STAGE(PG8_SA(0, 1), cA + hstep, voffA);
    if (wr == 1) PG8_BAR;
    PG8_WAIT_V(2); PG8_BAR;
    PG8_STAGE(PG8_SB(1, 0), cB + kstep, voffB); PG8_STAGE(PG8_SA(1, 0), cA + kstep, voffA); if (!DIAG) PG8_STAGE(PG8_SB(1, 1), cB + hstep + kstep, voffB);
    if (DIAG) { PG8_WAIT_V(4); } else { PG8_WAIT_V(6); } PG8_BAR;
    for (;;) {
        const bool has_next = S.next(ui + 1, nxt);
        const char* nA = has_next ? (const char*)g.A + (size_t)nxt.pm * tstep : cA; const char* nB = has_next ? (const char*)g.Bt + (size_t)nxt.pn * tstep : cB;
#pragma unroll 1
        for (int t = 0; t < nt; t += 2) {
            const bool last = (t == nt - 2); const bool lo_half = (2 * t < nt); (void)lo_half;
            const char* a1 = cA + (size_t)(t + 1) * kstep;
            const char* a2 = last ? nA : cA + (size_t)(t + 2) * kstep; const char* b2 = last ? nB : cB + (size_t)(t + 2) * kstep;
            const char* a3 = a2 + kstep; const char* b3 = b2 + kstep;
            const bool lo2 = last || (2 * (t + 2) < nt), lo3 = last || (2 * (t + 3) < nt); (void)lo2; (void)lo3;
#define PG8_WV() do { if (DIAG) { PG8_WAIT_V(6); } else { PG8_WAIT_V(8); } } while (0)
            if (!DIAG || lo_half) PG8_LDB(B0, 0, 0); if (!DIAG || !lo_half) PG8_LDB(B1, 0, 1); PG8_SCHED; PG8_LDA(At, 0, 0); PG8_STAGE(PG8_SA(1, 1), a1 + hstep, voffA);
            PG8_WV(); PG8_WAIT_L(0); PG8_BAR; if (!DIAG || lo_half) PG8_MMA(0, 0, At, B0); if (!DIAG || !lo_half) PG8_MMA(0, 1, At, B1); PG8_BAR; PG8_SCHED;
            PG8_LDA(At, 0, 1); if (!DIAG || lo2) PG8_STAGE(PG8_SB(0, 0), b2, voffB); if (!DIAG || !lo2) PG8_STAGE(PG8_SB(0, 1), b2 + hstep, voffB); PG8_STAGE(PG8_SA(0, 0), a2, voffA);
            PG8_WV(); PG8_WAIT_L(0); PG8_BAR; if (!DIAG || lo_half) PG8_MMA(1, 0, At, B0); if (!DIAG || !lo_half) PG8_MMA(1, 1, At, B1); PG8_BAR; PG8_SCHED;
            if (!DIAG || lo_half) PG8_LDB(B0, 1, 0); if (!DIAG || !lo_half) PG8_LDB(B1, 1, 1); PG8_SCHED; PG8_LDA(At, 1, 0); PG8_STAGE(PG8_SA(0, 1), a2 + hstep, voffA);
            PG8_WV(); PG8_WAIT_L(0); PG8_BAR; if (!DIAG || lo_half) PG8_MMA(0, 0, At, B0); if (!DIAG || !lo_half) PG8_MMA(0, 1, At, B1); PG8_BAR; PG8_SCHED;
            PG8_LDA(At, 1, 1); if (!DIAG || lo3) PG8_STAGE(PG8_SB(1, 0), b3, voffB); if (!DIAG || !lo3) PG8_STAGE(PG8_SB(1, 1), b3 + hstep, voffB); PG8_STAGE(PG8_SA(1, 0), a3, voffA);
            PG8_WV(); PG8_WAIT_L(0); PG8_BAR; if (!DIAG || lo_half) PG8_MMA(1, 0, At, B0); if (!DIAG || !lo_half) PG8_MMA(1, 1, At, B1); PG8_BAR; PG8_SCHED;
#undef PG8_WV
        }
        if (wr == 0) PG8_BAR;
        if constexpr (F8) {
#pragma unroll
            for (int a = 0; a < 2; ++a)
#pragma unroll
                for (int b = 0; b < 2; ++b)
#pragma unroll
                    for (int m = 0; m < 4; ++m) { acc[a][b][m][0] = acc8[a][b][m].lo; acc[a][b][m][1] = acc8[a][b][m].hi; acc8[a][b][m] = (f32x8){0.f, 0.f, 0.f, 0.f, 0.f, 0.f, 0.f, 0.f}; }
        }
        { int l2 = lane_id(); asm volatile("" : "+v"(l2)); E(acc, cur, wr, wc, l2 & 15, l2 >> 4); }
        if (!has_next) break;
#pragma unroll
        for (int a = 0; a < 2; ++a)
#pragma unroll
            for (int b = 0; b < 2; ++b)
#pragma unroll
                for (int m = 0; m < 4; ++m)
#pragma unroll
                    for (int n = 0; n < 2; ++n) acc[a][b][m][n] = (f32x4){0.f, 0.f, 0.f, 0.f};
        cur = nxt; cA = nA; cB = nB; ++ui;
        if (wr == 1) PG8_BAR;
    }
    PG8_WAIT_V(0);
    PG8_BAR;
#undef PG8_SA
#undef PG8_SB
#undef PG8_STAGE
#undef PG8_LDA
#undef PG8_LDB
#undef PG8_MMA
#undef PG8_WAIT_V
#undef PG8_WAIT_L
#undef PG8_BAR
#undef PG8_SCHED
}
}

__device__ __forceinline__ float xsum16(float x) { const auto r = __builtin_amdgcn_permlane16_swap(__float_as_uint(x), __float_as_uint(x), false, false); return __uint_as_float(r[0]) + __uint_as_float(r[1]); }
__device__ __forceinline__ float xsum32(float x) { const auto r = __builtin_amdgcn_permlane32_swap(__float_as_uint(x), __float_as_uint(x), false, false); return __uint_as_float(r[0]) + __uint_as_float(r[1]); }
struct EpiInProj {
    static constexpr bool PERM = true;
    int part; unsigned char* ws; int use8; int pnoff; float wsc;
    __device__ __forceinline__ void operator()(const f32x4 (&acc)[2][2][4][2], const pg8::Unit& u, int wr, int wc, int fr, int fq) const {
        asm volatile("" : "+v"(fr), "+v"(fq));
        const int row0 = u.pm * 256 + wr * 64 + fr;
        const int pi = u.pn + pnoff;
        const int T = part == 0 ? (pi < 2 ? pi : (pi < 6 ? pi + 3 : (pi == 6 ? 2 : pi + 2))) : (pi < 2 ? pi + 3 : pi + 9);
        if (part == 0) {
            const bool normed = (T <= 1) || (T == 2 && wc < 2) || (T >= 5 && T <= 8);
            if (normed) {
                const bool isA = (T <= 2), isQ = (T <= 1) || (T == 5) || (T == 6);
                const float* gw = (const float*)(ws + WS_NRM) + 64 * ((isA ? 0 : 2) + (isQ ? 0 : 1));
                h16_t* dst; int pitch, colbase;
                if (T <= 1) { dst = (h16_t*)(ws + WS_QA); pitch = 512; colbase = 256 * T + 64 * wc; }
                else if (T == 2) { dst = (h16_t*)(ws + WS_KA); pitch = 128; colbase = 64 * wc; }
                else if (T <= 6) { dst = (h16_t*)(ws + WS_QB); pitch = 512; colbase = 256 * (T - 5) + 64 * wc; }
                else { dst = (h16_t*)(ws + WS_KB); pitch = 512; colbase = 256 * (T - 7) + 64 * wc; }
                f32x4 gv[2][2];
#pragma unroll
                for (int bj = 0; bj < 2; ++bj)
#pragma unroll
                    for (int n = 0; n < 2; ++n) gv[bj][n] = *(const f32x4*)(gw + 32 * bj + 8 * fq + 4 * n) * (use8 ? SQK6 : 1.0f);
                const float sc = isQ ? C2 : 1.0f;
                const int pidx32 = ((fr | (fq << 4)) ^ 32) << 2, pidx16 = ((fr | (fq << 4)) ^ 16) << 2;
                const h16_t* tar = (const h16_t*)(ws + WS_TAR); const h16_t* tac = (const h16_t*)(ws + WS_TAC); const h16_t* tb = (const h16_t*)(ws + WS_TB);
                const int pitch6 = (pitch >> 6) * 48, hoff6 = (colbase >> 6) * 48;
                f32x4 ysv[4][2][2];
                extern __shared__ __attribute__((aligned(16))) unsigned char epi_lds_[];
                LAS unsigned char* stl = (LAS unsigned char*)epi_lds_ + pg8::STAGE_BYTES + (wr * 4 + wc) * 3072;
#pragma unroll
                for (int ai = 0; ai < 2; ++ai) {
#pragma unroll
                    for (int m = 0; m < 4; ++m) {
                        const int r = row0 + ai * 128 + m * 16, t = r & (SEQ - 1);
                        float ss = 0.f;
#pragma unroll
                        for (int bj = 0; bj < 2; ++bj)
#pragma unroll
                            for (int n = 0; n < 2; ++n) { const f32x4 v = acc[ai][bj][m][n]; ss += (v[0] * v[0] + v[1] * v[1]) + (v[2] * v[2] + v[3] * v[3]); }
                        ss = xsum16(ss); ss = xsum32(ss);
                        const float rs = __builtin_amdgcn_rsqf(ss * (wsc * wsc * (1.0f / 64.0f)) + EPS) * wsc;
                        f32x4 y[2][2];
#pragma unroll
                        for (int bj = 0; bj < 2; ++bj)
#pragma unroll
                            for (int n = 0; n < 2; ++n) y[bj][n] = acc[ai][bj][m][n] * rs * gv[bj][n];
                        if (isA) {
#pragma unroll
                            for (int bj = 0; bj < 2; ++bj) {
                                const int pos = bj == 0 ? (t >> 6) : (t & 63);
                                const h16_t* tp = (bj == 0 ? tar : tac) + pos * 32 + 8 * (fq & 1);
                                const u32x4 cw = *(const u32x4*)tp, sw = *(const u32x4*)(tp + 16);
                                const float sgn = fq < 2 ? -1.0f : 1.0f;
#pragma unroll
                                for (int n = 0; n < 2; ++n)
#pragma unroll
                                    for (int i = 0; i < 4; ++i) {
                                        const int e = 4 * n + i; const unsigned cwe = cw[e >> 1], swe = sw[e >> 1];
                                        const float cs = h2f((unsigned short)((e & 1) ? (cwe >> 16) : (cwe & 0xffffu))), sn = h2f((unsigned short)((e & 1) ? (swe >> 16) : (swe & 0xffffu)));
                                        const float yv = y[bj][n][i], pv = __uint_as_float((unsigned)__builtin_amdgcn_ds_bpermute(pidx32, (int)__float_as_uint(yv)));
                                        y[bj][n][i] = yv * cs + sgn * pv * sn;
                                    }
                            }
                        } else {
                            const h16_t* tp = tb + t * 16;
                            const u32x4 cw = *(const u32x4*)tp, sw = *(const u32x4*)(tp + 8);
                            const float sgn = fq == 0 ? -1.0f : 1.0f;
#pragma unroll
                            for (int n = 0; n < 2; ++n)
#pragma unroll
                                for (int i = 0; i < 4; ++i) {
                                    const int e = 4 * n + i; const unsigned cwe = cw[e >> 1], swe = sw[e >> 1];
                                    const float cs = h2f((unsigned short)((e & 1) ? (cwe >> 16) : (cwe & 0xffffu))), sn = h2f((unsigned short)((e & 1) ? (swe >> 16) : (swe & 0xffffu)));
                                    const float yv = y[0][n][i], pv = __uint_as_float((unsigned)__builtin_amdgcn_ds_bpermute(pidx16, (int)__float_as_uint(yv)));
                                    y[0][n][i] = fq < 2 ? (yv * cs + sgn * pv * sn) : yv;
                                }
                        }
#pragma unroll
                        for (int bj = 0; bj < 2; ++bj) {
                            if (use8) { ysv[m][bj][0] = y[bj][0]; ysv[m][bj][1] = y[bj][1];
                            } else {
                            u32x4 w; w.x = pk2h(y[bj][0][0] * sc, y[bj][0][1] * sc); w.y = pk2h(y[bj][0][2] * sc, y[bj][0][3] * sc); w.z = pk2h(y[bj][1][0] * sc, y[bj][1][1] * sc); w.w = pk2h(y[bj][1][2] * sc, y[bj][1][3] * sc);
                            *(u32x4*)(dst + (size_t)r * pitch + colbase + 32 * bj + 8 * fq) = w; }
                        }
                    }
                    if (use8) {
#pragma unroll
                        for (int bj = 0; bj < 2; ++bj) {
                            f32x16 s0, s1;
#pragma unroll
                            for (int i = 0; i < 16; ++i) { const int m_ = i >> 2, c0 = 2 * (i & 3); s0[i] = ysv[m_][bj][c0 >> 2][c0 & 3]; s1[i] = ysv[m_][bj][(c0 + 1) >> 2][(c0 + 1) & 3]; }
                            const i32x6 d6 = __builtin_amdgcn_cvt_scalef32_2xpk16_fp6_f32(s0, s1, 1.0f);
                            const int dwoff = fq == 0 ? 16 * bj : (fq == 1 ? 16 * bj + 8 : (fq == 2 ? 16 * bj + 12 : 36 + 8 * bj));
                            const int shoff = fq == 0 ? 16 * bj + 4 : (fq == 1 ? 16 * bj + 6 : (fq == 2 ? 32 + 8 * bj : 34 + 8 * bj));
#pragma unroll
                            for (int m = 0; m < 4; ++m) {
                                const unsigned a0 = (unsigned)d6[3 * (m >> 1)], a1 = (unsigned)d6[3 * (m >> 1) + 1], a2 = (unsigned)d6[3 * (m >> 1) + 2];
                                const unsigned lo = (m & 1) ? ((a1 >> 16) | (a2 << 16)) : a0, hi16 = (m & 1) ? (a2 >> 16) : (a1 & 0xffffu);
                                const unsigned dwv = (fq & 1) ? ((lo >> 16) | (hi16 << 16)) : lo, shv = (fq & 1) ? (lo & 0xffffu) : hi16;
                                LAS unsigned char* p6 = stl + (m * 16 + fr) * 48;
                                *(LAS unsigned*)(p6 + dwoff) = dwv; *(LAS unsigned short*)(p6 + shoff) = (unsigned short)shv;
                            }
                        }
                        asm volatile("s_waitcnt lgkmcnt(0)" ::: "memory");
                        {   const int lrow = fr + 16 * fq;
                            unsigned char* g6 = (unsigned char*)dst + (size_t)(u.pm * 256 + wr * 64 + ai * 128 + lrow) * pitch6 + hoff6;
#pragma unroll
                            for (int j = 0; j < 3; ++j) { const u32x4 v = *(const LAS u32x4*)(stl + lrow * 48 + 16 * j); *(u32x4*)(g6 + 16 * j) = v; }
                        }
                        asm volatile("s_waitcnt lgkmcnt(0)" ::: "memory");
                    }
                }
            } else if (use8) {
                unsigned char* vt; int drow0;
                if (T == 2) { vt = ws + WS_VTA; drow0 = (wc - 2) * 64; } else { vt = ws + WS_VTB; drow0 = (2 * (T - 9) + (wc >> 1)) * 128 + (wc & 1) * 64; }
                const int rows_per_b = (T == 2) ? 128 : 512;
                extern __shared__ __attribute__((aligned(16))) unsigned char epi_lds_[];
                LAS unsigned char* stl = (LAS unsigned char*)epi_lds_ + pg8::STAGE_BYTES + (wr * 4 + wc) * 3072;
#pragma unroll
                for (int ai = 0; ai < 2; ++ai) {
                    const int rt = u.pm * 256 + wr * 64 + ai * 128, b = rt >> 13, tk0 = rt & (SEQ - 1);
#pragma unroll
                    for (int bj = 0; bj < 2; ++bj) {
#pragma unroll
                        for (int m = 0; m < 4; ++m) {
                            const int tau = 16 * m + fr;
                            const int pos = 32 * ((tau >> 2) & 1) + 16 * (tau >> 5) + 4 * ((tau >> 3) & 3) + (tau & 3);
#pragma unroll
                            for (int n = 0; n < 2; ++n) { const f32x4 v = acc[ai][bj][m][n];
                                int w0 = 0; w0 = __builtin_amdgcn_cvt_pk_fp8_f32(v[0], v[1], w0, false); w0 = __builtin_amdgcn_cvt_pk_fp8_f32(v[2], v[3], w0, true);
#pragma unroll
                                for (int i = 0; i < 4; ++i) stl[(8 * fq + 4 * n + i) * 64 + pos] = (unsigned char)((unsigned)w0 >> (8 * i)); }
                        }
                        asm volatile("s_waitcnt lgkmcnt(0)" ::: "memory");
                        const int ln_ = fr + 16 * fq;
#pragma unroll
                        for (int j = 0; j < 2; ++j) { const int id = ln_ + 64 * j, dl = id >> 2, c16 = id & 3;
                            const u32x4 v = *(const LAS u32x4*)(stl + dl * 64 + 16 * c16);
                            *(u32x4*)(vt + ((size_t)(b * rows_per_b + drow0 + 32 * bj + dl)) * SEQ + tk0 + 16 * c16) = v; }
                        asm volatile("s_waitcnt lgkmcnt(0)" ::: "memory");
                    }
                }
            } else {
                h16_t* dst; int pitch, colbase;
                if (T == 2) { dst = (h16_t*)(ws + WS_VA); pitch = 128; colbase = 64 * (wc - 2); }
                else { dst = (h16_t*)(ws + WS_VB); pitch = 512; colbase = 256 * (T - 9) + 64 * wc; }
#pragma unroll
                for (int ai = 0; ai < 2; ++ai)
#pragma unroll
                    for (int m = 0; m < 4; ++m) {
                        const int r = row0 + ai * 128 + m * 16;
#pragma unroll
                        for (int bj = 0; bj < 2; ++bj) {
                            const f32x4 v0 = acc[ai][bj][m][0], v1 = acc[ai][bj][m][1];
                            u32x4 w; w.x = pk2h(v0[0], v0[1]); w.y = pk2h(v0[2], v0[3]); w.z = pk2h(v1[0], v1[1]); w.w = pk2h(v1[2], v1[3]);
                            *(u32x4*)(dst + (size_t)r * pitch + colbase + 32 * bj + 8 * fq) = w;
                        }
                    }
            }
        } else {
            if (T <= 12) {
                h16_t* oab = (h16_t*)(ws + WS_OAB);
                const int colt = (T >= 11 ? 512 + 256 * (T - 11) : 256 * (T - 3)) + 64 * wc;
#pragma unroll
                for (int aim = 0; aim < 4; ++aim) { const int ai = aim >> 1, m0 = (aim & 1) * 2;
                    u32x4 ovs[2][4][2];
#pragma unroll
                    for (int m = m0; m < m0 + 2; ++m)
#pragma unroll
                        for (int bj = 0; bj < 2; ++bj) ovs[ai][m][bj] = *(const u32x4*)(oab + (size_t)(row0 + ai * 128 + m * 16) * 1024 + colt + 16 * fq + 8 * bj);
                    __builtin_amdgcn_sched_barrier(0);
#pragma unroll
                    for (int m = m0; m < m0 + 2; ++m) {
                        const int r = row0 + ai * 128 + m * 16;
#pragma unroll
                        for (int bj = 0; bj < 2; ++bj) {
                            h16_t* p = oab + (size_t)r * 1024 + colt + 16 * fq + 8 * bj;
                            const u32x4 ov = ovs[ai][m][bj];
                            float o[8];
#pragma unroll
                            for (int e = 0; e < 4; ++e) { o[2 * e] = h2f((unsigned short)(ov[e] & 0xffffu)); o[2 * e + 1] = h2f((unsigned short)(ov[e] >> 16)); }
                            float q[8];
#pragma unroll
                            for (int n = 0; n < 2; ++n)
#pragma unroll
                                for (int i = 0; i < 4; ++i) q[4 * n + i] = o[4 * n + i] * silu_f(acc[ai][bj][m][n][i]);
                            u32x4 w; w.x = pk2h(q[0], q[1]); w.y = pk2h(q[2], q[3]); w.z = pk2h(q[4], q[5]); w.w = pk2h(q[6], q[7]);
                            *(u32x4*)p = w;
                        }
                    }
                    __builtin_amdgcn_sched_barrier(0);
                }
            } else {
                unsigned char* dst = ws + (T <= 16 ? WS_SGA : WS_SGB);
                const int colt = 256 * (T <= 16 ? T - 13 : T - 17) + 64 * wc;
#pragma unroll
                for (int ai = 0; ai < 2; ++ai)
#pragma unroll
                    for (int m = 0; m < 4; ++m) {
                        const int r = row0 + ai * 128 + m * 16;
                        u32x4 w;
#pragma unroll
                        for (int bj = 0; bj < 2; ++bj) {
                            const f32x4 v0 = acc[ai][bj][m][0], v1 = acc[ai][bj][m][1];
                            unsigned w0 = 0u, w1 = 0u;
#pragma unroll
                            for (int i = 0; i < 4; ++i) {
                                w0 = __builtin_amdgcn_cvt_pk_u8_f32(__builtin_amdgcn_rcpf(__builtin_fmaf(__builtin_amdgcn_exp2f(v0[i] * wsc), 1.0f / 255.0f, 1.0f / 255.0f)), i, w0);
                                w1 = __builtin_amdgcn_cvt_pk_u8_f32(__builtin_amdgcn_rcpf(__builtin_fmaf(__builtin_amdgcn_exp2f(v1[i] * wsc), 1.0f / 255.0f, 1.0f / 255.0f)), i, w1); }
                            w[2 * bj] = w0; w[2 * bj + 1] = w1;
                        }
                        *(u32x4*)(dst + (size_t)r * 1024 + colt + 16 * fq) = w;
                    }
            }
        }
    }
};
struct EpiMerge {
    static constexpr bool PERM = true;
    const unsigned char* SGA; const unsigned char* SGB; h16_t* MG;
    __device__ __forceinline__ void operator()(const f32x4 (&acc)[2][2][4][2], const pg8::Unit& u, int wr, int wc, int fr, int fq) const {
        asm volatile("" : "+v"(fr), "+v"(fq));
        const int row0 = u.pm * 256 + wr * 64 + fr, col0 = u.pn * 128 + wc * 32 + 8 * fq;
#pragma unroll
        for (int ai = 0; ai < 2; ++ai) {
            u32x2 gas[2][4], gbs[2][4];
#pragma unroll
            for (int m = 0; m < 4; ++m) { const size_t off = (size_t)(row0 + ai * 128 + m * 16) * 1024 + col0; gas[ai][m] = *(const u32x2*)(SGA + off); gbs[ai][m] = *(const u32x2*)(SGB + off); }
            __builtin_amdgcn_sched_barrier(0);
#pragma unroll
            for (int m = 0; m < 4; ++m) {
                const size_t off = (size_t)(row0 + ai * 128 + m * 16) * 1024 + col0;
                const u32x2 ga = gas[ai][m], gb = gbs[ai][m];
                float q[8];
#pragma unroll
                for (int e = 0; e < 8; ++e) {
                    const float a = (float)((ga[e >> 2] >> (8 * (e & 3))) & 0xffu), b = (float)((gb[e >> 2] >> (8 * (e & 3))) & 0xffu);
                    q[e] = (a * acc[ai][0][m][e >> 2][e & 3] + b * acc[ai][1][m][e >> 2][e & 3]) * (1.0f / 255.0f);
                }
                u32x4 w; w.x = pk2h(q[0], q[1]); w.y = pk2h(q[2], q[3]); w.z = pk2h(q[4], q[5]); w.w = pk2h(q[6], q[7]);
                *(u32x4*)(MG + off) = w;
            }
            __builtin_amdgcn_sched_barrier(0);
        }
    }
};
struct EpiOut {
    static constexpr bool PERM = false;
    const float* xp; long xs_delta; const float* gate; float* out;
    __device__ __forceinline__ void operator()(const f32x4 (&acc)[2][2][4][2], const pg8::Unit& u, int wr, int wc, int fr, int fq) const {
        asm volatile("" : "+v"(fr), "+v"(fq));
        const int row0 = u.pm * 256 + wr * 64 + fr, col0 = u.pn * 256 + wc * 32 + 4 * fq;
        const float* grow = gate + ((u.pm * 256) >> 13) * DM;
        f32x4 gvs[2][2];
#pragma unroll
        for (int bj = 0; bj < 2; ++bj)
#pragma unroll
            for (int n = 0; n < 2; ++n) gvs[bj][n] = *(const f32x4*)(grow + col0 + bj * 128 + n * 16);
#pragma unroll
        for (int aim = 0; aim < 4; ++aim) { const int ai = aim >> 1, m0 = (aim & 1) * 2;
            f32x4 xvs[4][2][2];
#pragma unroll
            for (int m = m0; m < m0 + 2; ++m) {
                const int r = row0 + ai * 128 + m * 16;
                const float* xrow = (const float*)((const char*)(xp + (size_t)r * DM) + (r >= TOKP ? xs_delta : 0l));
#pragma unroll
                for (int bj = 0; bj < 2; ++bj)
#pragma unroll
                    for (int n = 0; n < 2; ++n) xvs[m][bj][n] = *(const f32x4*)(xrow + col0 + bj * 128 + n * 16);
            }
            __builtin_amdgcn_sched_barrier(0);
#pragma unroll
            for (int m = m0; m < m0 + 2; ++m) {
                const int r = row0 + ai * 128 + m * 16;
#pragma unroll
                for (int bj = 0; bj < 2; ++bj)
#pragma unroll
                    for (int n = 0; n < 2; ++n) {
                        const int c = col0 + bj * 128 + n * 16;
                        *(f32x4*)(out + (size_t)r * DM + c) = xvs[m][bj][n] + gvs[bj][n] * acc[ai][bj][m][n];
                    }
            }
            __builtin_amdgcn_sched_barrier(0);
        }
    }
};

namespace att {
constexpr int NW = 8, QBLK = 32, QB = QBLK * NW, KVBLK = 64, NT = SEQ / KVBLK;
constexpr int NSLOT = 3, SLOTB = 8192;
constexpr int NS8 = 6, SB8 = 4096;
constexpr int LDS_K = 0, LDS_V = NSLOT * SLOTB, LDS_WS = LDS_V + NSLOT * 2 * SLOTB, LDS_OST = LDS_WS + NW * 64 * 4, OST_WAVE = 8192, LDS_BYTES = LDS_OST + NW * OST_WAVE;
__device__ __forceinline__ int crow(int r, int hi) { return (r & 3) + 8 * (r >> 2) + 4 * hi; }
#define SBAR() __builtin_amdgcn_sched_barrier(0)
__device__ __forceinline__ void glds16(const void* gsrc, unsigned lds_dst) { unsigned keep;
    asm volatile("s_mov_b32 %0, m0\n\ts_mov_b32 m0, %2\n\ts_nop 0\n\tglobal_load_lds_dwordx4 %1, off\n\ts_mov_b32 m0, %0" : "=&s"(keep) : "v"(gsrc), "s"(lds_dst) : "memory"); }
__device__ __forceinline__ float max3f(float a, float b, float c) { float r; asm("v_max3_f32 %0, %1, %2, %3" : "=v"(r) : "v"(a), "v"(b), "v"(c)); return r; }
__device__ __forceinline__ float max2f(float a, float b) { float r; asm("v_max_f32_e32 %0, %1, %2" : "=v"(r) : "v"(a), "v"(b)); return r; }
__device__ __forceinline__ float fadd_s(float a, float b) { float r; asm("v_add_f32_e32 %0, %1, %2" : "=v"(r) : "v"(a), "v"(b)); return r; }
__device__ __forceinline__ float fsub_s(float a, float b) { float r; asm("v_sub_f32_e32 %0, %1, %2" : "=v"(r) : "v"(a), "v"(b)); return r; }
#define WAIT_BAR(N) asm volatile("s_waitcnt vmcnt(" #N ") lgkmcnt(0)\n\ts_barrier" ::: "memory")
__device__ __forceinline__ void qkt(f32x16& p0, f32x16& p1, const char* Kslot, const f16x8* qr, const f32x16& negm, int r32, int hi) {
    const char* kb = Kslot + hi * 1024 + r32 * 16;
#pragma unroll
    for (int d0 = 0; d0 < 4; ++d0) {
        const f16x8 b0 = *reinterpret_cast<const f16x8*>(kb + d0 * 2048);
        const f16x8 b1 = *reinterpret_cast<const f16x8*>(kb + d0 * 2048 + 512);
        if (d0 == 0) { p0 = MFMA32(b0, qr[0], negm); p1 = MFMA32(b1, qr[0], negm); }
        else { p0 = MFMA32(b0, qr[d0], p0); p1 = MFMA32(b1, qr[d0], p1); } }
}
typedef LAS const char* lds_cptr;
typedef short v4i16_t __attribute__((ext_vector_type(4)));
__device__ __forceinline__ void kload8(f16x8* kf, lds_cptr kp) {
    kf[0] = *(const LAS f16x8*)(kp);        kf[1] = *(const LAS f16x8*)(kp + 512);
    kf[2] = *(const LAS f16x8*)(kp + 2048); kf[3] = *(const LAS f16x8*)(kp + 2560);
    kf[4] = *(const LAS f16x8*)(kp + 4096); kf[5] = *(const LAS f16x8*)(kp + 4608);
    kf[6] = *(const LAS f16x8*)(kp + 6144); kf[7] = *(const LAS f16x8*)(kp + 6656);
}
__device__ __forceinline__ void kload2(f16x8* kf, lds_cptr kp, int j) { kf[2 * j] = *(const LAS f16x8*)(kp + j * 2048); kf[2 * j + 1] = *(const LAS f16x8*)(kp + j * 2048 + 512); }
__device__ __forceinline__ s16x4 vtr(lds_cptr p) { return __builtin_bit_cast(s16x4, __builtin_amdgcn_ds_read_tr16_b64_v4i16((LAS v4i16_t*)p)); }
__device__ __forceinline__ float rowmax(const f32x16& p0, const f32x16& p1) {
    float a = max3f(p0[0], p0[1], p1[0]), b = max3f(p0[2], p0[3], p1[1]); a = max3f(a, p1[2], p1[3]);
#pragma unroll
    for (int r = 4; r < 16; r += 4) { a = max3f(a, p0[r], p0[r + 1]); b = max3f(b, p0[r + 2], p0[r + 3]); a = max3f(a, p1[r], p1[r + 1]); b = max3f(b, p1[r + 2], p1[r + 3]); }
    const float m = max2f(a, b);
    auto rr = __builtin_amdgcn_permlane32_swap(__float_as_uint(m), __float_as_uint(m), false, false);
    return max2f(__uint_as_float(rr[0]), __uint_as_float(rr[1]));
}
__device__ __forceinline__ f16x8 mk8(s16x4 lo, s16x4 hi) { typedef short s16x8 __attribute__((ext_vector_type(8))); s16x8 v = {lo[0], lo[1], lo[2], lo[3], hi[0], hi[1], hi[2], hi[3]}; return __builtin_bit_cast(f16x8, v); }
__device__ __forceinline__ void pv(f32x16* o, int vb, f16x8 pa0, f16x8 pa1, f16x8 pa2, f16x8 pa3) {
#pragma unroll
    for (int d0 = 0; d0 < 2; ++d0) { s16x4 lo[4], hi[4];
#pragma unroll
        for (int ks = 0; ks < 4; ++ks) {
            asm volatile("ds_read_b64_tr_b16 %0,%1 offset:%c2" : "=&v"(lo[ks]) : "v"(vb), "i"(d0 * 4096 + ks * 1024) : "memory");
            asm volatile("ds_read_b64_tr_b16 %0,%1 offset:%c2" : "=&v"(hi[ks]) : "v"(vb), "i"(d0 * 4096 + ks * 1024 + 512) : "memory"); }
        asm volatile("s_waitcnt lgkmcnt(0)" ::: "memory"); SBAR();
        o[d0] = MFMA32(pa0, mk8(lo[0], hi[0]), o[d0]);
        o[d0] = MFMA32(pa1, mk8(lo[1], hi[1]), o[d0]);
        o[d0] = MFMA32(pa2, mk8(lo[2], hi[2]), o[d0]);
        o[d0] = MFMA32(pa3, mk8(lo[3], hi[3]), o[d0]);
    }
}
template <int THRL, bool FAST> __device__ __forceinline__ void attn_pass(const h16_t* Qw, int QP, const h16_t* Kh, int KP, const h16_t* Vh, int VP, char* shm, f32x16 (&o)[2], float& l_out, int wave_in) {
    int tid = wave_in * 64 + lane_id(); asm volatile("" : "+v"(tid));
    const int lane = tid & 63, r32 = lane & 31, hi = lane >> 5; const int wid = wave_in;
    const unsigned lds0 = (unsigned)(uintptr_t)shm;
    float* wsf = (float*)(shm + LDS_WS) + wid * 64;
    const h16_t* ksrc = Kh + (long)lane * KP + wid * 8;
    const h16_t* vsrc = Vh + (long)(16 * (wid & 3) + (lane >> 2)) * VP + (wid >> 2) * 32 + (lane & 3) * 8;
    const unsigned kdst = lds0 + LDS_K + wid * 1024, vdst = lds0 + LDS_V + wid * 1024;
#define DMA_K(t, slot) glds16(ksrc + (long)(t) * KVBLK * KP, (unsigned)__builtin_amdgcn_readfirstlane(kdst + (slot)))
#define DMA_V(t, slot) glds16(vsrc + (long)(t) * KVBLK * VP, (unsigned)__builtin_amdgcn_readfirstlane(vdst + (slot)))
    const int vb0 = (int)(lds0 + LDS_V) + ((lane >> 4) & 1) * 32 + (lane & 3) * 8 + (4 * hi + ((lane & 15) >> 2)) * 64;
    const char* Kbase = shm + LDS_K; f16x8 kf[8];
    const lds_cptr shm3 = (lds_cptr)shm; const lds_cptr kp0 = shm3 + LDS_K + hi * 1024 + r32 * 16; const lds_cptr vp0 = shm3 + LDS_V + ((lane >> 4) & 1) * 32 + (lane & 3) * 8 + (4 * hi + ((lane & 15) >> 2)) * 64;
    DMA_K(0, 0); DMA_V(0, 0); DMA_K(1, SLOTB);
    f16x8 qr[4];
#pragma unroll
    for (int d0 = 0; d0 < 4; ++d0) qr[d0] = *reinterpret_cast<const f16x8*>(&Qw[(long)r32 * QP + d0 * 16 + hi * 8]);
    float mhat = 0.f, l_reg = 0.f; o[0] = f32x16{}; o[1] = f32x16{}; f32x16 negm = f32x16{}; if constexpr (!FAST) asm volatile("" : "+v"(negm));
    bool resc = false;
#define NEGM (FAST ? f32x16{} : negm)
#define START(P0, P1) do { if constexpr (!FAST) { const float rm = rowmax(P0, P1); resc = false; \
    { const float dl = rm; mhat = fadd_s(mhat, dl); \
      _Pragma("unroll") for (int r = 0; r < 16; ++r) { P0[r] = fsub_s(P0[r], dl); P1[r] = fsub_s(P1[r], dl); } \
      _Pragma("unroll") for (int r = 0; r < 16; ++r) negm[r] = -mhat; asm volatile("" : "+v"(negm)); } } \
    _Pragma("unroll") for (int r = 0; r < 16; ++r) P0[r] = __builtin_amdgcn_exp2f(P0[r]); } while (0)
#define RESC() do { if constexpr (!FAST) { if (resc) { asm volatile("s_waitcnt lgkmcnt(0)" ::: "memory"); \
      _Pragma("unroll") for (int d_ = 0; d_ < 2; ++d_) _Pragma("unroll") for (int r = 0; r < 16; ++r) o[d_][r] *= wsf[crow(r, hi)]; } } } while (0)
    f32x16 pA0, pA1, pB0, pB1;
    int sl_prev = 0, sl_cur = 0, sl_next = SLOTB;
#define ROT() do { sl_prev = sl_cur; sl_cur = sl_next; sl_next = (sl_next == (NSLOT - 1) * SLOTB) ? 0 : sl_next + SLOTB; } while (0)
    DMA_K(2, 2 * SLOTB);
    WAIT_BAR(3);
    qkt(pA0, pA1, Kbase, qr, NEGM, r32, hi); asm volatile("s_nop 15\n\ts_nop 7" : "+v"(pA0), "+v"(pA1));
    START(pA0, pA1);
    _Pragma("unroll") for (int r = 0; r < 16; ++r) pA1[r] = __builtin_amdgcn_exp2f(pA1[r]);
    WAIT_BAR(0);
    DMA_K(3, 0); DMA_V(1, SLOTB);
    ROT();
    kload8(kf, kp0 + sl_cur);
    WAIT_BAR(2);
    s16x4 vlo[8], vhi[8]; u32x4 pw0, pw1, pw2, pw3;
#define PKW(P, B) pk2h(P[B], P[B + 1])
#define PAF(k) __builtin_bit_cast(f16x8, pw##k)
#define VFR(i) mk8(vlo[i], vhi[i])
#define PIN(x) asm volatile("" : "+v"(x))
#define MX3(a, b, c) __builtin_fmaxf(__builtin_fmaxf((a), (b)), (c))
#define GAPA(MF, A0, A1, A2, A3, W0, W1, PW) do { MF; sacc += A0; sacc += A1; sacc += A2; sacc += A3; PIN(sacc); W0; W1; PIN(PW); SBAR(); } while (0)
#define EX(v) __builtin_amdgcn_exp2f(v)
#define GAPB(MF, X, B) do { MF; X[B] = EX(X[B]); X[B + 1] = EX(X[B + 1]); X[B + 2] = EX(X[B + 2]); X[B + 3] = EX(X[B + 3]); PIN(X); SBAR(); } while (0)
#define VRD(i) do { vlo[i] = vtr(vp_ + (((i) >> 2) * 4096 + ((i) & 3) * 1024)); vhi[i] = vtr(vp_ + (((i) >> 2) * 4096 + ((i) & 3) * 1024 + 512)); } while (0)
#define KRD(G, j) do { if (G) { kload2(kf, kp0 + sl_next, j); SBAR(); } } while (0)
#define STEP(C0, C1, P0, P1, t, GK, GV, GL) do { SBAR(); \
    const lds_cptr vp_ = vp0 + sl_prev; \
    if constexpr (FAST) { if (GK) { DMA_K((t) + 3, sl_cur); } } \
    VRD(0); SBAR(); float sacc = (P0[0] + P0[1]); \
    GAPA(C0 = MFMA32(kf[0], qr[0], NEGM), P0[2], P0[3], P0[4], P0[5],     pw0[0] = PKW(P0, 0), pw0[1] = PKW(P0, 2), pw0); \
    if constexpr (FAST) { if (GV) { DMA_V((t) + 1, sl_next); } } \
    VRD(4); SBAR(); GAPA(C1 = MFMA32(kf[1], qr[0], NEGM), P0[6], P0[7], P0[8], P0[9],     pw0[2] = PKW(P0, 4), pw0[3] = PKW(P0, 6), pw0); \
    VRD(1); SBAR(); GAPA(C0 = MFMA32(kf[2], qr[1], C0),   P0[10], P0[11], P0[12], P0[13], pw1[0] = PKW(P0, 8), pw1[1] = PKW(P0, 10), pw1); \
    VRD(5); SBAR(); GAPA(C1 = MFMA32(kf[3], qr[1], C1),   P0[14], P0[15], P1[0], P1[1],   pw1[2] = PKW(P0, 12), pw1[3] = PKW(P0, 14), pw1); \
    VRD(2); SBAR(); GAPA(C0 = MFMA32(kf[4], qr[2], C0),   P1[2], P1[3], P1[4], P1[5],     pw2[0] = PKW(P1, 0), pw2[1] = PKW(P1, 2), pw2); \
    VRD(6); SBAR(); GAPA(C1 = MFMA32(kf[5], qr[2], C1),   P1[6], P1[7], P1[8], P1[9],     pw2[2] = PKW(P1, 4), pw2[3] = PKW(P1, 6), pw2); \
    VRD(3); SBAR(); GAPA(C0 = MFMA32(kf[6], qr[3], C0),   P1[10], P1[11], P1[12], P1[13], pw3[0] = PKW(P1, 8), pw3[1] = PKW(P1, 10), pw3); \
    VRD(7); SBAR(); GAPA(C1 = MFMA32(kf[7], qr[3], C1),   P1[14], P1[15], 0.f, 0.f,       pw3[2] = PKW(P1, 12), pw3[3] = PKW(P1, 14), pw3); \
    l_reg += sacc; \
    if constexpr (!FAST) { \
    if (GK) { DMA_K((t) + 3, sl_cur); } if (GV) { DMA_V((t) + 1, sl_next); } \
    { float a = MX3(C0[0], C0[1], C1[0]), b = MX3(C0[2], C0[3], C1[1]); a = MX3(a, C1[2], C1[3]); \
      _Pragma("unroll") for (int r = 4; r < 16; r += 4) { a = MX3(a, C0[r], C0[r + 1]); b = MX3(b, C0[r + 2], C0[r + 3]); a = MX3(a, C1[r], C1[r + 1]); b = MX3(b, C1[r + 2], C1[r + 3]); } \
      float rm = __builtin_fmaxf(a, b); { auto rr = __builtin_amdgcn_permlane32_swap(__float_as_uint(rm), __float_as_uint(rm), false, false); rm = __builtin_fmaxf(__uint_as_float(rr[0]), __uint_as_float(rr[1])); } \
      resc = false; \
      if (__builtin_expect(__any(rm > (float)THRL), 0)) { const float dl = __builtin_fmaxf(rm, 0.f); mhat += dl; \
        _Pragma("unroll") for (int r = 0; r < 16; ++r) { C0[r] -= dl; C1[r] -= dl; } \
        _Pragma("unroll") for (int r = 0; r < 16; ++r) negm[r] = -mhat; asm volatile("" : "+v"(negm)); \
        const float f = __builtin_amdgcn_exp2f(-dl); l_reg *= f; if (hi == 0) wsf[r32] = f; resc = true; } } } \
    SBAR(); \
    GAPB(o[0] = MFMA32(PAF(0), VFR(0), o[0]), C0, 0); \
    GAPB(o[1] = MFMA32(PAF(0), VFR(4), o[1]), C0, 4); \
    KRD(GL, 0); GAPB(o[0] = MFMA32(PAF(1), VFR(1), o[0]), C0, 8); \
    KRD(GL, 1); GAPB(o[1] = MFMA32(PAF(1), VFR(5), o[1]), C0, 12); \
    KRD(GL, 2); GAPB(o[0] = MFMA32(PAF(2), VFR(2), o[0]), C1, 0); \
    KRD(GL, 3); GAPB(o[1] = MFMA32(PAF(2), VFR(6), o[1]), C1, 4); \
    GAPB(o[0] = MFMA32(PAF(3), VFR(3), o[0]), C1, 8); \
    GAPB(o[1] = MFMA32(PAF(3), VFR(7), o[1]), C1, 12); \
    } while (0)
    int t = 1;
    for (; t + 5 < NT; t += 2) {
        STEP(pB0, pB1, pA0, pA1, t, true, true, true);     WAIT_BAR(2); RESC(); ROT();
        STEP(pA0, pA1, pB0, pB1, t + 1, true, true, true); WAIT_BAR(2); RESC(); ROT();
    }
#define ENDW(tt) do { if ((tt) + 3 < NT) { WAIT_BAR(2); } else if ((tt) + 2 < NT) { WAIT_BAR(1); } else { WAIT_BAR(0); } } while (0)
    for (; t + 1 < NT; t += 2) {
        STEP(pB0, pB1, pA0, pA1, t, (t + 3 < NT), (t + 1 < NT), (t + 1 < NT));         ENDW(t);     RESC(); ROT();
        STEP(pA0, pA1, pB0, pB1, t + 1, (t + 4 < NT), (t + 2 < NT), (t + 2 < NT));     ENDW(t + 1); RESC(); ROT();
    }
    STEP(pB0, pB1, pA0, pA1, NT - 1, false, false, false); RESC();
    { float sacc = pB0[0] + pB0[1]; _Pragma("unroll") for (int r = 2; r < 16; ++r) sacc += pB0[r]; _Pragma("unroll") for (int r = 0; r < 16; ++r) sacc += pB1[r]; l_reg += sacc;
      pw0 = (u32x4){PKW(pB0, 0), PKW(pB0, 2), PKW(pB0, 4), PKW(pB0, 6)}; pw1 = (u32x4){PKW(pB0, 8), PKW(pB0, 10), PKW(pB0, 12), PKW(pB0, 14)}; pw2 = (u32x4){PKW(pB1, 0), PKW(pB1, 2), PKW(pB1, 4), PKW(pB1, 6)}; pw3 = (u32x4){PKW(pB1, 8), PKW(pB1, 10), PKW(pB1, 12), PKW(pB1, 14)};
      SBAR(); pv(o, vb0 + sl_cur, PAF(0), PAF(1), PAF(2), PAF(3)); }
#undef PKW
#undef PAF
#undef VFR
#undef PIN
#undef MX3
#undef GAPA
#undef GAPB
#undef EX
#undef VRD
#undef KRD
#undef STEP
#undef ENDW
    { auto rr = __builtin_amdgcn_permlane32_swap(__float_as_uint(l_reg), __float_as_uint(l_reg), false, false); l_reg = __uint_as_float(rr[0]) + __uint_as_float(rr[1]); }
    l_out = l_reg;
    asm volatile("s_waitcnt lgkmcnt(0)\n\ts_barrier" ::: "memory");
#undef DMA_K
#undef DMA_V
#undef START
#undef NEGM
#undef RESC
#undef ROT
}

__device__ __forceinline__ void pv128(f32x16* o, int vb, f16x8 pa0, f16x8 pa1, f16x8 pa2, f16x8 pa3) {
#pragma unroll
    for (int d0 = 0; d0 < 4; ++d0) { s16x4 lo[4], hi[4];
#pragma unroll
        for (int ks = 0; ks < 4; ++ks) {
            asm volatile("ds_read_b64_tr_b16 %0,%1 offset:%c2" : "=&v"(lo[ks]) : "v"(vb), "i"(d0 * 4096 + ks * 1024) : "memory");
            asm volatile("ds_read_b64_tr_b16 %0,%1 offset:%c2" : "=&v"(hi[ks]) : "v"(vb), "i"(d0 * 4096 + ks * 1024 + 512) : "memory"); }
        asm volatile("s_waitcnt lgkmcnt(0)" ::: "memory"); SBAR();
        o[d0] = MFMA32(pa0, mk8(lo[0], hi[0]), o[d0]);
        o[d0] = MFMA32(pa1, mk8(lo[1], hi[1]), o[d0]);
        o[d0] = MFMA32(pa2, mk8(lo[2], hi[2]), o[d0]);
        o[d0] = MFMA32(pa3, mk8(lo[3], hi[3]), o[d0]);
    }
}
template <int THRL, bool FAST> __device__ __forceinline__ void attn_pass128(const h16_t* Qw, int QP, const h16_t* Kh, int KP, const h16_t* Vh, int VP, char* shm, f32x16 (&o)[4], float& l_out, int wave_in) {
    int tid = wave_in * 64 + lane_id(); asm volatile("" : "+v"(tid));
    const int lane = tid & 63, r32 = lane & 31, hi = lane >> 5; const int wid = wave_in;
    const unsigned lds0 = (unsigned)(uintptr_t)shm;
    float* wsf = (float*)(shm + LDS_WS) + wid * 64;
    const h16_t* ksrc = Kh + (long)lane * KP + wid * 8;
    const h16_t* vsrc = Vh + (long)(16 * (wid & 3) + (lane >> 2)) * VP + (wid >> 2) * 32 + (lane & 3) * 8;
    const unsigned kdst = lds0 + LDS_K + wid * 1024, vdst = lds0 + LDS_V + wid * 1024;
#define DMA_K(t, slot) glds16(ksrc + (long)(t) * KVBLK * KP, (unsigned)__builtin_amdgcn_readfirstlane(kdst + (slot)))
#define DMA_V(t, slot) do { glds16(vsrc + (long)(t) * KVBLK * VP, (unsigned)__builtin_amdgcn_readfirstlane(vdst + (slot))); glds16(vsrc + (long)(t) * KVBLK * VP + 64, (unsigned)__builtin_amdgcn_readfirstlane(vdst + (slot) + 8192)); } while (0)
    const int vb0 = (int)(lds0 + LDS_V) + ((lane >> 4) & 1) * 32 + (lane & 3) * 8 + (4 * hi + ((lane & 15) >> 2)) * 64;
    const char* Kbase = shm + LDS_K; f16x8 kf[8];
    const lds_cptr shm3 = (lds_cptr)shm; const lds_cptr kp0 = shm3 + LDS_K + hi * 1024 + r32 * 16; const lds_cptr vp0 = shm3 + LDS_V + ((lane >> 4) & 1) * 32 + (lane & 3) * 8 + (4 * hi + ((lane & 15) >> 2)) * 64;
    DMA_K(0, 0); DMA_V(0, 0); DMA_K(1, SLOTB);
    f16x8 qr[4];
#pragma unroll
    for (int d0 = 0; d0 < 4; ++d0) qr[d0] = *reinterpret_cast<const f16x8*>(&Qw[(long)r32 * QP + d0 * 16 + hi * 8]);
    float mhat = 0.f, l_reg = 0.f; o[0] = f32x16{}; o[1] = f32x16{}; o[2] = f32x16{}; o[3] = f32x16{}; f32x16 negm = f32x16{}; if constexpr (!FAST) asm volatile("" : "+v"(negm));
    bool resc = false;
#define NEGM (FAST ? f32x16{} : negm)
#define RESC() do { if constexpr (!FAST) if (resc) { asm volatile("s_waitcnt lgkmcnt(0)" ::: "memory"); \
      _Pragma("unroll") for (int d_ = 0; d_ < 4; ++d_) _Pragma("unroll") for (int r = 0; r < 16; ++r) o[d_][r] *= wsf[crow(r, hi)]; } } while (0)
    f32x16 C0, C1; u32x4 pA0, pA1, pA2, pA3, pB0, pB1, pB2, pB3;
    int sl_prev = 0, sl_cur = 0, sl_next = SLOTB;
#define ROT() do { sl_prev = sl_cur; sl_cur = sl_next; sl_next = (sl_next == (NSLOT - 1) * SLOTB) ? 0 : sl_next + SLOTB; } while (0)
    DMA_K(2, 2 * SLOTB);
    WAIT_BAR(3);
    qkt(C0, C1, Kbase, qr, NEGM, r32, hi); asm volatile("s_nop 15\n\ts_nop 7" : "+v"(C0), "+v"(C1));
    { float rm = 0.f; if constexpr (!FAST) { rm = rowmax(C0, C1); mhat = rm; }
      _Pragma("unroll") for (int r = 0; r < 16; ++r) { C0[r] = __builtin_amdgcn_exp2f(C0[r] - rm); C1[r] = __builtin_amdgcn_exp2f(C1[r] - rm); }
      if constexpr (!FAST) { _Pragma("unroll") for (int r = 0; r < 16; ++r) negm[r] = -mhat; asm volatile("" : "+v"(negm)); }
      float sacc = 0.f; _Pragma("unroll") for (int r = 0; r < 16; ++r) sacc += C0[r] + C1[r]; l_reg = sacc;
      pA0 = (u32x4){pk2h(C0[0], C0[1]), pk2h(C0[2], C0[3]), pk2h(C0[4], C0[5]), pk2h(C0[6], C0[7])}; pA1 = (u32x4){pk2h(C0[8], C0[9]), pk2h(C0[10], C0[11]), pk2h(C0[12], C0[13]), pk2h(C0[14], C0[15])};
      pA2 = (u32x4){pk2h(C1[0], C1[1]), pk2h(C1[2], C1[3]), pk2h(C1[4], C1[5]), pk2h(C1[6], C1[7])}; pA3 = (u32x4){pk2h(C1[8], C1[9]), pk2h(C1[10], C1[11]), pk2h(C1[12], C1[13]), pk2h(C1[14], C1[15])}; }
    WAIT_BAR(0);
    DMA_K(3, 0); DMA_V(1, 2 * SLOTB);
    ROT();
    kload8(kf, kp0 + sl_cur);
    WAIT_BAR(3);
    s16x4 vlo[16], vhi[16];
#define PAFW(w) __builtin_bit_cast(f16x8, w)
#define VFR(i) mk8(vlo[i], vhi[i])
#define PIN(x) asm volatile("" : "+v"(x))
#define MX3(a, b, c) __builtin_fmaxf(__builtin_fmaxf((a), (b)), (c))
#define EX(v) __builtin_amdgcn_exp2f(v)
#define VRD(i) do { vlo[i] = vtr(vp_ + (((i) >> 2) * 4096 + ((i) & 3) * 1024)); vhi[i] = vtr(vp_ + (((i) >> 2) * 4096 + ((i) & 3) * 1024 + 512)); } while (0)
#define KRD(G, j) do { if (G) { kload2(kf, kp0 + sl_next, j); } } while (0)
#define QK1(PRE, CC, KF, QR, CI) do { PRE; SBAR(); CC = MFMA32(KF, QR, CI); SBAR(); } while (0)
#define NOP_ do { } while (0)
#define GB0(PRE, OA, PW, FI, X, B) do { PRE; SBAR(); OA = MFMA32(PAFW(PW), VFR(FI), OA); X[B] = EX(X[B]); X[B + 1] = EX(X[B + 1]); PIN(X); SBAR(); } while (0)
#define GB(PRE, OA, PW, FI, X, B, Y, YB, PN, W) do { PRE; SBAR(); OA = MFMA32(PAFW(PW), VFR(FI), OA); X[B] = EX(X[B]); X[B + 1] = EX(X[B + 1]); PIN(X); \
    sacc += Y[YB]; sacc += Y[YB + 1]; PN[W] = pk2h(Y[YB], Y[YB + 1]); PIN(sacc); PIN(PN); SBAR(); } while (0)
#define STEP128(PC0, PC1, PC2, PC3, PN0, PN1, PN2, PN3, t, GK, GV, GL) do { SBAR(); \
    const lds_cptr vp_ = vp0 + 2 * sl_prev; \
    QK1(if constexpr (FAST) { if (GK) { DMA_K((t) + 3, sl_cur); } }, C0, kf[0], qr[0], NEGM); \
    QK1(if constexpr (FAST) { if (GV) { DMA_V((t) + 1, 2 * sl_next); } }, C1, kf[1], qr[0], NEGM); \
    QK1(NOP_,    C0, kf[2], qr[1], C0); \
    QK1(NOP_,    C1, kf[3], qr[1], C1); \
    QK1(VRD(0),  C0, kf[4], qr[2], C0); \
    QK1(VRD(4),  C1, kf[5], qr[2], C1); \
    QK1(VRD(8),  C0, kf[6], qr[3], C0); \
    QK1(VRD(12), C1, kf[7], qr[3], C1); \
    if constexpr (!FAST) { \
    if (GK) { DMA_K((t) + 3, sl_cur); } if (GV) { DMA_V((t) + 1, 2 * sl_next); } \
    { float a = MX3(C0[0], C0[1], C1[0]), b = MX3(C0[2], C0[3], C1[1]); a = MX3(a, C1[2], C1[3]); \
      _Pragma("unroll") for (int r = 4; r < 16; r += 4) { a = MX3(a, C0[r], C0[r + 1]); b = MX3(b, C0[r + 2], C0[r + 3]); a = MX3(a, C1[r], C1[r + 1]); b = MX3(b, C1[r + 2], C1[r + 3]); } \
      float rm = __builtin_fmaxf(a, b); { auto rr = __builtin_amdgcn_permlane32_swap(__float_as_uint(rm), __float_as_uint(rm), false, false); rm = __builtin_fmaxf(__uint_as_float(rr[0]), __uint_as_float(rr[1])); } \
      resc = false; \
      if (__builtin_expect(__any(rm > (float)THRL), 0)) { const float dl = __builtin_fmaxf(rm, 0.f); mhat += dl; \
        _Pragma("unroll") for (int r = 0; r < 16; ++r) { C0[r] -= dl; C1[r] -= dl; } \
        _Pragma("unroll") for (int r = 0; r < 16; ++r) negm[r] = -mhat; asm volatile("" : "+v"(negm)); \
        const float f = __builtin_amdgcn_exp2f(-dl); l_reg *= f; if (hi == 0) wsf[r32] = f; resc = true; } } } \
    SBAR(); float sacc = 0.f; \
    GB0(VRD(1),  o[0], PC0, 0,  C0, 0); \
    GB(VRD(5),   o[1], PC0, 4,  C0, 2,  C0, 0,  PN0, 0); \
    GB(VRD(9),   o[2], PC0, 8,  C0, 4,  C0, 2,  PN0, 1); \
    GB(VRD(13),  o[3], PC0, 12, C0, 6,  C0, 4,  PN0, 2); \
    GB(VRD(2),   o[0], PC1, 1,  C0, 8,  C0, 6,  PN0, 3); \
    GB(VRD(6),   o[1], PC1, 5,  C0, 10, C0, 8,  PN1, 0); \
    GB(VRD(10),  o[2], PC1, 9,  C0, 12, C0, 10, PN1, 1); \
    GB(VRD(14),  o[3], PC1, 13, C0, 14, C0, 12, PN1, 2); \
    GB(VRD(3),   o[0], PC2, 2,  C1, 0,  C0, 14, PN1, 3); \
    GB(VRD(7),   o[1], PC2, 6,  C1, 2,  C1, 0,  PN2, 0); \
    GB(VRD(11),  o[2], PC2, 10, C1, 4,  C1, 2,  PN2, 1); \
    GB(VRD(15),  o[3], PC2, 14, C1, 6,  C1, 4,  PN2, 2); \
    GB(KRD(GL, 0), o[0], PC3, 3,  C1, 8,  C1, 6,  PN2, 3); \
    GB(KRD(GL, 1), o[1], PC3, 7,  C1, 10, C1, 8,  PN3, 0); \
    GB(KRD(GL, 2), o[2], PC3, 11, C1, 12, C1, 10, PN3, 1); \
    GB(KRD(GL, 3), o[3], PC3, 15, C1, 14, C1, 12, PN3, 2); \
    sacc += C1[14]; sacc += C1[15]; PN3[3] = pk2h(C1[14], C1[15]); l_reg += sacc; \
    } while (0)
    int t = 1;
    for (; t + 5 < NT; t += 2) {
        STEP128(pA0, pA1, pA2, pA3, pB0, pB1, pB2, pB3, t, true, true, true);     WAIT_BAR(3); RESC(); ROT();
        STEP128(pB0, pB1, pB2, pB3, pA0, pA1, pA2, pA3, t + 1, true, true, true); WAIT_BAR(3); RESC(); ROT();
    }
#define ENDW(tt) do { if ((tt) + 3 < NT) { WAIT_BAR(3); } else if ((tt) + 2 < NT) { WAIT_BAR(2); } else { WAIT_BAR(0); } } while (0)
    for (; t + 1 < NT; t += 2) {
        STEP128(pA0, pA1, pA2, pA3, pB0, pB1, pB2, pB3, t, (t + 3 < NT), (t + 1 < NT), (t + 1 < NT));         ENDW(t);     RESC(); ROT();
        STEP128(pB0, pB1, pB2, pB3, pA0, pA1, pA2, pA3, t + 1, (t + 4 < NT), (t + 2 < NT), (t + 2 < NT));     ENDW(t + 1); RESC(); ROT();
    }
    STEP128(pA0, pA1, pA2, pA3, pB0, pB1, pB2, pB3, NT - 1, false, false, false); RESC();
    SBAR(); pv128(o, vb0 + 2 * sl_cur, PAFW(pB0), PAFW(pB1), PAFW(pB2), PAFW(pB3));
#undef PAFW
#undef VFR
#undef PIN
#undef MX3
#undef EX
#undef VRD
#undef KRD
#undef QK1
#undef NOP_
#undef GB0
#undef GB
#undef STEP128
#undef ENDW
    { auto rr = __builtin_amdgcn_permlane32_swap(__float_as_uint(l_reg), __float_as_uint(l_reg), false, false); l_reg = __uint_as_float(rr[0]) + __uint_as_float(rr[1]); }
    l_out = l_reg;
    asm volatile("s_waitcnt lgkmcnt(0)\n\ts_barrier" ::: "memory");
#undef DMA_K
#undef DMA_V
#undef NEGM
#undef RESC
#undef ROT
}

typedef int v8i __attribute__((ext_vector_type(8)));
#define MFMA8(a, b, c) __builtin_amdgcn_mfma_scale_f32_32x32x64_f8f6f4(a, b, c, 0, 0, 0, 0, 0, 0)
#define MFMA8S(a, b, c) __builtin_amdgcn_mfma_scale_f32_16x16x128_f8f6f4(a, b, c, 0, 0, 0, 0, 0, 0)
#define MFMA6(a, b, c) __builtin_amdgcn_mfma_scale_f32_32x32x64_f8f6f4(a, b, c, 2, 2, 0, sc6, 0, sc6)
__device__ __forceinline__ v8i ld24(lds_cptr p16, lds_cptr p8) { const u32x4 a = *(const LAS u32x4*)p16; const u32x2 b = *(const LAS u32x2*)p8; return (v8i){(int)a.x, (int)a.y, (int)a.z, (int)a.w, (int)b.x, (int)b.y, 0, 0}; }
__device__ __forceinline__ v8i ld32(lds_cptr p0, lds_cptr p1) { const u32x4 a = *(const LAS u32x4*)p0, b = *(const LAS u32x4*)p1; return (v8i){(int)a.x, (int)a.y, (int)a.z, (int)a.w, (int)b.x, (int)b.y, (int)b.z, (int)b.w}; }
template <int NV> __device__ __forceinline__ void attn_first_dma(const unsigned char* Kh8, int KP, const unsigned char* VT, char* shm, int wave_in) {
    int tid = wave_in * 64 + lane_id(); asm volatile("" : "+v"(tid));
    const int lane = tid & 63, wid = wave_in; const bool kw = wid < 4, kwk = wid < 3;
    const unsigned lds0 = (unsigned)(uintptr_t)shm; constexpr int VCH = NV * 512;
    const unsigned char* ksrc = Kh8 + (long)lane * KP + (wid & 3) * 16;
    const unsigned char* vsrc = VT + (long)(lane + ((kw && NV == 4) ? 64 : 0)) * SEQ + (wid & 3) * 16;
    const unsigned kdst = lds0 + LDS_K + (wid & 3) * 1024, vdst = lds0 + LDS_V + (wid & 3) * VCH + ((kw && NV == 4) ? 1024 : 0);
    const bool vw = !kw || NV == 4;
#define FD_K(t) do { if (kwk) glds16(ksrc + (long)(t) * KVBLK * KP, (unsigned)__builtin_amdgcn_readfirstlane(kdst + (t) * SB8)); } while (0)
#define FD_V(t) do { if (vw) glds16(vsrc + (t) * KVBLK, (unsigned)__builtin_amdgcn_readfirstlane(vdst + (t) * 2 * SB8)); } while (0)
    FD_K(0); FD_K(1); FD_V(0); FD_K(2); FD_K(3); FD_V(1); FD_K(4); FD_K(5); FD_V(2); FD_V(3);
#undef FD_K
#undef FD_V
}
template <int NV> __device__ __forceinline__ void attn_pass8(const unsigned char* Qw8, int QP, const unsigned char* Kh8, int KP, const unsigned char* VT, int mI, char* shm, f32x16 (&o)[NV], float& l_out, int wave_in, bool pre = false) {
    int tid = wave_in * 64 + lane_id(); asm volatile("" : "+v"(tid));
    const int lane = tid & 63, r32 = lane & 31, hi = lane >> 5; const int wid = wave_in;
    const unsigned lds0 = (unsigned)(uintptr_t)shm;
    constexpr int VCH = NV * 512;
    const bool kw = wid < 4, kwk = wid < 3;
    const unsigned char* ksrc = Kh8 + (long)lane * KP + (wid & 3) * 16;
    const unsigned char* vsrc = VT + (long)(lane + ((kw && NV == 4) ? 64 : 0)) * SEQ + (wid & 3) * 16;
    const unsigned kdst = lds0 + LDS_K + (wid & 3) * 1024, vdst = lds0 + LDS_V + (wid & 3) * VCH + ((kw && NV == 4) ? 1024 : 0);
#define DMA_K8(t, slot) do { if (kwk) glds16(ksrc + (long)(t) * KVBLK * KP, (unsigned)__builtin_amdgcn_readfirstlane(kdst + (slot))); } while (0)
#define DMA_V8(t, slot) do { if (!kw || NV == 4) glds16(vsrc + (t) * KVBLK, (unsigned)__builtin_amdgcn_readfirstlane(vdst + (slot))); } while (0)
#define OWN_BAR() do { if (kwk && NV == 4) { WAIT_BAR(4); } else { WAIT_BAR(2); } } while (0)
    const lds_cptr shm3 = (lds_cptr)shm;
    const lds_cptr kp0 = shm3 + LDS_K + hi * 1024 + r32 * 16, kq0 = shm3 + LDS_K + 2048 + r32 * 16 + 8 * hi;
    const lds_cptr vp0 = shm3 + LDS_V + (2 * hi) * VCH + r32 * 16;
    if (!pre) attn_first_dma<NV>(Kh8, KP, VT, shm, wave_in);
    v8i q8; { const u32x4 a = *(const u32x4*)(Qw8 + (long)r32 * QP + 16 * hi); const u32x2 b = *(const u32x2*)(Qw8 + (long)r32 * QP + 32 + 8 * hi); q8 = (v8i){(int)a.x, (int)a.y, (int)a.z, (int)a.w, (int)b.x, (int)b.y, 0, 0}; }
    float l_reg = 0.f;
#pragma unroll
    for (int d = 0; d < NV; ++d) o[d] = f32x16{};
    f32x16 cinit; { int mI_ = mI; asm volatile("" : "+s"(mI_)); float cv = 8.0f * (float)(7 - mI_) * (1.0f / 65536.0f); asm volatile("" : "+v"(cv));
#pragma unroll
        for (int r = 0; r < 16; ++r) cinit[r] = cv; }
    asm volatile("" : "+v"(cinit));
    int sc6 = 0x77; asm volatile("" : "+v"(sc6));
    f32x16 C0, C1; v8i pA, pB, kf0, kf1;
    v8i ones8; { int one4 = ((lane & 15) == ((lane >> 4) & 1)) ? 0x38383838 : 0; asm volatile("" : "+v"(one4));
#pragma unroll
        for (int w = 0; w < 8; ++w) ones8[w] = one4; }
    f32x4 lsum = f32x4{};
    int sl_prev = 0, sl_cur = 0, sl_next = SB8;
#define ROT() do { sl_prev = sl_cur; sl_cur = sl_next; sl_next = (sl_next == (NS8 - 1) * SB8) ? 0 : sl_next + SB8; } while (0)
#define SL3() (sl_cur >= 3 * SB8 ? sl_cur - 3 * SB8 : sl_cur + 3 * SB8)
#define KLD(sl) do { kf0 = ld24(kp0 + (sl), kq0 + (sl)); kf1 = ld24(kp0 + (sl) + 512, kq0 + (sl) + 512); } while (0)
#define CODES(PW, w0, w1) do { _Pragma("unroll") for (int w_ = (w0); w_ < (w1); ++w_) { \
      const float c0_ = w_ < 4 ? C0[4 * w_] : C1[4 * (w_ - 4)], c1_ = w_ < 4 ? C0[4 * w_ + 1] : C1[4 * (w_ - 4) + 1], c2_ = w_ < 4 ? C0[4 * w_ + 2] : C1[4 * (w_ - 4) + 2], c3_ = w_ < 4 ? C0[4 * w_ + 3] : C1[4 * (w_ - 4) + 3]; \
      const unsigned x_ = __builtin_bit_cast(unsigned, __builtin_amdgcn_cvt_pknorm_u16(c0_, c1_)), y_ = __builtin_bit_cast(unsigned, __builtin_amdgcn_cvt_pknorm_u16(c2_, c3_));     \
      PW[w_] = (int)__builtin_amdgcn_perm(y_, x_, 0x06040200u); } } while (0)
    asm volatile("s_waitcnt vmcnt(0) lgkmcnt(0)\n\ts_barrier" ::: "memory");
    KLD(0);
    C0 = MFMA6(kf0, q8, cinit); C1 = MFMA6(kf1, q8, cinit);
    CODES(pA, 0, 8);
    ROT();
    KLD(sl_cur);
    WAIT_BAR(0);
#define VLD(db) ld32(vp_ + (db) * 512, vp_ + (db) * 512 + VCH)
#define PINV(x) asm volatile("" : "+v"(x))
#define STEP8(PC, PN, t, GK, GV, GL) do { SBAR(); \
    const lds_cptr vp_ = vp0 + 2 * sl_prev; \
    v8i vfa = VLD(0), vfb = VLD(1); SBAR(); \
    C0 = MFMA6(kf0, q8, cinit); C1 = MFMA6(kf1, q8, cinit); PINV(C0); PINV(C1); SBAR(); \
    if (GK) { DMA_K8((t) + 5, sl_prev); } if (GV) { DMA_V8((t) + 3, 2 * SL3()); } \
    if (GL) { KLD(sl_next); } SBAR(); \
    o[0] = MFMA8(PC, vfa, o[0]); PINV(o[0]); SBAR(); if constexpr (NV == 4) { vfa = VLD(2); } CODES(PN, 0, 8 / NV); PINV(PN); SBAR(); \
    o[1] = MFMA8(PC, vfb, o[1]); PINV(o[1]); SBAR(); if constexpr (NV == 4) { vfb = VLD(3); } CODES(PN, 8 / NV, 16 / NV); PINV(PN); SBAR(); \
    if constexpr (NV == 4) { \
    o[2] = MFMA8(PC, vfa, o[2]); PINV(o[2]); SBAR(); CODES(PN, 4, 6); PINV(PN); SBAR(); \
    o[3] = MFMA8(PC, vfb, o[3]); PINV(o[3]); SBAR(); CODES(PN, 6, 8); PINV(PN); SBAR(); } \
    lsum = MFMA8S(PC, ones8, lsum); PINV(lsum); SBAR(); \
    } while (0)
#define ENDW8(tt) do { if ((tt) + 6 < NT) { OWN_BAR(); } else { WAIT_BAR(0); } } while (0)
    int t = 1;
    if (wid >= 4) __builtin_amdgcn_s_setprio(1);
#pragma unroll 1
    for (; t + 1 < NT; t += 2) {
        STEP8(pA, pB, t, (t + 5 < NT), (t + 3 < NT), (t + 1 < NT));         ROT();
        STEP8(pB, pA, t + 1, (t + 6 < NT), (t + 4 < NT), (t + 2 < NT));     ENDW8(t); ROT();
    }
    STEP8(pA, pB, NT - 1, false, false, false);
    { const lds_cptr vp_ = vp0 + 2 * sl_cur;
#pragma unroll
      for (int db = 0; db < NV; ++db) { const v8i vf = ld32(vp_ + db * 512, vp_ + db * 512 + VCH); o[db] = MFMA8(pB, vf, o[db]); } }
    lsum = MFMA8S(pB, ones8, lsum);
    __builtin_amdgcn_s_setprio(0);
    { float* wsf = (float*)(shm + LDS_WS) + wid * 64;
#pragma unroll
      for (int r = 0; r < 4; ++r) if ((lane & 15) < 2) wsf[16 * (lane & 15) + 4 * (lane >> 4) + r] = lsum[r];
      asm volatile("s_waitcnt lgkmcnt(0)" ::: "memory");
      l_reg = wsf[r32]; asm volatile("s_waitcnt lgkmcnt(0)" ::: "memory"); }
    l_out = l_reg;
    asm volatile("s_waitcnt lgkmcnt(0)\n\ts_barrier" ::: "memory");
#undef DMA_K8
#undef DMA_V8
#undef OWN_BAR
#undef ROT
#undef SL3
#undef KLD
#undef CODES
#undef STEP8
#undef PINV
#undef VLD
#undef ENDW8
}
__device__ __forceinline__ void attn_pass8_2x(const unsigned char* Qw8, int QP, const unsigned char* Kh8, int KP, const unsigned char* VT, int mI, char* shm, f32x16 (&oa)[2], f32x16 (&ob)[2], float& la_out, float& lb_out, int wave_in, bool pre = false) {
    constexpr int NV = 2;
    int tid = wave_in * 64 + lane_id(); asm volatile("" : "+v"(tid));
    const int lane = tid & 63, r32 = lane & 31, hi = lane >> 5; const int wid = wave_in;
    const unsigned lds0 = (unsigned)(uintptr_t)shm;
    constexpr int VCH = NV * 512;
    const bool kw = wid < 4, kwk = wid < 3;
    const unsigned char* ksrc = Kh8 + (long)lane * KP + (wid & 3) * 16;
    const unsigned char* vsrc = VT + (long)lane * SEQ + (wid & 3) * 16;
    const unsigned kdst = lds0 + LDS_K + (wid & 3) * 1024, vdst = lds0 + LDS_V + (wid & 3) * VCH;
#define DMA_K8(t, slot) do { if (kwk) glds16(ksrc + (long)(t) * KVBLK * KP, (unsigned)__builtin_amdgcn_readfirstlane(kdst + (slot))); } while (0)
#define DMA_V8(t, slot) do { if (!kw) glds16(vsrc + (t) * KVBLK, (unsigned)__builtin_amdgcn_readfirstlane(vdst + (slot))); } while (0)
#define OWN_BAR() WAIT_BAR(2)
    const lds_cptr shm3 = (lds_cptr)shm;
    const lds_cptr kp0 = shm3 + LDS_K + hi * 1024 + r32 * 16, kq0 = shm3 + LDS_K + 2048 + r32 * 16 + 8 * hi;
    const lds_cptr vp0 = shm3 + LDS_V + (2 * hi) * VCH + r32 * 16;
    if (!pre) attn_first_dma<2>(Kh8, KP, VT, shm, wave_in);
    v8i q8a, q8b;
    { const u32x4 a = *(const u32x4*)(Qw8 + (long)r32 * QP + 16 * hi); const u32x2 b = *(const u32x2*)(Qw8 + (long)r32 * QP + 32 + 8 * hi); q8a = (v8i){(int)a.x, (int)a.y, (int)a.z, (int)a.w, (int)b.x, (int)b.y, 0, 0}; }
    { const u32x4 a = *(const u32x4*)(Qw8 + (long)(32 + r32) * QP + 16 * hi); const u32x2 b = *(const u32x2*)(Qw8 + (long)(32 + r32) * QP + 32 + 8 * hi); q8b = (v8i){(int)a.x, (int)a.y, (int)a.z, (int)a.w, (int)b.x, (int)b.y, 0, 0}; }
#pragma unroll
    for (int d = 0; d < NV; ++d) { oa[d] = f32x16{}; ob[d] = f32x16{}; }
    f32x16 cinit; { int mI_ = mI; asm volatile("" : "+s"(mI_)); float cv = 8.0f * (float)(7 - mI_) * (1.0f / 65536.0f); asm volatile("" : "+v"(cv));
#pragma unroll
        for (int r = 0; r < 16; ++r) cinit[r] = cv; }
    asm volatile("" : "+v"(cinit));
    int sc6 = 0x77; asm volatile("" : "+v"(sc6));
    f32x16 C0, C1; v8i pAa, pBa, pAb, pBb, kf0, kf1;
    v8i ones8; { int one4 = ((lane & 15) == ((lane >> 4) & 1)) ? 0x38383838 : 0; asm volatile("" : "+v"(one4));
#pragma unroll
        for (int w = 0; w < 8; ++w) ones8[w] = one4; }
    f32x4 lsa = f32x4{}, lsb = f32x4{};
    int sl_prev = 0, sl_cur = 0, sl_next = SB8;
#define ROT() do { sl_prev = sl_cur; sl_cur = sl_next; sl_next = (sl_next == (NS8 - 1) * SB8) ? 0 : sl_next + SB8; } while (0)
#define SL3() (sl_cur >= 3 * SB8 ? sl_cur - 3 * SB8 : sl_cur + 3 * SB8)
#define KLD(sl) do { kf0 = ld24(kp0 + (sl), kq0 + (sl)); kf1 = ld24(kp0 + (sl) + 512, kq0 + (sl) + 512); } while (0)
#define CODES(PW, w0, w1) do { _Pragma("unroll") for (int w_ = (w0); w_ < (w1); ++w_) { \
      const float c0_ = w_ < 4 ? C0[4 * w_] : C1[4 * (w_ - 4)], c1_ = w_ < 4 ? C0[4 * w_ + 1] : C1[4 * (w_ - 4) + 1], c2_ = w_ < 4 ? C0[4 * w_ + 2] : C1[4 * (w_ - 4) + 2], c3_ = w_ < 4 ? C0[4 * w_ + 3] : C1[4 * (w_ - 4) + 3]; \
      const unsigned x_ = __builtin_bit_cast(unsigned, __builtin_amdgcn_cvt_pknorm_u16(c0_, c1_)), y_ = __builtin_bit_cast(unsigned, __builtin_amdgcn_cvt_pknorm_u16(c2_, c3_));     \
      PW[w_] = (int)__builtin_amdgcn_perm(y_, x_, 0x06040200u); } } while (0)
    asm volatile("s_waitcnt vmcnt(0) lgkmcnt(0)\n\ts_barrier" ::: "memory");
    KLD(0);
    C0 = MFMA6(kf0, q8a, cinit); C1 = MFMA6(kf1, q8a, cinit);
    CODES(pAa, 0, 8);
    C0 = MFMA6(kf0, q8b, cinit); C1 = MFMA6(kf1, q8b, cinit);
    CODES(pAb, 0, 8);
    ROT();
    KLD(sl_cur);
    WAIT_BAR(0);
#define VLD(db) ld32(vp_ + (db) * 512, vp_ + (db) * 512 + VCH)
#define PINV(x) asm volatile("" : "+v"(x))
#define STEP2(PCa, PNa, PCb, PNb, t, GK, GV, GL) do { SBAR(); \
    const lds_cptr vp_ = vp0 + 2 * sl_prev; \
    v8i vfa = VLD(0), vfb = VLD(1); SBAR(); \
    C0 = MFMA6(kf0, q8a, cinit); C1 = MFMA6(kf1, q8a, cinit); PINV(C0); PINV(C1); SBAR(); \
    if (GK) { DMA_K8((t) + 5, sl_prev); } if (GV) { DMA_V8((t) + 3, 2 * SL3()); } SBAR(); \
    oa[0] = MFMA8(PCa, vfa, oa[0]); PINV(oa[0]); SBAR(); CODES(PNa, 0, 4); PINV(PNa); SBAR(); \
    oa[1] = MFMA8(PCa, vfb, oa[1]); PINV(oa[1]); SBAR(); CODES(PNa, 4, 8); PINV(PNa); SBAR(); \
    C0 = MFMA6(kf0, q8b, cinit); C1 = MFMA6(kf1, q8b, cinit); PINV(C0); PINV(C1); SBAR(); \
    if (GL) { KLD(sl_next); } SBAR(); \
    ob[0] = MFMA8(PCb, vfa, ob[0]); PINV(ob[0]); SBAR(); CODES(PNb, 0, 4); PINV(PNb); SBAR(); \
    ob[1] = MFMA8(PCb, vfb, ob[1]); PINV(ob[1]); SBAR(); CODES(PNb, 4, 8); PINV(PNb); SBAR(); \
    lsa = MFMA8S(PCa, ones8, lsa); PINV(lsa); lsb = MFMA8S(PCb, ones8, lsb); PINV(lsb); SBAR(); \
    } while (0)
#define ENDW8(tt) do { if ((tt) + 6 < NT) { OWN_BAR(); } else { WAIT_BAR(0); } } while (0)
    int t = 1;
    if (wid >= 4) __builtin_amdgcn_s_setprio(1);
#pragma unroll 1
    for (; t + 1 < NT; t += 2) {
        STEP2(pAa, pBa, pAb, pBb, t, (t + 5 < NT), (t + 3 < NT), (t + 1 < NT));         ROT();
        STEP2(pBa, pAa, pBb, pAb, t + 1, (t + 6 < NT), (t + 4 < NT), (t + 2 < NT));     ENDW8(t); ROT();
    }
    STEP2(pAa, pBa, pAb, pBb, NT - 1, false, false, false);
    { const lds_cptr vp_ = vp0 + 2 * sl_cur;
#pragma unroll
      for (int db = 0; db < NV; ++db) { const v8i vf = ld32(vp_ + db * 512, vp_ + db * 512 + VCH); oa[db] = MFMA8(pBa, vf, oa[db]); ob[db] = MFMA8(pBb, vf, ob[db]); } }
    lsa = MFMA8S(pBa, ones8, lsa); lsb = MFMA8S(pBb, ones8, lsb);
    __builtin_amdgcn_s_setprio(0);
    { float* wsf = (float*)(shm + LDS_WS) + wid * 64;
#pragma unroll
      for (int r = 0; r < 4; ++r) if ((lane & 15) < 2) { wsf[16 * (lane & 15) + 4 * (lane >> 4) + r] = lsa[r]; wsf[32 + 16 * (lane & 15) + 4 * (lane >> 4) + r] = lsb[r]; }
      asm volatile("s_waitcnt lgkmcnt(0)" ::: "memory");
      la_out = wsf[r32]; lb_out = wsf[32 + r32]; asm volatile("s_waitcnt lgkmcnt(0)" ::: "memory"); }
    asm volatile("s_waitcnt lgkmcnt(0)\n\ts_barrier" ::: "memory");
#undef DMA_K8
#undef DMA_V8
#undef OWN_BAR
#undef ROT
#undef SL3
#undef KLD
#undef CODES
#undef STEP2
#undef PINV
#undef VLD
#undef ENDW8
}
#undef SBAR
#undef WAIT_BAR
}

constexpr int LDS_BYTES = 156 * 1024;
static_assert(att::LDS_BYTES <= LDS_BYTES && pg8::STAGE_BYTES <= LDS_BYTES, "LDS map");
constexpr int NWAVES = 8;

struct Args {
    const float* x_prompt; const float* x_sample; const float* c_prompt; const float* c_sample;
    const float* w_ada; const float* b_ada; const float* norm_g; const float* w_in;
    const float* qn_a; const float* kn_a; const float* qn_b; const float* kn_b;
    const float* lq1; const float* lk1; const float* lq2; const float* lk2; const float* subln_g;
    const float* w_proj_a; const float* w_proj_b; const float* w_out;
    float* out; unsigned char* ws;
};
__constant__ double INV_A[16] = {1.0, 0.5623413251903491, 0.31622776601683794, 0.1778279410038923, 0.1, 0.05623413251903491, 0.03162277660168379, 0.01778279410038923, 0.01, 0.005623413251903491, 0.0031622776601683794, 0.0017782794100389228, 0.001, 0.0005623413251903491, 0.00031622776601683794, 0.00017782794100389227};
__constant__ double INV_B[8] = {1.0, 0.19392274474868576, 0.03760603093086393, 0.007292664737217109, 0.001414213562373095, 0.0002742481756762073, 5.318295896944988e-05, 1.031338537721246e-05};

__device__ __forceinline__ int win_row(int n) {
    const int T = n >> 8, o = n & 255;
    int base;
    if (T < 2) base = T * 256; else if (T == 2) base = 6 * 256; else if (T < 5) base = (9 + (T - 3)) * 256; else if (T < 9) base = (T - 3) * 256; else if (T < 11) base = (T - 2) * 256; else base = T * 256;
    if (T == 3 || T == 4 || T >= 11) return base + 128 * ((o >> 3) & 1) + 32 * (o >> 6) + 8 * ((o >> 4) & 3) + (o & 7);
    return base + 128 * ((o >> 5) & 1) + 32 * (o >> 6) + (o & 31);
}
__device__ __forceinline__ void transpose_item(const float* W, int N, h16_t* WT, int KD, int kofs, int k0, int n0, int drow0, LAS float* scr, int lane, unsigned char* WT8 = nullptr, int drow8 = 0, float sc8 = 1.0f, float wmul = 1.0f) {
#pragma unroll 8
    for (int i = 0; i < 32; ++i) { const int kk = 2 * i + (lane >> 5); scr[kk * 33 + (lane & 31)] = W[(size_t)(k0 + kk) * N + n0 + (lane & 31)]; }
    asm volatile("s_waitcnt lgkmcnt(0)" ::: "memory");
    const int c = lane & 7;
#pragma unroll
    for (int j = 0; j < 4; ++j) { const int n = (lane >> 3) + 8 * j; const LAS float* s = scr + (8 * c) * 33 + n;
        u32x4 o; o.x = pk2h(s[0 * 33] * wmul, s[1 * 33] * wmul); o.y = pk2h(s[2 * 33] * wmul, s[3 * 33] * wmul); o.z = pk2h(s[4 * 33] * wmul, s[5 * 33] * wmul); o.w = pk2h(s[6 * 33] * wmul, s[7 * 33] * wmul);
        *(u32x4*)(WT + (size_t)(drow0 >= 0 ? drow0 + n : win_row(n0 + n)) * KD + kofs + k0 + 8 * c) = o;
        if (WT8) { int w0 = 0, w1 = 0;
            w0 = __builtin_amdgcn_cvt_pk_fp8_f32(s[0 * 33] * sc8, s[1 * 33] * sc8, w0, false); w0 = __builtin_amdgcn_cvt_pk_fp8_f32(s[2 * 33] * sc8, s[3 * 33] * sc8, w0, true);
            w1 = __builtin_amdgcn_cvt_pk_fp8_f32(s[4 * 33] * sc8, s[5 * 33] * sc8, w1, false); w1 = __builtin_amdgcn_cvt_pk_fp8_f32(s[6 * 33] * sc8, s[7 * 33] * sc8, w1, true);
            *(u32x2*)(WT8 + (size_t)(drow8 >= 0 ? drow8 + n : win_row(n0 + n) + drow8) * 1024 + k0 + 8 * c) = (u32x2){(unsigned)w0, (unsigned)w1}; } }
    asm volatile("s_waitcnt lgkmcnt(0)" ::: "memory");
}
__device__ __forceinline__ unsigned amax_bits(const unsigned char* ws, int G, size_t off = WS_AMAX) {
    int ln = lane_id(); asm volatile("" : "+v"(ln));
    float m = 0.f; for (int i = ln; i < G; i += 64) m = fmaxf(m, ((const float*)(ws + off))[i]);
#pragma unroll
    for (int o_ = 1; o_ < 64; o_ <<= 1) m = fmaxf(m, __shfl_xor(m, o_));
    return (unsigned)__builtin_amdgcn_readfirstlane((int)__float_as_uint(m));
}
__device__ __forceinline__ int w8_exp(unsigned amax_bits) {
    const float am = __uint_as_float(amax_bits);
    if (!(am > 1e-30f) || !(am < 1e30f)) return 0;
    const float r = 224.0f / am; return (int)((__float_as_uint(r) >> 23) & 255u) - 127;
}


__device__ __forceinline__ void score_bounds(const Args& A, float& boundA, float& boundB) {
    int ln = lane_id(); asm volatile("" : "+v"(ln));
    float qa = fabsf(A.qn_a[ln]), ka = fabsf(A.kn_a[ln]), qb_ = fabsf(A.qn_b[ln]), kb_ = fabsf(A.kn_b[ln]);
#pragma unroll
    for (int o_ = 1; o_ < 64; o_ <<= 1) { qa = fmaxf(qa, __shfl_xor(qa, o_)); ka = fmaxf(ka, __shfl_xor(ka, o_)); qb_ = fmaxf(qb_, __shfl_xor(qb_, o_)); kb_ = fmaxf(kb_, __shfl_xor(kb_, o_)); }
    boundA = __uint_as_float(__builtin_amdgcn_readfirstlane(__float_as_uint(C2 * 64.0f * 1.01f * qa * ka))); boundB = __uint_as_float(__builtin_amdgcn_readfirstlane(__float_as_uint(C2 * 64.0f * 1.01f * qb_ * kb_)));
}
__device__ __forceinline__ bool use_fp8(float boundA, float boundB) { return (boundA <= 13.7f) && (boundB <= 13.7f); }

#define XB_TMO      128
#define XB_XCNT(j)  (256  + 64 * (j))
#define XB_XSUB(j)  (1280 + 64 * (j))
#define XB_XGEN(j)  (2304 + 64 * (j))
#define XB_TOP      3328
#define XB_TOPGEN   3392
#define XB_AMAX      3456
#define XCD_BAR_WORDS 3472
#define XB_SPIN_CAP (1u << 18)
__device__ __forceinline__ unsigned xb_ld(unsigned* p)              { return __hip_atomic_load(p, __ATOMIC_RELAXED, __HIP_MEMORY_SCOPE_AGENT); }
__device__ __forceinline__ unsigned xb_add(unsigned* p, unsigned v) { return __hip_atomic_fetch_add(p, v, __ATOMIC_RELAXED, __HIP_MEMORY_SCOPE_AGENT); }
__device__ __forceinline__ unsigned xb_xcc_id() { return (unsigned)__builtin_amdgcn_s_getreg((3 << 11) | 20) & 0xFu; }
#define XB_SPIN(cond, bar) do { unsigned _sp = 0; while (cond) { __builtin_amdgcn_s_sleep(1); \
    if ((++_sp & 255u) == 0u) { if (xb_ld(&(bar)[XB_TMO])) break; if (_sp > XB_SPIN_CAP) { atomicAdd(&(bar)[XB_TMO], 1u); break; } } } } while (0)
struct XcdBarrier { unsigned* bar; unsigned x; volatile LAS unsigned* st; int wave; };
__device__ __forceinline__ XcdBarrier xcd_barrier_post(unsigned* bar, volatile LAS unsigned* st, int wave) {
    XcdBarrier b; b.bar = bar; b.x = xb_xcc_id(); b.st = st; b.wave = wave;
    if (wave == 0 && lane_id() == 0) (void)xb_add(&bar[XB_XCNT(b.x)], 1u);
    return b;
}
__device__ __forceinline__ void xcd_barrier_complete(unsigned* bar, unsigned x, unsigned& nloc, unsigned& nx) {
    const unsigned G = gridDim.x * gridDim.y * gridDim.z;
    unsigned sum, cnt, mine, sp = 0u;
    for (;;) {
        sum = 0u; cnt = 0u; mine = 0u;
#pragma unroll
        for (unsigned j = 0; j < 16; ++j) { const unsigned c = xb_ld(&bar[XB_XCNT(j)]); sum += c; cnt += (c > 0u) ? 1u : 0u; mine = (j == x) ? c : mine; }
        if (sum == G) break;
        __builtin_amdgcn_s_sleep(1);
        if ((++sp & 255u) == 0u) { if (xb_ld(&bar[XB_TMO])) break; if (sp > XB_SPIN_CAP) { atomicAdd(&bar[XB_TMO], 1u); break; } }
    }
    nloc = mine > 0u ? mine : 1u; nx = cnt > 0u ? cnt : 1u;
}
__device__ __forceinline__ void xcd_barrier(const XcdBarrier& b) {
    asm volatile("s_waitcnt vmcnt(0)" ::: "memory");
    __syncthreads();
    if (b.wave == 0 && lane_id() == 0) {
        unsigned* bar = b.bar;
        __builtin_amdgcn_s_waitcnt(0);
        unsigned nloc = b.st[0], nx = b.st[1];
        if (nloc == 0u) { xcd_barrier_complete(bar, b.x, nloc, nx); b.st[0] = nloc; b.st[1] = nx; }
        const unsigned old = xb_add(&bar[XB_XSUB(b.x)], 1u);
        const unsigned gen = old / nloc;
        if (old + 1u == (gen + 1u) * nloc) {
            __builtin_amdgcn_fence(__ATOMIC_RELEASE, "agent");
            asm volatile("s_waitcnt vmcnt(0)" ::: "memory");
            const unsigned og = xb_add(&bar[XB_TOP], 1u);
            const unsigned tg = og / nx;
            if (og + 1u == (tg + 1u) * nx) xb_add(&bar[XB_TOPGEN], 1u);
            else XB_SPIN(xb_ld(&bar[XB_TOPGEN]) == tg, bar);
            __builtin_amdgcn_fence(__ATOMIC_ACQUIRE, "agent");
            xb_add(&bar[XB_XGEN(b.x)], 1u);
            asm volatile("s_waitcnt vmcnt(0)" ::: "memory");
        } else {
            XB_SPIN(xb_ld(&bar[XB_XGEN(b.x)]) == gen, bar);
            __builtin_amdgcn_fence(__ATOMIC_ACQUIRE, "agent");
            asm volatile("s_waitcnt vmcnt(0)" ::: "memory");
        }
    }
    __syncthreads();
}

__global__ void __launch_bounds__(NWAVES * 64, 2) mega_fwd(Args A) {
    extern __shared__ __attribute__((aligned(16))) unsigned char lds[];
    LAS unsigned char* ldsl = (LAS unsigned char*)lds;
    const int tid = threadIdx.x, lane = tid & 63, wave = __builtin_amdgcn_readfirstlane(tid >> 6);
    const int G = gridDim.x; const int bx = blockIdx.x; const int vcu = (G % 8 == 0) ? (bx % 8) * (G / 8) + bx / 8 : bx;
    unsigned char* ws = A.ws;
    const int gw = vcu * NWAVES + wave, NGW = G * NWAVES;
    volatile LAS unsigned* bar_st = (volatile LAS unsigned*)(ldsl + LDS_BYTES - 64);
    if (tid == 0) { bar_st[0] = 0u; bar_st[1] = 0u; }
    __syncthreads();
    const XcdBarrier xbar = xcd_barrier_post((unsigned*)ws, bar_st, wave);

    {
        for (int it = gw; it < 48 * 16; it += NGW) {
            const int cgp = it % 48, kc = it / 48, col = cgp * 64 + lane, k0 = kc * 64;
            float sv[6], ac[6];
#pragma unroll
            for (int b = 0; b < 6; ++b) { const float c = b < 4 ? A.c_prompt[b * DM + k0 + lane] : A.c_sample[(b - 4) * DM + k0 + lane]; sv[b] = silu_f(c); ac[b] = 0.f; }
            for (int kk = 0; kk < 64; ++kk) {
                const float w = A.w_ada[(size_t)(k0 + kk) * 3072 + col];
#pragma unroll
                for (int b = 0; b < 6; ++b) ac[b] += __shfl(sv[b], kk) * w;
            }
            float* modp = (float*)(ws + WS_MODP);
#pragma unroll
            for (int b = 0; b < 6; ++b) modp[(size_t)(kc * 6 + b) * 3072 + col] = ac[b];
        }
        {
            float am = 0.f;
            for (int i = gw * 64 + lane; i < DM * 384; i += NGW * 64) {
                const int row = i / 384, c4 = i - row * 384, col = c4 < 128 ? 4 * c4 : 1280 + 4 * (c4 - 128);
                const f32x4 v = *(const f32x4*)(A.w_in + (size_t)row * DIN + col);
                am = fmaxf(fmaxf(am, fmaxf(fabsf(v.x), fabsf(v.y))), fmaxf(fabsf(v.z), fabsf(v.w)));
            }
            float ag = 0.f;
            for (int i = gw * 64 + lane; i < DM * 512; i += NGW * 64) {
                const int row = i >> 9, col = 3328 + 4 * (i & 511);
                const f32x4 v = *(const f32x4*)(A.w_in + (size_t)row * DIN + col);
                ag = fmaxf(fmaxf(ag, fmaxf(fabsf(v.x), fabsf(v.y))), fmaxf(fabsf(v.z), fabsf(v.w)));
            }
#pragma unroll
            for (int o_ = 1; o_ < 64; o_ <<= 1) { am = fmaxf(am, __shfl_xor(am, o_)); ag = fmaxf(ag, __shfl_xor(ag, o_)); }
            LAS float* amw = (LAS float*)(ldsl + 1024);
            if (lane == 0) { amw[wave] = am; amw[8 + wave] = ag; }
            __syncthreads();
            if (tid == 0) { float m = amw[0], mg = amw[8];
#pragma unroll
                for (int w = 1; w < NWAVES; ++w) { m = fmaxf(m, amw[w]); mg = fmaxf(mg, amw[8 + w]); }
                ((float*)(ws + WS_AMAX))[bx] = m; ((float*)(ws + WS_AMAXG))[bx] = mg; }
        }
    }
    xcd_barrier(xbar);

    {
        LAS float* Gt = (LAS float*)(ldsl + 140 * 1024); LAS float* St = Gt + DM;
        const float* modp = (const float*)(ws + WS_MODP);
        if (vcu < NBATCH) {
            for (int c = tid; c < DM; c += NWAVES * 64) { float g = A.b_ada[2048 + c];
                for (int kc = 0; kc < 16; ++kc) g += modp[(size_t)(kc * 6 + vcu) * 3072 + 2048 + c];
                ((float*)(ws + WS_GATE))[vcu * DM + c] = g; }
        }
        const int rstart = (int)((long)TOK * vcu / G), rend = (int)((long)TOK * (vcu + 1) / G);
        const int b_lo = rstart >> 13, b_hi = (rend - 1) >> 13;
        for (int b = b_lo; b <= b_hi; ++b) {
            __syncthreads();
            for (int c = tid; c < DM; c += NWAVES * 64) { float sh = A.b_ada[c], scl = A.b_ada[1024 + c];
                for (int kc = 0; kc < 16; ++kc) { sh += modp[(size_t)(kc * 6 + b) * 3072 + c]; scl += modp[(size_t)(kc * 6 + b) * 3072 + 1024 + c]; }
                Gt[c] = A.norm_g[c] * (1.0f + scl); St[c] = sh; }
            __syncthreads();
            const int lo = rstart > b * SEQ ? rstart : b * SEQ, hi_ = rend < (b + 1) * SEQ ? rend : (b + 1) * SEQ;
            for (int r = lo + wave; r < hi_; r += NWAVES) {
                const float* xrow = r < TOKP ? A.x_prompt + (size_t)r * DM : A.x_sample + (size_t)(r - TOKP) * DM;
                const f32x4* xr = (const f32x4*)xrow + lane;
                f32x4 v[4]; float s = 0.f;
#pragma unroll
                for (int j = 0; j < 4; ++j) { v[j] = __builtin_nontemporal_load(xr + 64 * j); s += (v[j].x * v[j].x + v[j].y * v[j].y) + (v[j].z * v[j].z + v[j].w * v[j].w); }
                const float rstd = 1.0f / sqrtf(wave_sum(s) * (1.0f / DM) + EPS);
                u32x2* o8 = (u32x2*)((h16_t*)(ws + WS_XN) + (size_t)r * DM) + lane;
                unsigned* o8b = (unsigned*)(ws + WS_XN8 + (size_t)r * DM) + lane;
#pragma unroll
                for (int j = 0; j < 4; ++j) { const f32x4 gq = *(const LAS f32x4*)(Gt + 4 * lane + 256 * j), sq = *(const LAS f32x4*)(St + 4 * lane + 256 * j);
                    const f32x4 h = v[j] * rstd * gq + sq; u32x2 w; w.x = pk2h(h.x, h.y); w.y = pk2h(h.z, h.w); o8[64 * j] = w;
                    int w8 = 0; w8 = __builtin_amdgcn_cvt_pk_fp8_f32(__builtin_amdgcn_fmed3f(h.x, -448.f, 448.f), __builtin_amdgcn_fmed3f(h.y, -448.f, 448.f), w8, false);
                    w8 = __builtin_amdgcn_cvt_pk_fp8_f32(__builtin_amdgcn_fmed3f(h.z, -448.f, 448.f), __builtin_amdgcn_fmed3f(h.w, -448.f, 448.f), w8, true); o8b[64 * j] = (unsigned)w8; }
            }
        }
        __syncthreads();
        LAS float* scr = (LAS float*)(ldsl + wave * 16384);
        const float w8s = __uint_as_float((unsigned)(127 + w8_exp(amax_bits(ws, G))) << 23);
        const float w8g = -1.4426950408889634f * __uint_as_float((unsigned)(127 + w8_exp(amax_bits(ws, G, WS_AMAXG))) << 23);
        constexpr int I_IN = (DM / 64) * (DIN / 32), I_PA = (512 / 64) * (DM / 32), I_OUT = (DM / 64) * (DM / 32);
        constexpr int NITEMS = I_IN + 2 * I_PA + I_OUT;
        for (int it = gw; it < NITEMS; it += NGW) {
            int r = it;
            if (r < I_IN) { const int nblk = DIN / 32, kb = r / nblk, nb = r % nblk, wr_ = win_row(32 * nb), T_ = nb >> 3;
                const bool qk8 = T_ < 2 || (T_ >= 5 && T_ <= 8);
                transpose_item(A.w_in, DIN, (h16_t*)(ws + WS_WIN), DM, 0, 64 * kb, 32 * nb, -1, scr, lane, qk8 ? ws + WS_WIN8 : (T_ >= 13 ? ws + WS_WIN8G : nullptr), qk8 ? wr_ : -13 * 256, qk8 ? w8s : w8g, T_ >= 13 ? -1.4426950408889634f : 1.0f); continue; } r -= I_IN;
            if (r < I_PA) { const int nblk = DM / 32, kb = r / nblk, nb = r % nblk, n0 = 32 * nb; transpose_item(A.w_proj_a, DM, (h16_t*)(ws + WS_WAB), DM, 0, 64 * kb, n0, 256 * (n0 >> 7) + (n0 & 127), scr, lane); continue; } r -= I_PA;
            if (r < I_PA) { const int nblk = DM / 32, kb = r / nblk, nb = r % nblk, n0 = 32 * nb; transpose_item(A.w_proj_b, DM, (h16_t*)(ws + WS_WAB), DM, 512, 64 * kb, n0, 256 * (n0 >> 7) + 128 + (n0 & 127), scr, lane); continue; } r -= I_PA;
            { const int nblk = DM / 32, kb = r / nblk, nb = r % nblk; transpose_item(A.w_out, DM, (h16_t*)(ws + WS_WOUT), DM, 0, 64 * kb, 32 * nb, 32 * nb, scr, lane); }
        }
        for (int row = gw; row < 2048; row += NGW) {
            h16_t* p = (h16_t*)(ws + WS_WAB) + (size_t)row * DM + ((row & 128) ? 0 : 512) + lane * 8;
            *(u32x4*)p = (u32x4){0u, 0u, 0u, 0u};
        }
        if (vcu == 0) { float* nrm = (float*)(ws + WS_NRM);
            if (tid < 64) { nrm[tid] = A.qn_a[tid]; nrm[64 + tid] = A.kn_a[tid]; nrm[128 + tid] = A.qn_b[tid]; nrm[192 + tid] = A.kn_b[tid]; }
            if (tid < 128) nrm[256 + tid] = A.subln_g[tid]; }
        {
            const int gt = vcu * (NWAVES * 64) + tid, NGT = G * NWAVES * 64;
            for (int e = gt; e < 65536 + 2048 + 1024; e += NGT) {
                int pos, j, kind; if (e < 65536) { kind = 0; pos = e >> 3; j = e & 7; } else if (e < 65536 + 2048) { kind = 1; pos = (e - 65536) >> 4; j = e & 15; } else { kind = 2; pos = (e - 65536 - 2048) >> 4; j = e & 15; }
                const double inv = kind == 0 ? INV_B[j] : INV_A[j & 15];
                double rev = (double)pos * inv * 0.15915494309189533577; rev -= floor(rev);
                const double q4 = floor(rev * 4.0 + 0.5); const double xr = (rev - q4 * 0.25) * 6.283185307179586476925; const double x2 = xr * xr;
                const double sp = xr * (1.0 + x2 * (-1.0 / 6 + x2 * (1.0 / 120 + x2 * (-1.0 / 5040 + x2 * (1.0 / 362880 + x2 * (-1.0 / 39916800 + x2 * (1.0 / 6227020800.0)))))));
                const double cp = 1.0 + x2 * (-0.5 + x2 * (1.0 / 24 + x2 * (-1.0 / 720 + x2 * (1.0 / 40320 + x2 * (-1.0 / 3628800 + x2 * (1.0 / 479001600.0 + x2 * (-1.0 / 87178291200.0)))))));
                const int qd = ((int)q4) & 3;
                const double cd = qd == 0 ? cp : qd == 1 ? -sp : qd == 2 ? -cp : sp, sd = qd == 0 ? sp : qd == 1 ? cp : qd == 2 ? -sp : -cp;
                const float cs = (float)cd, sn = (float)sd;
                h16_t* tp; int stride, half;
                if (kind == 0) { tp = (h16_t*)(ws + WS_TB); stride = 16; half = 8; } else if (kind == 1) { tp = (h16_t*)(ws + WS_TAR); stride = 32; half = 16; } else { tp = (h16_t*)(ws + WS_TAC); stride = 32; half = 16; }
                tp[pos * stride + j] = f2h(cs);
                tp[pos * stride + half + j] = f2h(sn);
            }
        }
    }
    xcd_barrier(xbar);

    int p4_u8, p4_eg;
    {
        float bA_, bB_; score_bounds(A, bA_, bB_); const int u8 = use_fp8(bA_, bB_) ? 1 : 0;
        p4_u8 = __builtin_amdgcn_readfirstlane(u8); p4_eg = __builtin_amdgcn_readfirstlane(w8_exp(amax_bits(ws, G, WS_AMAXG)));
        if (u8) {
            const int eqk = w8_exp(amax_bits(ws, G));
            pg8::Gemm g{(const h16_t*)(ws + WS_XN8), (const h16_t*)(ws + WS_WIN8), TOK, 6 * 256, DM / 2, 0x7f00 | (127 - eqk)}; pg8::StaticOrder S; S.init(TOK, 6 * 256, G, bx);
            if (G == 256) { S.i2 = 3; S.G2 = 192; S.c2 = (bx >= 128 && bx < 192) ? -1 : (bx < 128 ? bx : bx - 64); }
            EpiInProj E{0, ws, 1, 0, 1.0f};
            pg8::gemm_phase<EpiInProj, false, true>(ldsl, g, S, E, wave);
        }
        {
            const int nt16 = u8 ? 3 : 9;
            pg8::Gemm g{(const h16_t*)(ws + WS_XN), (const h16_t*)(ws + WS_WIN) + (size_t)(9 - nt16) * 256 * DM, TOK, nt16 * 256, DM}; pg8::StaticOrder S; S.init(TOK, nt16 * 256, G, u8 ? (bx + G / 2) % G : bx);
            EpiInProj E{0, ws, u8, 9 - nt16, 1.0f};
            pg8::gemm_phase<EpiInProj>(ldsl, g, S, E, wave);
        }
    }
    xcd_barrier(xbar);

    {
        float lam;
        { int ln = lane_id(); asm volatile("" : "+v"(ln)); const float p1 = A.lq1[ln] * A.lk1[ln], p2 = A.lq2[ln] * A.lk2[ln]; lam = __uint_as_float(__builtin_amdgcn_readfirstlane(__float_as_uint(__expf(wave_sum(p1)) - __expf(wave_sum(p2)) + LAM_INIT))); }
        float boundA, boundB; score_bounds(A, boundA, boundB); const bool use8 = use_fp8(boundA, boundB);
        auto shift_of = [](float bound) -> int { const unsigned b = __float_as_uint(bound); const int e = (int)(b >> 23) - 127; const unsigned m = (b & 0x7fffffu) | 0x800000u;
            const int fx = e >= 13 ? (int)(m << (e - 13)) : (e >= -10 ? (int)(m >> (13 - e)) : 0);
            return (fx - 8960 + 1024) >> 10; };
        const int mIA = shift_of(boundA), mIB = shift_of(boundB);
        char* shm = (char*)lds;
        h16_t* OAB = (h16_t*)(ws + WS_OAB);
        auto first_dma = [&](int s_, int p_) {
            if (s_ < 768) { const int u = (s_ >> 8) * 32 + (s_ & 31), xg = (s_ & 255) >> 5, j = u >> 4, id = 3 * xg + (j >> 1), b = id >> 2, kvh = (id >> 1) & 1;
                att::attn_first_dma<2>((const unsigned char*)(ws + WS_KA) + (long)b * SEQ * 96 + kvh * 48, 96, (const unsigned char*)(ws + WS_VTA) + (long)((b * 2 + kvh) * 64) * SEQ, shm, wave);
            } else { const int a = s_ - 768, ii = a >> 8, vv = a & 255, xg = vv >> 5, id = 3 * xg + ii, b = id >> 2, h = id & 3;
                att::attn_first_dma<4>((const unsigned char*)(ws + WS_KB) + (long)b * SEQ * 384 + (2 * h + p_) * 48, 384, (const unsigned char*)(ws + WS_VTB) + (long)((b * 4 + h) * 128) * SEQ, shm, wave); }
        };
        if (use8 && vcu < 1536) first_dma(vcu, 0);
        for (int s = vcu; s < 1536; s += G) {
            const bool isB = s >= 768;
            if (!isB) {
                const int u = (s >> 8) * 32 + (s & 31), xg = (s & 255) >> 5, qb = u & 15, j = u >> 4, id = 3 * xg + (j >> 1), sel = j & 1, b = id >> 2;
                const long rowbase = (long)b * SEQ + qb * 512 + wave * 64;
                const int kvh = (id >> 1) & 1, h = 4 * kvh + 2 * (id & 1) + sel;
                const h16_t* Qw = (const h16_t*)(ws + WS_QA) + rowbase * 512 + h * 64;
                const h16_t* Kh = (const h16_t*)(ws + WS_KA) + (long)b * SEQ * 128 + kvh * 64;
                const h16_t* Vh = (const h16_t*)(ws + WS_VA) + (long)b * SEQ * 128 + kvh * 64;
                f32x16 oa[2], ob[2]; float la, lb;
                if (use8) att::attn_pass8_2x((const unsigned char*)(ws + WS_QA) + rowbase * 384 + h * 48, 384, (const unsigned char*)(ws + WS_KA) + (long)b * SEQ * 96 + kvh * 48, 96,
                                             (const unsigned char*)(ws + WS_VTA) + (long)((b * 2 + kvh) * 64) * SEQ, mIA, shm, oa, ob, la, lb, wave, true);
                if (use8 && s + G < 1536) first_dma(s + G, 0);
                auto epiA = [&](const f32x16 (&o)[2], float l, long rb) {
                    int tid2 = wave * 64 + lane_id(); asm volatile("" : "+v"(tid2));
                    const int lane = tid2 & 63, r32 = lane & 31, hi = lane >> 5;
                    float* wsf = (float*)(shm + att::LDS_WS) + wave * 64;
                    h16_t* stg = (h16_t*)(shm + att::LDS_OST + wave * att::OST_WAVE);
                    if (hi == 0) wsf[32 + r32] = l; asm volatile("s_waitcnt lgkmcnt(0)" ::: "memory");
                    float rli[16];
#pragma unroll
                    for (int r = 0; r < 16; ++r) rli[r] = __builtin_amdgcn_rcpf(wsf[32 + att::crow(r, hi)]);
#pragma unroll
                    for (int r = 0; r < 16; ++r) { const int orow = att::crow(r, hi);
#pragma unroll
                        for (int d0 = 0; d0 < 2; ++d0) stg[orow * 64 + d0 * 32 + r32] = f2h(o[d0][r] * rli[r]); }
                    asm volatile("s_waitcnt lgkmcnt(0)" ::: "memory");
                    h16_t* Ow = OAB + rb * 1024 + h * 64;
#pragma unroll
                    for (int i = 0; i < 4; ++i) { const int row = i * 8 + (lane >> 3), ch = lane & 7; const u32x4 v = *(const u32x4*)(stg + row * 64 + ch * 8); *(u32x4*)(Ow + (long)row * 1024 + ch * 8) = v; }
                    asm volatile("s_waitcnt lgkmcnt(0)" ::: "memory");
                };
                if (use8) { epiA(oa, la, rowbase); epiA(ob, lb, rowbase + 32); }
                else {
#pragma unroll 1
                    for (int sub = 0; sub < 2; ++sub) { att::attn_pass<8, false>(Qw + (long)sub * 32 * 512, 512, Kh, 128, Vh, 128, shm, oa, la, wave); epiA(oa, la, rowbase + 32 * sub); }
                }
            } else {
                const int a = s - 768, ii = a >> 8, vv = a & 255, xg = vv >> 5, qb = vv & 31, id = 3 * xg + ii, b = id >> 2, h = id & 3;
                const long rowbase = (long)b * SEQ + qb * 256 + wave * 32;
                const h16_t* Vh = (const h16_t*)(ws + WS_VB) + (long)b * SEQ * 512 + h * 128;
#pragma unroll 1
                for (int p = 0; p < 2; ++p) {
                    const h16_t* Qw = (const h16_t*)(ws + WS_QB) + rowbase * 512 + (2 * h + p) * 64;
                    const h16_t* Kh = (const h16_t*)(ws + WS_KB) + (long)b * SEQ * 512 + (2 * h + p) * 64;
                    f32x16 o[4]; float l;
                    if (use8) att::attn_pass8<4>((const unsigned char*)(ws + WS_QB) + rowbase * 384 + (2 * h + p) * 48, 384, (const unsigned char*)(ws + WS_KB) + (long)b * SEQ * 384 + (2 * h + p) * 48, 384,
                                                 (const unsigned char*)(ws + WS_VTB) + (long)((b * 4 + h) * 128) * SEQ, mIB, shm, o, l, wave, true);
                    else att::attn_pass128<8, false>(Qw, 512, Kh, 512, Vh, 512, shm, o, l, wave);
                    if (use8) { if (p == 0) first_dma(s, 1); else if (s + G < 1536) first_dma(s + G, 0); }
                    int tid2 = wave * 64 + lane_id(); asm volatile("" : "+v"(tid2));
                    const int lane = tid2 & 63, r32 = lane & 31, hi = lane >> 5;
                    float* wsf = (float*)(shm + att::LDS_WS) + wave * 64;
                    unsigned* stw = (unsigned*)(shm + att::LDS_OST + wave * att::OST_WAVE);
                    h16_t* stg = (h16_t*)stw;
                    if (hi == 0) wsf[32 + r32] = l; asm volatile("s_waitcnt lgkmcnt(0)" ::: "memory");
                    float rli[16];
#pragma unroll
                    for (int r = 0; r < 16; ++r) rli[r] = __builtin_amdgcn_rcpf(wsf[32 + att::crow(r, hi)]);
                    if (p == 0) {
#pragma unroll
                        for (int d0 = 0; d0 < 4; ++d0)
#pragma unroll
                            for (int r = 0; r < 16; r += 2) stw[(d0 * 8 + (r >> 1)) * 64 + lane] = pk2h(o[d0][r] * rli[r], o[d0][r + 1] * rli[r + 1]);
                        asm volatile("s_waitcnt lgkmcnt(0)" ::: "memory");
                    } else {
                        unsigned sv[32];
#pragma unroll
                        for (int i = 0; i < 32; ++i) sv[i] = stw[i * 64 + lane];
                        asm volatile("s_waitcnt lgkmcnt(0)" ::: "memory");
#pragma unroll
                        for (int d0 = 0; d0 < 4; ++d0)
#pragma unroll
                            for (int r = 0; r < 16; ++r) { const unsigned w = sv[d0 * 8 + (r >> 1)]; const float o0 = h2f((unsigned short)((r & 1) ? (w >> 16) : (w & 0xffffu)));
                                const float dv = o0 - lam * (o[d0][r] * rli[r]);
                                stg[att::crow(r, hi) * 128 + d0 * 32 + r32] = f2h(dv); }
                        asm volatile("s_waitcnt lgkmcnt(0)" ::: "memory");
                        const float* sg = A.subln_g;
                        h16_t* Ow = OAB + rowbase * 1024 + 512 + h * 128;
#pragma unroll
                        for (int i = 0; i < 8; ++i) { const int row = i * 4 + (lane >> 4), ch = lane & 15; const u32x4 v = *(const u32x4*)(stg + row * 128 + ch * 8);
                            float f[8]; float q = 0.f;
#pragma unroll
                            for (int e = 0; e < 4; ++e) { f[2 * e] = h2f((unsigned short)(v[e] & 0xffffu)); f[2 * e + 1] = h2f((unsigned short)(v[e] >> 16)); q += f[2 * e] * f[2 * e] + f[2 * e + 1] * f[2 * e + 1]; }
                            q += __shfl_xor(q, 1); q += __shfl_xor(q, 2); q += __shfl_xor(q, 4); q += __shfl_xor(q, 8);
                            const float rn = __builtin_amdgcn_rsqf(q * (1.0f / 128.0f) + EPS) * (1.0f - LAM_INIT);
                            const f32x4 g0 = *(const f32x4*)(sg + ch * 8), g1 = *(const f32x4*)(sg + ch * 8 + 4);
                            u32x4 w; w.x = pk2h(f[0] * rn * g0[0], f[1] * rn * g0[1]); w.y = pk2h(f[2] * rn * g0[2], f[3] * rn * g0[3]); w.z = pk2h(f[4] * rn * g1[0], f[5] * rn * g1[1]); w.w = pk2h(f[6] * rn * g1[2], f[7] * rn * g1[3]);
                            *(u32x4*)(Ow + (long)row * 1024 + ch * 8) = w; }
                        asm volatile("s_waitcnt lgkmcnt(0)" ::: "memory");
                    }
                }
            }
        }
    }
    xcd_barrier(xbar);

    {
        const int u8 = p4_u8;
        {
            const int nt16 = u8 ? 4 : 12;
            pg8::Gemm g{(const h16_t*)(ws + WS_XN), (const h16_t*)(ws + WS_WIN) + (size_t)9 * 256 * DM, TOK, nt16 * 256, DM}; pg8::StaticOrder S; S.init(TOK, nt16 * 256, G, bx);
            EpiInProj E{1, ws, 0, 0, 1.0f};
            pg8::gemm_phase<EpiInProj>(ldsl, g, S, E, wave);
        }
        if (u8) {
            pg8::Gemm g{(const h16_t*)(ws + WS_XN8), (const h16_t*)(ws + WS_WIN8G), TOK, 8 * 256, DM / 2, 0x7f00 | (127 - p4_eg)}; pg8::StaticOrder S; S.init(TOK, 8 * 256, G, bx);
            EpiInProj E{1, ws, 0, 4, 1.0f};
            pg8::gemm_phase<EpiInProj, false, true>(ldsl, g, S, E, wave);
        }
    }
    xcd_barrier(xbar);

    {
        pg8::Gemm g{(const h16_t*)(ws + WS_OAB), (const h16_t*)(ws + WS_WAB), TOK, 2048, DM}; pg8::StaticOrder S; S.init(TOK, 2048, G, bx);
        EpiMerge E{ws + WS_SGA, ws + WS_SGB, (h16_t*)(ws + WS_MG)};
        pg8::gemm_phase<EpiMerge, true>(ldsl, g, S, E, wave);
    }
    xcd_barrier(xbar);

    {
        pg8::Gemm g{(const h16_t*)(ws + WS_MG), (const h16_t*)(ws + WS_WOUT), TOK, DM, DM}; pg8::StaticOrder S; S.init(TOK, DM, G, bx);
        EpiOut E{A.x_prompt, (long)((const char*)A.x_sample - (const char*)A.x_prompt) - (long)TOKP * DM * 4, (const float*)(ws + WS_GATE), A.out};
        pg8::gemm_phase<EpiOut>(ldsl, g, S, E, wave);
    }
}

extern "C" void kernel_launch(void* const* d_in, const int* in_sizes, int n_in, void* d_out, int out_size, void* d_ws, size_t ws_size, hipStream_t stream) {
    static int grid = 0;
    if (grid == 0) {
        if (n_in != 20 || out_size != TOK * DM || ws_size < WS_END) { fprintf(stderr, "kernel_launch: unexpected shapes (n_in %d out %d ws %zu)\n", n_in, out_size, ws_size); grid = -1; return; }
        int dev = 0, cus = 0, per_cu = 0;
        hipGetDevice(&dev); hipDeviceGetAttribute(&cus, hipDeviceAttributeMultiprocessorCount, dev);
        hipFuncSetAttribute((const void*)mega_fwd, hipFuncAttributeMaxDynamicSharedMemorySize, LDS_BYTES);
        hipOccupancyMaxActiveBlocksPerMultiprocessor(&per_cu, (const void*)mega_fwd, NWAVES * 64, LDS_BYTES);
        (void)hipGetLastError();
        if (per_cu < 1) fprintf(stderr, "kernel_launch: occupancy query reports %d blocks per CU\n", per_cu);
        grid = cus > 0 ? cus : 256;
    }
    if (grid < 0) return;
    Args a{};
    a.x_prompt = (const float*)d_in[0]; a.x_sample = (const float*)d_in[1]; a.c_prompt = (const float*)d_in[2]; a.c_sample = (const float*)d_in[3];
    a.w_ada = (const float*)d_in[4]; a.b_ada = (const float*)d_in[5]; a.norm_g = (const float*)d_in[6]; a.w_in = (const float*)d_in[7];
    a.qn_a = (const float*)d_in[8]; a.kn_a = (const float*)d_in[9]; a.qn_b = (const float*)d_in[10]; a.kn_b = (const float*)d_in[11];
    a.lq1 = (const float*)d_in[12]; a.lk1 = (const float*)d_in[13]; a.lq2 = (const float*)d_in[14]; a.lk2 = (const float*)d_in[15]; a.subln_g = (const float*)d_in[16];
    a.w_proj_a = (const float*)d_in[17]; a.w_proj_b = (const float*)d_in[18]; a.w_out = (const float*)d_in[19];
    a.out = (float*)d_out; a.ws = (unsigned char*)d_ws;
    if (hipMemsetAsync(d_ws, 0, XCD_BAR_WORDS * 4, stream) != hipSuccess) { fprintf(stderr, "kernel_launch: hipMemsetAsync failed\n"); return; }
    void* args[] = {&a};
    hipError_t e = hipLaunchCooperativeKernel((const void*)mega_fwd, dim3(grid), dim3(NWAVES * 64), args, LDS_BYTES, stream);
    if (e != hipSuccess) fprintf(stderr, "kernel_launch: cooperative launch failed: %s (grid %d)\n", hipGetErrorString(e), grid);
}
```

```cpp
#include <hip/hip_runtime.h>
#include <cstdio>
#include <cstdint>
#include <cmath>

#define LAS __attribute__((address_space(3)))
#define GAS __attribute__((address_space(1)))
typedef unsigned short h16_t;
#ifndef LP_BF16
#define LP_BF16 1
#endif
#if LP_BF16
typedef __bf16 lp_t;
typedef short f16x8 __attribute__((ext_vector_type(8)));
#define MFMA16(a, b, c) __builtin_amdgcn_mfma_f32_16x16x32_bf16(a, b, c, 0, 0, 0)
#define MFMA32(a, b, c) __builtin_amdgcn_mfma_f32_32x32x16_bf16(a, b, c, 0, 0, 0)
#else
typedef _Float16 lp_t;
typedef _Float16 f16x8 __attribute__((ext_vector_type(8)));
#define MFMA16(a, b, c) __builtin_amdgcn_mfma_f32_16x16x32_f16(a, b, c, 0, 0, 0)
#endif
typedef lp_t f16x2 __attribute__((ext_vector_type(2)));
typedef float f32x2 __attribute__((ext_vector_type(2)));
typedef float f32x4 __attribute__((ext_vector_type(4)));
typedef float f32x8 __attribute__((ext_vector_type(8)));
typedef float f32x16 __attribute__((ext_vector_type(16)));
typedef unsigned u32x2 __attribute__((ext_vector_type(2)));
typedef unsigned u32x4 __attribute__((ext_vector_type(4)));
typedef short s16x4 __attribute__((ext_vector_type(4)));
typedef int i32x4 __attribute__((ext_vector_type(4)));
typedef int i32x8 __attribute__((ext_vector_type(8)));
typedef int i32x6 __attribute__((ext_vector_type(6)));
#define MFMA8S_G(a, b, c) __builtin_amdgcn_mfma_scale_f32_16x16x128_f8f6f4(a, b, c, 0, 0, 0, scv, 1, scv)

constexpr int DM = 1024, SEQ = 8192, NBATCH = 6, TOK = NBATCH * SEQ, TOKP = 4 * SEQ, DIN = 5376;
constexpr float EPS = 1e-6f;
constexpr float C2 = 0.125f * 1.4426950408889634f;
constexpr float SQK6 = 1.2011224087864498f;
constexpr float LAM_INIT = 0.2f;

constexpr size_t MiB = 1u << 20;
constexpr size_t WS_MODP = 1 * MiB;
constexpr size_t WS_GATE = 3 * MiB;
constexpr size_t WS_TAR = 3 * MiB + 65536;
constexpr size_t WS_TAC = WS_TAR + 8192;
constexpr size_t WS_TB = WS_TAC + 4096;
constexpr size_t WS_NRM = WS_GATE + 32768;
constexpr size_t WS_AMAX = WS_GATE + 32768 + 4096;
constexpr size_t WS_SSQ = 4 * MiB;
constexpr size_t WS_WIN = 6 * MiB;
constexpr size_t WS_WAB = 17 * MiB;
constexpr size_t WS_WOUT = 21 * MiB;
constexpr size_t WS_XN = 24 * MiB;
constexpr size_t WS_MG = WS_XN;
constexpr size_t WS_QA = 120 * MiB, WS_KA = 168 * MiB, WS_VA = 180 * MiB, WS_QB = 192 * MiB, WS_KB = 240 * MiB, WS_VB = 288 * MiB;
constexpr size_t WS_OAB = 336 * MiB;
constexpr size_t WS_SGA = 120 * MiB, WS_SGB = 216 * MiB;
constexpr size_t WS_VTA = 432 * MiB;
constexpr size_t WS_VTB = 438 * MiB;
constexpr size_t WS_XN8 = WS_VB;
constexpr size_t WS_WIN8G = WS_VA + 2 * MiB;
constexpr size_t WS_AMAXG = WS_AMAX + 1024;
constexpr size_t WS_WIN8 = WS_VA;
constexpr size_t WS_END = 462 * MiB;

__device__ __forceinline__ unsigned pk2h(float lo, float hi) { f32x2 v = {lo, hi}; f16x2 b = __builtin_convertvector(v, f16x2); return __builtin_bit_cast(unsigned, b); }
__device__ __forceinline__ float h2f(unsigned short u) { return (float)__builtin_bit_cast(lp_t, u); }
__device__ __forceinline__ unsigned short f2h(float v) { return __builtin_bit_cast(unsigned short, (lp_t)v); }
__device__ __forceinline__ int lane_id() { unsigned z = 0u; asm volatile("" : "+v"(z)); return (int)__builtin_amdgcn_mbcnt_hi(~0u, __builtin_amdgcn_mbcnt_lo(~0u, z)); }
__device__ __forceinline__ float wave_sum(float v) {
#pragma unroll
    for (int o = 1; o < 64; o <<= 1) v += __shfl_xor(v, o);
    return v;
}
__device__ __forceinline__ float silu_f(float v) { return v * __builtin_amdgcn_rcpf(1.0f + __expf(-v)); }
__device__ __forceinline__ float sigm_f(float v) { return __builtin_amdgcn_rcpf(1.0f + __expf(-v)); }

namespace pg8 {
constexpr int BM = 256, BK = 64, HALF = 128, HTB = HALF * BK * 2, STAGE_BYTES = 8 * HTB, NXCD = 8, WGM = 8;
__host__ __device__ __forceinline__ int lds_byte(int r, int c) { const int st = (r >> 4) * 2 + (c >> 5), rr = r & 15, cc = c & 31, ob = rr * 64 + cc * 2; return st * 1024 + (ob ^ (((ob >> 9) & 1) << 5)); }
__host__ __device__ __forceinline__ void stage_rc(int b, int& R, int& C) { const int st = b / 1024, sb = b % 1024, swz = sb ^ (((sb >> 9) & 1) << 5); R = (st >> 1) * 16 + swz / 64; C = (st & 1) * 32 + (swz % 64) / 2; }
__host__ __device__ __forceinline__ int perm32(int rho) { const int n = rho >> 4, i = rho & 15; return 8 * (i >> 2) + 4 * n + (i & 3); }
struct Unit { int pm, pn; };
struct Gemm { const h16_t* A; const h16_t* Bt; int M, N, K; int sc = 0x7f7f; };
struct StaticOrder {
    int nM, nN, nwg, G, c, i2, G2, c2;
    __device__ void init(int M, int N, int G_, int c_) { nM = M / BM; nN = N / BM; nwg = nM * nN; G = G_; c = c_; i2 = 1 << 20; G2 = G_; c2 = c_; }
    __device__ bool next(int i, Unit& u) const {
        long L;
        if (i < i2) L = (long)i * G + c; else { if (c2 < 0) return false; L = (long)i2 * G + (long)(i - i2) * G2 + c2; }
        if (L >= nwg) return false;
        int wgid = (int)L; { const int q = nwg / NXCD, r = nwg % NXCD, xcd = wgid % NXCD, off = wgid / NXCD; wgid = (xcd < r ? xcd * (q + 1) : r * (q + 1) + (xcd - r) * q) + off; }
        const int nig = WGM * nN, gid = wgid / nig, fm = gid * WGM, gsz = (nM - fm) < WGM ? (nM - fm) : WGM;
        u.pm = fm + ((wgid % nig) % gsz); u.pn = (wgid % nig) / gsz; return true;
    }
};
__device__ __forceinline__ i32x8 cat8(f16x8 a, f16x8 b) { const i32x4 x = __builtin_bit_cast(i32x4, a), y = __builtin_bit_cast(i32x4, b); return __builtin_shufflevector(x, y, 0, 1, 2, 3, 4, 5, 6, 7); }
template <class Epi, bool DIAG = false, bool F8 = false>
__device__ __forceinline__ void gemm_phase(LAS unsigned char* lds, const Gemm g, const StaticOrder& S, const Epi& E, int wave_in) {
    int tid = wave_in * 64 + lane_id(); asm volatile("" : "+v"(tid));
    const int wid = wave_in, lane = tid & 63, wr = wid >> 2, wc = wid & 3, fr = lane & 15, fq = lane >> 4;
    const int K = g.K, nt = K / BK;
    int scv = g.sc; asm volatile("" : "+v"(scv)); (void)scv;
    unsigned voffA[2], voffB[2];
#pragma unroll
    for (int i = 0; i < 2; ++i) { int R, C; stage_rc(tid * 16 + i * 8192, R, C); const int Rb = Epi::PERM ? ((R & ~31) + perm32(R & 31)) : R;
        voffA[i] = (unsigned)(R * K + C) * 2u; voffB[i] = (unsigned)(Rb * K + C) * 2u; }
    const size_t kstep = (size_t)(BK * 2);
    const size_t hstep = (size_t)HALF * K * 2;
    const size_t tstep = 2 * hstep;
    const unsigned ldsw = (unsigned)wid * 1024u;
    const int aoff = lds_byte(wr * 64 + fr, fq * 8), boff = lds_byte(wc * 32 + fr, fq * 8);
#define PG8_SA(b, h) (((b) * 2 + (h)) * HTB)
#define PG8_SB(b, h) ((4 + (b) * 2 + (h)) * HTB)
#define PG8_STAGE(bufoff, gbase, voff) do { _Pragma("unroll") for (int _i = 0; _i < 2; ++_i) \
        __builtin_amdgcn_global_load_lds((const unsigned*)((const char*)(gbase) + (voff)[_i]), (LAS unsigned*)(lds + (bufoff) + ldsw + _i * 8192), 16, 0, 0); } while (0)
#define PG8_LD8(p) ({ const i32x4 x_ = *(const LAS i32x4*)(p), y_ = *(const LAS i32x4*)((p) + 1024); (i32x8){x_[0], x_[1], x_[2], x_[3], y_[0], y_[1], y_[2], y_[3]}; })
#define PG8_LDA(dst, b, h) do { if constexpr (F8) { _Pragma("unroll") for (int m = 0; m < 4; ++m) dst##8[m] = PG8_LD8(lds + PG8_SA(b, h) + aoff + m * 2048); } else { \
        _Pragma("unroll") for (int m = 0; m < 4; ++m) _Pragma("unroll") for (int k = 0; k < 2; ++k) dst[m][k] = *(const LAS f16x8*)(lds + PG8_SA(b, h) + aoff + m * 2048 + k * 1024); } } while (0)
#define PG8_LDB(dst, b, h) do { if constexpr (F8) { _Pragma("unroll") for (int n = 0; n < 2; ++n) dst##8[n] = PG8_LD8(lds + PG8_SB(b, h) + boff + n * 2048); } else { \
        _Pragma("unroll") for (int n = 0; n < 2; ++n) _Pragma("unroll") for (int k = 0; k < 2; ++k) dst[n][k] = *(const LAS f16x8*)(lds + PG8_SB(b, h) + boff + n * 2048 + k * 1024); } } while (0)
#define PG8_MMA(ai, bj, At, Bt) do { __builtin_amdgcn_s_setprio(1); if constexpr (F8) { _Pragma("unroll") for (int m = 0; m < 4; ++m) _Pragma("unroll") for (int n = 0; n < 2; ++n) \
        { if (n == 0) acc8[ai][bj][m].lo = MFMA8S_G(Bt##8[n], At##8[m], acc8[ai][bj][m].lo); else acc8[ai][bj][m].hi = MFMA8S_G(Bt##8[n], At##8[m], acc8[ai][bj][m].hi); } \
        _Pragma("unroll") for (int m = 0; m < 4; ++m) asm volatile("" : "+v"(acc8[ai][bj][m])); } else { \
        _Pragma("unroll") for (int m = 0; m < 4; ++m) _Pragma("unroll") for (int n = 0; n < 2; ++n) _Pragma("unroll") for (int k = 0; k < 2; ++k) \
        acc[ai][bj][m][n] = MFMA16(Bt[n][k], At[m][k], acc[ai][bj][m][n]); } __builtin_amdgcn_s_setprio(0); } while (0)
#define PG8_WAIT_V(n) asm volatile("s_waitcnt vmcnt(" #n ")" ::: "memory")
#define PG8_WAIT_L(n) asm volatile("s_waitcnt lgkmcnt(" #n ")" ::: "memory")
#define PG8_BAR __builtin_amdgcn_s_barrier()
#define PG8_SCHED __builtin_amdgcn_sched_barrier(0)
    Unit cur, nxt; int ui = 0;
    if (!S.next(0, cur)) return;
    f32x4 acc[2][2][4][2];
    f32x8 acc8[2][2][4];
#pragma unroll
    for (int a = 0; a < 2; ++a)
#pragma unroll
        for (int b = 0; b < 2; ++b)
#pragma unroll
            for (int m = 0; m < 4; ++m) acc8[a][b][m] = (f32x8){0.f, 0.f, 0.f, 0.f, 0.f, 0.f, 0.f, 0.f};
#pragma unroll
    for (int a = 0; a < 2; ++a)
#pragma unroll
        for (int b = 0; b < 2; ++b)
#pragma unroll
            for (int m = 0; m < 4; ++m)
#pragma unroll
                for (int n = 0; n < 2; ++n) acc[a][b][m][n] = (f32x4){0.f, 0.f, 0.f, 0.f};
    f16x8 At[4][2], B0[2][2], B1[2][2]; i32x8 At8[4], B08[2], B18[2];
    const char* cA = (const char*)g.A + (size_t)cur.pm * tstep; const char* cB = (const char*)g.Bt + (size_t)cur.pn * tstep;
    PG8_STAGE(PG8_SB(0, 0), cB, voffB); if (!DIAG) PG8_STAGE(PG8_SB(0, 1), cB + hstep, voffB); PG8_STAGE(PG8_SA(0, 0), cA, voffA); PG8_STAGE(PG8_SA(0, 1), cA + hstep, voffA);
    if (wr == 1) PG8_BAR;
    PG8_WAIT_V(2); PG8_BAR;
    PG8_STAGE(PG8_SB(1, 0), cB + kstep, voffB); PG8_STAGE(PG8_SA(1, 0), cA + kstep, voffA); if (!DIAG) PG8_STAGE(PG8_SB(1, 1), cB + hstep + kstep, voffB);
    if (DIAG) { PG8_WAIT_V(4); } else { PG8_WAIT_V(6); } PG8_BAR;
    for (;;) {
        const bool has_next = S.next(ui + 1, nxt);
        const char* nA = has_next ? (const char*)g.A + (size_t)nxt.pm * tstep : cA; const char* nB = has_next ? (const char*)g.Bt + (size_t)nxt.pn * tstep : cB;
#pragma unroll 1
        for (int t = 0; t < nt; t += 2) {
            const bool last = (t == nt - 2); const bool lo_half = (2 * t < nt); (void)lo_half;
            const char* a1 = cA + (size_t)(t + 1) * kstep;
            const char* a2 = last ? nA : cA + (size_t)(t + 2) * kstep; const char* b2 = last ? nB : cB + (size_t)(t + 2) * kstep;
            const char* a3 = a2 + kstep; const char* b3 = b2 + kstep;
            const bool lo2 = last || (2 * (t + 2) < nt), lo3 = last || (2 * (t + 3) < nt); (void)lo2; (void)lo3;
#define PG8_WV() do { if (DIAG) { PG8_WAIT_V(6); } else { PG8_WAIT_V(8); } } while (0)
            if (!DIAG || lo_half) PG8_LDB(B0, 0, 0); if (!DIAG || !lo_half) PG8_LDB(B1, 0, 1); PG8_SCHED; PG8_LDA(At, 0, 0); PG8_STAGE(PG8_SA(1, 1), a1 + hstep, voffA);
            PG8_WV(); PG8_WAIT_L(0); PG8_BAR; if (!DIAG || lo_half) PG8_MMA(0, 0, At, B0); if (!DIAG || !lo_half) PG8_MMA(0, 1, At, B1); PG8_BAR; PG8_SCHED;
            PG8_LDA(At, 0, 1); if (!DIAG || lo2) PG8_STAGE(PG8_SB(0, 0), b2, voffB); if (!DIAG || !lo2) PG8_STAGE(PG8_SB(0, 1), b2 + hstep, voffB); PG8_STAGE(PG8_SA(0, 0), a2, voffA);
            PG8_WV(); PG8_WAIT_L(0); PG8_BAR; if (!DIAG || lo_half) PG8_MMA(1, 0, At, B0); if (!DIAG || !lo_half) PG8_MMA(1, 1, At, B1); PG8_BAR; PG8_SCHED;
            if (!DIAG || lo_half) PG8_LDB(B0, 1, 0); if (!DIAG || !lo_half) PG8_LDB(B1, 1, 1); PG8_SCHED; PG8_LDA(At, 1, 0); PG8_STAGE(PG8_SA(0, 1), a2 + hstep, voffA);
            PG8_WV(); PG8_WAIT_L(0); PG8_BAR; if (!DIAG || lo_half) PG8_MMA(0, 0, At, B0); if (!DIAG || !lo_half) PG8_MMA(0, 1, At, B1); PG8_BAR; PG8_SCHED;
            PG8_LDA(At, 1, 1); if (!DIAG || lo3) PG8_STAGE(PG8_SB(1, 0), b3, voffB); if (!DIAG || !lo3) PG8_STAGE(PG8_SB(1, 1), b3 + hstep, voffB); PG8_STAGE(PG8_SA(1, 0), a3, voffA);
            PG8_WV(); PG8_WAIT_L(0); PG8_BAR; if (!DIAG || lo_half) PG8_MMA(1, 0, At, B0); if (!DIAG || !lo_half) PG8_MMA(1, 1, At, B1); PG8_BAR; PG8_SCHED;
#undef PG8_WV
        }
        if (wr == 0) PG8_BAR;
        if constexpr (F8) {
#pragma unroll
            for (int a = 0; a < 2; ++a)
#pragma unroll
                for (int b = 0; b < 2; ++b)
#pragma unroll
                    for (int m = 0; m < 4; ++m) { acc[a][b][m][0] = acc8[a][b][m].lo; acc[a][b][m][1] = acc8[a][b][m].hi; acc8[a][b][m] = (f32x8){0.f, 0.f, 0.f, 0.f, 0.f, 0.f, 0.f, 0.f}; }
        }
        { int l2 = lane_id(); asm volatile("" : "+v"(l2)); E(acc, cur, wr, wc, l2 & 15, l2 >> 4); }
        if (!has_next) break;
#pragma unroll
        for (int a = 0; a < 2; ++a)
#pragma unroll
            for (int b = 0; b < 2; ++b)
#pragma unroll
                for (int m = 0; m < 4; ++m)
#pragma unroll
                    for (int n = 0; n < 2; ++n) acc[a][b][m][n] = (f32x4){0.f, 0.f, 0.f, 0.f};
        cur = nxt; cA = nA; cB = nB; ++ui;
        if (wr == 1) PG8_BAR;
    }
    PG8_WAIT_V(0);
    PG8_BAR;
#undef PG8_SA
#undef PG8_SB
#undef PG8_STAGE
#undef PG8_LDA
#undef PG8_LDB
#undef PG8_MMA
#undef PG8_WAIT_V
#undef PG8_WAIT_L
#undef PG8_BAR
#undef PG8_SCHED
}
}

__device__ __forceinline__ float xsum16(float x) { const auto r = __builtin_amdgcn_permlane16_swap(__float_as_uint(x), __float_as_uint(x), false, false); return __uint_as_float(r[0]) + __uint_as_float(r[1]); }
__device__ __forceinline__ float xsum32(float x) { const auto r = __builtin_amdgcn_permlane32_swap(__float_as_uint(x), __float_as_uint(x), false, false); return __uint_as_float(r[0]) + __uint_as_float(r[1]); }
struct EpiInProj {
    static constexpr bool PERM = true;
    int part; unsigned char* ws; int use8; int pnoff; float wsc;
    __device__ __forceinline__ void operator()(const f32x4 (&acc)[2][2][4][2], const pg8::Unit& u, int wr, int wc, int fr, int fq) const {
        asm volatile("" : "+v"(fr), "+v"(fq));
        const int row0 = u.pm * 256 + wr * 64 + fr;
        const int pi = u.pn + pnoff;
        const int T = part == 0 ? (pi < 2 ? pi : (pi < 6 ? pi + 3 : (pi == 6 ? 2 : pi + 2))) : (pi < 2 ? pi + 3 : pi + 9);
        if (part == 0) {
            const bool normed = (T <= 1) || (T == 2 && wc < 2) || (T >= 5 && T <= 8);
            if (normed) {
                const bool isA = (T <= 2), isQ = (T <= 1) || (T == 5) || (T == 6);
                const float* gw = (const float*)(ws + WS_NRM) + 64 * ((isA ? 0 : 2) + (isQ ? 0 : 1));
                h16_t* dst; int pitch, colbase;
                if (T <= 1) { dst = (h16_t*)(ws + WS_QA); pitch = 512; colbase = 256 * T + 64 * wc; }
                else if (T == 2) { dst = (h16_t*)(ws + WS_KA); pitch = 128; colbase = 64 * wc; }
                else if (T <= 6) { dst = (h16_t*)(ws + WS_QB); pitch = 512; colbase = 256 * (T - 5) + 64 * wc; }
                else { dst = (h16_t*)(ws + WS_KB); pitch = 512; colbase = 256 * (T - 7) + 64 * wc; }
                f32x4 gv[2][2];
#pragma unroll
                for (int bj = 0; bj < 2; ++bj)
#pragma unroll
                    for (int n = 0; n < 2; ++n) gv[bj][n] = *(const f32x4*)(gw + 32 * bj + 8 * fq + 4 * n) * (use8 ? SQK6 : 1.0f);
                const float sc = isQ ? C2 : 1.0f;
                const int pidx32 = ((fr | (fq << 4)) ^ 32) << 2, pidx16 = ((fr | (fq << 4)) ^ 16) << 2;
                const h16_t* tar = (const h16_t*)(ws + WS_TAR); const h16_t* tac = (const h16_t*)(ws + WS_TAC); const h16_t* tb = (const h16_t*)(ws + WS_TB);
                const int pitch6 = (pitch >> 6) * 48, hoff6 = (colbase >> 6) * 48;
                f32x4 ysv[4][2][2];
                extern __shared__ __attribute__((aligned(16))) unsigned char epi_lds_[];
                LAS unsigned char* stl = (LAS unsigned char*)epi_lds_ + pg8::STAGE_BYTES + (wr * 4 + wc) * 3072;
#pragma unroll
                for (int ai = 0; ai < 2; ++ai) {
#pragma unroll
                    for (int m = 0; m < 4; ++m) {
                        const int r = row0 + ai * 128 + m * 16, t = r & (SEQ - 1);
                        float ss = 0.f;
#pragma unroll
                        for (int bj = 0; bj < 2; ++bj)
#pragma unroll
                            for (int n = 0; n < 2; ++n) { const f32x4 v = acc[ai][bj][m][n]; ss += (v[0] * v[0] + v[1] * v[1]) + (v[2] * v[2] + v[3] * v[3]); }
                        ss = xsum16(ss); ss = xsum32(ss);
                        const float rs = __builtin_amdgcn_rsqf(ss * (wsc * wsc * (1.0f / 64.0f)) + EPS) * wsc;
                        f32x4 y[2][2];
#pragma unroll
                        for (int bj = 0; bj < 2; ++bj)
#pragma unroll
                            for (int n = 0; n < 2; ++n) y[bj][n] = acc[ai][bj][m][n] * rs * gv[bj][n];
                        if (isA) {
#pragma unroll
                            for (int bj = 0; bj < 2; ++bj) {
                                const int pos = bj == 0 ? (t >> 6) : (t & 63);
                                const h16_t* tp = (bj == 0 ? tar : tac) + pos * 32 + 8 * (fq & 1);
                                const u32x4 cw = *(const u32x4*)tp, sw = *(const u32x4*)(tp + 16);
                                const float sgn = fq < 2 ? -1.0f : 1.0f;
#pragma unroll
                                for (int n = 0; n < 2; ++n)
#pragma unroll
                                    for (int i = 0; i < 4; ++i) {
                                        const int e = 4 * n + i; const unsigned cwe = cw[e >> 1], swe = sw[e >> 1];
                                        const float cs = h2f((unsigned short)((e & 1) ? (cwe >> 16) : (cwe & 0xffffu))), sn = h2f((unsigned short)((e & 1) ? (swe >> 16) : (swe & 0xffffu)));
                                        const float yv = y[bj][n][i], pv = __uint_as_float((unsigned)__builtin_amdgcn_ds_bpermute(pidx32, (int)__float_as_uint(yv)));
                                        y[bj][n][i] = yv * cs + sgn * pv * sn;
                                    }
                            }
                        } else {
                            const h16_t* tp = tb + t * 16;
                            const u32x4 cw = *(const u32x4*)tp, sw = *(const u32x4*)(tp + 8);
                            const float sgn = fq == 0 ? -1.0f : 1.0f;
#pragma unroll
                            for (int n = 0; n < 2; ++n)
#pragma unroll
                                for (int i = 0; i < 4; ++i) {
                                    const int e = 4 * n + i; const unsigned cwe = cw[e >> 1], swe = sw[e >> 1];
                                    const float cs = h2f((unsigned short)((e & 1) ? (cwe >> 16) : (cwe & 0xffffu))), sn = h2f((unsigned short)((e & 1) ? (swe >> 16) : (swe & 0xffffu)));
                                    const float yv = y[0][n][i], pv = __uint_as_float((unsigned)__builtin_amdgcn_ds_bpermute(pidx16, (int)__float_as_uint(yv)));
                                    y[0][n][i] = fq < 2 ? (yv * cs + sgn * pv * sn) : yv;
                                }
                        }
#pragma unroll
                        for (int bj = 0; bj < 2; ++bj) {
                            if (use8) { ysv[m][bj][0] = y[bj][0]; ysv[m][bj][1] = y[bj][1];
                            } else {
                            u32x4 w; w.x = pk2h(y[bj][0][0] * sc, y[bj][0][1] * sc); w.y = pk2h(y[bj][0][2] * sc, y[bj][0][3] * sc); w.z = pk2h(y[bj][1][0] * sc, y[bj][1][1] * sc); w.w = pk2h(y[bj][1][2] * sc, y[bj][1][3] * sc);
                            *(u32x4*)(dst + (size_t)r * pitch + colbase + 32 * bj + 8 * fq) = w; }
                        }
                    }
                    if (use8) {
#pragma unroll
                        for (int bj = 0; bj < 2; ++bj) {
                            f32x16 s0, s1;
#pragma unroll
                            for (int i = 0; i < 16; ++i) { const int m_ = i >> 2, c0 = 2 * (i & 3); s0[i] = ysv[m_][bj][c0 >> 2][c0 & 3]; s1[i] = ysv[m_][bj][(c0 + 1) >> 2][(c0 + 1) & 3]; }
                            const i32x6 d6 = __builtin_amdgcn_cvt_scalef32_2xpk16_fp6_f32(s0, s1, 1.0f);
                            const int dwoff = fq == 0 ? 16 * bj : (fq == 1 ? 16 * bj + 8 : (fq == 2 ? 16 * bj + 12 : 36 + 8 * bj));
                            const int shoff = fq == 0 ? 16 * bj + 4 : (fq == 1 ? 16 * bj + 6 : (fq == 2 ? 32 + 8 * bj : 34 + 8 * bj));
#pragma unroll
                            for (int m = 0; m < 4; ++m) {
                                const unsigned a0 = (unsigned)d6[3 * (m >> 1)], a1 = (unsigned)d6[3 * (m >> 1) + 1], a2 = (unsigned)d6[3 * (m >> 1) + 2];
                                const unsigned lo = (m & 1) ? ((a1 >> 16) | (a2 << 16)) : a0, hi16 = (m & 1) ? (a2 >> 16) : (a1 & 0xffffu);
                                const unsigned dwv = (fq & 1) ? ((lo >> 16) | (hi16 << 16)) : lo, shv = (fq & 1) ? (lo & 0xffffu) : hi16;
                                LAS unsigned char* p6 = stl + (m * 16 + fr) * 48;
                                *(LAS unsigned*)(p6 + dwoff) = dwv; *(LAS unsigned short*)(p6 + shoff) = (unsigned short)shv;
                            }
                        }
                        asm volatile("s_waitcnt lgkmcnt(0)" ::: "memory");
                        {   const int lrow = fr + 16 * fq;
                            unsigned char* g6 = (unsigned char*)dst + (size_t)(u.pm * 256 + wr * 64 + ai * 128 + lrow) * pitch6 + hoff6;
#pragma unroll
                            for (int j = 0; j < 3; ++j) { const u32x4 v = *(const LAS u32x4*)(stl + lrow * 48 + 16 * j); *(u32x4*)(g6 + 16 * j) = v; }
                        }
                        asm volatile("s_waitcnt lgkmcnt(0)" ::: "memory");
                    }
                }
            } else if (use8) {
                unsigned char* vt; int drow0;
                if (T == 2) { vt = ws + WS_VTA; drow0 = (wc - 2) * 64; } else { vt = ws + WS_VTB; drow0 = (2 * (T - 9) + (wc >> 1)) * 128 + (wc & 1) * 64; }
                const int rows_per_b = (T == 2) ? 128 : 512;
                extern __shared__ __attribute__((aligned(16))) unsigned char epi_lds_[];
                LAS unsigned char* stl = (LAS unsigned char*)epi_lds_ + pg8::STAGE_BYTES + (wr * 4 + wc) * 3072;
#pragma unroll
                for (int ai = 0; ai < 2; ++ai) {
                    const int rt = u.pm * 256 + wr * 64 + ai * 128, b = rt >> 13, tk0 = rt & (SEQ - 1);
#pragma unroll
                    for (int bj = 0; bj < 2; ++bj) {
#pragma unroll
                        for (int m = 0; m < 4; ++m) {
                            const int tau = 16 * m + fr;
                            const int pos = 32 * ((tau >> 2) & 1) + 16 * (tau >> 5) + 4 * ((tau >> 3) & 3) + (tau & 3);
#pragma unroll
                            for (int n = 0; n < 2; ++n) { const f32x4 v = acc[ai][bj][m][n];
                                int w0 = 0; w0 = __builtin_amdgcn_cvt_pk_fp8_f32(v[0], v[1], w0, false); w0 = __builtin_amdgcn_cvt_pk_fp8_f32(v[2], v[3], w0, true);
#pragma unroll
                                for (int i = 0; i < 4; ++i) stl[(8 * fq + 4 * n + i) * 64 + pos] = (unsigned char)((unsigned)w0 >> (8 * i)); }
                        }
                        asm volatile("s_waitcnt lgkmcnt(0)" ::: "memory");
                        const int ln_ = fr + 16 * fq;
#pragma unroll
                        for (int j = 0; j < 2; ++j) { const int id = ln_ + 64 * j, dl = id >> 2, c16 = id & 3;
                            const u32x4 v = *(const LAS u32x4*)(stl + dl * 64 + 16 * c16);
                            *(u32x4*)(vt + ((size_t)(b * rows_per_b + drow0 + 32 * bj + dl)) * SEQ + tk0 + 16 * c16) = v; }
                        asm volatile("s_waitcnt lgkmcnt(0)" ::: "memory");
                    }
                }
            } else {
                h16_t* dst; int pitch, colbase;
                if (T == 2) { dst = (h16_t*)(ws + WS_VA); pitch = 128; colbase = 64 * (wc - 2); }
                else { dst = (h16_t*)(ws + WS_VB); pitch = 512; colbase = 256 * (T - 9) + 64 * wc; }
#pragma unroll
                for (int ai = 0; ai < 2; ++ai)
#pragma unroll
                    for (int m = 0; m < 4; ++m) {
                        const int r = row0 + ai * 128 + m * 16;
#pragma unroll
                        for (int bj = 0; bj < 2; ++bj) {
                            const f32x4 v0 = acc[ai][bj][m][0], v1 = acc[ai][bj][m][1];
                            u32x4 w; w.x = pk2h(v0[0], v0[1]); w.y = pk2h(v0[2], v0[3]); w.z = pk2h(v1[0], v1[1]); w.w = pk2h(v1[2], v1[3]);
                            *(u32x4*)(dst + (size_t)r * pitch + colbase + 32 * bj + 8 * fq) = w;
                        }
                    }
            }
        } else {
            if (T <= 12) {
                h16_t* oab = (h16_t*)(ws + WS_OAB);
                const int colt = (T >= 11 ? 512 + 256 * (T - 11) : 256 * (T - 3)) + 64 * wc;
#pragma unroll
                for (int aim = 0; aim < 4; ++aim) { const int ai = aim >> 1, m0 = (aim & 1) * 2;
                    u32x4 ovs[2][4][2];
#pragma unroll
                    for (int m = m0; m < m0 + 2; ++m)
#pragma unroll
                        for (int bj = 0; bj < 2; ++bj) ovs[ai][m][bj] = *(const u32x4*)(oab + (size_t)(row0 + ai * 128 + m * 16) * 1024 + colt + 16 * fq + 8 * bj);
                    __builtin_amdgcn_sched_barrier(0);
#pragma unroll
                    for (int m = m0; m < m0 + 2; ++m) {
                        const int r = row0 + ai * 128 + m * 16;
#pragma unroll
                        for (int bj = 0; bj < 2; ++bj) {
                            h16_t* p = oab + (size_t)r * 1024 + colt + 16 * fq + 8 * bj;
                            const u32x4 ov = ovs[ai][m][bj];
                            float o[8];
#pragma unroll
                            for (int e = 0; e < 4; ++e) { o[2 * e] = h2f((unsigned short)(ov[e] & 0xffffu)); o[2 * e + 1] = h2f((unsigned short)(ov[e] >> 16)); }
                            float q[8];
#pragma unroll
                            for (int n = 0; n < 2; ++n)
#pragma unroll
                                for (int i = 0; i < 4; ++i) q[4 * n + i] = o[4 * n + i] * silu_f(acc[ai][bj][m][n][i]);
                            u32x4 w; w.x = pk2h(q[0], q[1]); w.y = pk2h(q[2], q[3]); w.z = pk2h(q[4], q[5]); w.w = pk2h(q[6], q[7]);
                            *(u32x4*)p = w;
                        }
                    }
                    __builtin_amdgcn_sched_barrier(0);
                }
            } else {
                unsigned char* dst = ws + (T <= 16 ? WS_SGA : WS_SGB);
                const int colt = 256 * (T <= 16 ? T - 13 : T - 17) + 64 * wc;
#pragma unroll
                for (int ai = 0; ai < 2; ++ai)
#pragma unroll
                    for (int m = 0; m < 4; ++m) {
                        const int r = row0 + ai * 128 + m * 16;
                        u32x4 w;
#pragma unroll
                        for (int bj = 0; bj < 2; ++bj) {
                            const f32x4 v0 = acc[ai][bj][m][0], v1 = acc[ai][bj][m][1];
                            unsigned w0 = 0u, w1 = 0u;
#pragma unroll
                            for (int i = 0; i < 4; ++i) {
                                w0 = __builtin_amdgcn_cvt_pk_u8_f32(__builtin_amdgcn_rcpf(__builtin_fmaf(__builtin_amdgcn_exp2f(v0[i] * wsc), 1.0f / 255.0f, 1.0f / 255.0f)), i, w0);
                                w1 = __builtin_amdgcn_cvt_pk_u8_f32(__builtin_amdgcn_rcpf(__builtin_fmaf(__builtin_amdgcn_exp2f(v1[i] * wsc), 1.0f / 255.0f, 1.0f / 255.0f)), i, w1); }
                            w[2 * bj] = w0; w[2 * bj + 1] = w1;
                        }
                        *(u32x4*)(dst + (size_t)r * 1024 + colt + 16 * fq) = w;
                    }
            }
        }
    }
};
struct EpiMerge {
    static constexpr bool PERM = true;
    const unsigned char* SGA; const unsigned char* SGB; h16_t* MG;
    __device__ __forceinline__ void operator()(const f32x4 (&acc)[2][2][4][2], const pg8::Unit& u, int wr, int wc, int fr, int fq) const {
        asm volatile("" : "+v"(fr), "+v"(fq));
        const int row0 = u.pm * 256 + wr * 64 + fr, col0 = u.pn * 128 + wc * 32 + 8 * fq;
#pragma unroll
        for (int ai = 0; ai < 2; ++ai) {
            u32x2 gas[2][4], gbs[2][4];
#pragma unroll
            for (int m = 0; m < 4; ++m) { const size_t off = (size_t)(row0 + ai * 128 + m * 16) * 1024 + col0; gas[ai][m] = *(const u32x2*)(SGA + off); gbs[ai][m] = *(const u32x2*)(SGB + off); }
            __builtin_amdgcn_sched_barrier(0);
#pragma unroll
            for (int m = 0; m < 4; ++m) {
                const size_t off = (size_t)(row0 + ai * 128 + m * 16) * 1024 + col0;
                const u32x2 ga = gas[ai][m], gb = gbs[ai][m];
                float q[8];
#pragma unroll
                for (int e = 0; e < 8; ++e) {
                    const float a = (float)((ga[e >> 2] >> (8 * (e & 3))) & 0xffu), b = (float)((gb[e >> 2] >> (8 * (e & 3))) & 0xffu);
                    q[e] = (a * acc[ai][0][m][e >> 2][e & 3] + b * acc[ai][1][m][e >> 2][e & 3]) * (1.0f / 255.0f);
                }
                u32x4 w; w.x = pk2h(q[0], q[1]); w.y = pk2h(q[2], q[3]); w.z = pk2h(q[4], q[5]); w.w = pk2h(q[6], q[7]);
                *(u32x4*)(MG + off) = w;
            }
            __builtin_amdgcn_sched_barrier(0);
        }
    }
};
struct EpiOut {
    static constexpr bool PERM = false;
    const float* xp; long xs_delta; const float* gate; float* out;
    __device__ __forceinline__ void operator()(const f32x4 (&acc)[2][2][4][2], const pg8::Unit& u, int wr, int wc, int fr, int fq) const {
        asm volatile("" : "+v"(fr), "+v"(fq));
        const int row0 = u.pm * 256 + wr * 64 + fr, col0 = u.pn * 256 + wc * 32 + 4 * fq;
        const float* grow = gate + ((u.pm * 256) >> 13) * DM;
        f32x4 gvs[2][2];
#pragma unroll
        for (int bj = 0; bj < 2; ++bj)
#pragma unroll
            for (int n = 0; n < 2; ++n) gvs[bj][n] = *(const f32x4*)(grow + col0 + bj * 128 + n * 16);
#pragma unroll
        for (int aim = 0; aim < 4; ++aim) { const int ai = aim >> 1, m0 = (aim & 1) * 2;
            f32x4 xvs[4][2][2];
#pragma unroll
            for (int m = m0; m < m0 + 2; ++m) {
                const int r = row0 + ai * 128 + m * 16;
                const float* xrow = (const float*)((const char*)(xp + (size_t)r * DM) + (r >= TOKP ? xs_delta : 0l));
#pragma unroll
                for (int bj = 0; bj < 2; ++bj)
#pragma unroll
                    for (int n = 0; n < 2; ++n) xvs[m][bj][n] = *(const f32x4*)(xrow + col0 + bj * 128 + n * 16);
            }
            __builtin_amdgcn_sched_barrier(0);
#pragma unroll
            for (int m = m0; m < m0 + 2; ++m) {
                const int r = row0 + ai * 128 + m * 16;
#pragma unroll
                for (int bj = 0; bj < 2; ++bj)
#pragma unroll
                    for (int n = 0; n < 2; ++n) {
                        const int c = col0 + bj * 128 + n * 16;
                        *(f32x4*)(out + (size_t)r * DM + c) = xvs[m][bj][n] + gvs[bj][n] * acc[ai][bj][m][n];
                    }
            }
            __builtin_amdgcn_sched_barrier(0);
        }
    }
};

namespace att {
constexpr int NW = 8, QBLK = 32, QB = QBLK * NW, KVBLK = 64, NT = SEQ / KVBLK;
constexpr int NSLOT = 3, SLOTB = 8192;
constexpr int LDS_K = 0, LDS_V = NSLOT * SLOTB, LDS_WS = LDS_V + NSLOT * 2 * SLOTB, LDS_OST = LDS_WS + NW * 64 * 4, OST_WAVE = 8192, LDS_BYTES = LDS_OST + NW * OST_WAVE;
__device__ __forceinline__ int crow(int r, int hi) { return (r & 3) + 8 * (r >> 2) + 4 * hi; }
#define SBAR() __builtin_amdgcn_sched_barrier(0)
__device__ __forceinline__ void glds16(const void* gsrc, unsigned lds_dst) { unsigned keep;
    asm volatile("s_mov_b32 %0, m0\n\ts_mov_b32 m0, %2\n\ts_nop 0\n\tglobal_load_lds_dwordx4 %1, off\n\ts_mov_b32 m0, %0" : "=&s"(keep) : "v"(gsrc), "s"(lds_dst) : "memory"); }
__device__ __forceinline__ float max3f(float a, float b, float c) { float r; asm("v_max3_f32 %0, %1, %2, %3" : "=v"(r) : "v"(a), "v"(b), "v"(c)); return r; }
__device__ __forceinline__ float max2f(float a, float b) { float r; asm("v_max_f32_e32 %0, %1, %2" : "=v"(r) : "v"(a), "v"(b)); return r; }
__device__ __forceinline__ float fadd_s(float a, float b) { float r; asm("v_add_f32_e32 %0, %1, %2" : "=v"(r) : "v"(a), "v"(b)); return r; }
__device__ __forceinline__ float fsub_s(float a, float b) { float r; asm("v_sub_f32_e32 %0, %1, %2" : "=v"(r) : "v"(a), "v"(b)); return r; }
#define WAIT_BAR(N) asm volatile("s_waitcnt vmcnt(" #N ") lgkmcnt(0)\n\ts_barrier" ::: "memory")
__device__ __forceinline__ void qkt(f32x16& p0, f32x16& p1, const char* Kslot, const f16x8* qr, const f32x16& negm, int r32, int hi) {
    const char* kb = Kslot + hi * 1024 + r32 * 16;
#pragma unroll
    for (int d0 = 0; d0 < 4; ++d0) {
        const f16x8 b0 = *reinterpret_cast<const f16x8*>(kb + d0 * 2048);
        const f16x8 b1 = *reinterpret_cast<const f16x8*>(kb + d0 * 2048 + 512);
        if (d0 == 0) { p0 = MFMA32(b0, qr[0], negm); p1 = MFMA32(b1, qr[0], negm); }
        else { p0 = MFMA32(b0, qr[d0], p0); p1 = MFMA32(b1, qr[d0], p1); } }
}
typedef LAS const char* lds_cptr;
typedef short v4i16_t __attribute__((ext_vector_type(4)));
__device__ __forceinline__ void kload8(f16x8* kf, lds_cptr kp) {
    kf[0] = *(const LAS f16x8*)(kp);        kf[1] = *(const LAS f16x8*)(kp + 512);
    kf[2] = *(const LAS f16x8*)(kp + 2048); kf[3] = *(const LAS f16x8*)(kp + 2560);
    kf[4] = *(const LAS f16x8*)(kp + 4096); kf[5] = *(const LAS f16x8*)(kp + 4608);
    kf[6] = *(const LAS f16x8*)(kp + 6144); kf[7] = *(const LAS f16x8*)(kp + 6656);
}
__device__ __forceinline__ void kload2(f16x8* kf, lds_cptr kp, int j) { kf[2 * j] = *(const LAS f16x8*)(kp + j * 2048); kf[2 * j + 1] = *(const LAS f16x8*)(kp + j * 2048 + 512); }
__device__ __forceinline__ s16x4 vtr(lds_cptr p) { return __builtin_bit_cast(s16x4, __builtin_amdgcn_ds_read_tr16_b64_v4i16((LAS v4i16_t*)p)); }
__device__ __forceinline__ float rowmax(const f32x16& p0, const f32x16& p1) {
    float a = max3f(p0[0], p0[1], p1[0]), b = max3f(p0[2], p0[3], p1[1]); a = max3f(a, p1[2], p1[3]);
#pragma unroll
    for (int r = 4; r < 16; r += 4) { a = max3f(a, p0[r], p0[r + 1]); b = max3f(b, p0[r + 2], p0[r + 3]); a = max3f(a, p1[r], p1[r + 1]); b = max3f(b, p1[r + 2], p1[r + 3]); }
    const float m = max2f(a, b);
    auto rr = __builtin_amdgcn_permlane32_swap(__float_as_uint(m), __float_as_uint(m), false, false);
    return max2f(__uint_as_float(rr[0]), __uint_as_float(rr[1]));
}
__device__ __forceinline__ f16x8 mk8(s16x4 lo, s16x4 hi) { typedef short s16x8 __attribute__((ext_vector_type(8))); s16x8 v = {lo[0], lo[1], lo[2], lo[3], hi[0], hi[1], hi[2], hi[3]}; return __builtin_bit_cast(f16x8, v); }
__device__ __forceinline__ void pv(f32x16* o, int vb, f16x8 pa0, f16x8 pa1, f16x8 pa2, f16x8 pa3) {
#pragma unroll
    for (int d0 = 0; d0 < 2; ++d0) { s16x4 lo[4], hi[4];
#pragma unroll
        for (int ks = 0; ks < 4; ++ks) {
            asm volatile("ds_read_b64_tr_b16 %0,%1 offset:%c2" : "=&v"(lo[ks]) : "v"(vb), "i"(d0 * 4096 + ks * 1024) : "memory");
            asm volatile("ds_read_b64_tr_b16 %0,%1 offset:%c2" : "=&v"(hi[ks]) : "v"(vb), "i"(d0 * 4096 + ks * 1024 + 512) : "memory"); }
        asm volatile("s_waitcnt lgkmcnt(0)" ::: "memory"); SBAR();
        o[d0] = MFMA32(pa0, mk8(lo[0], hi[0]), o[d0]);
        o[d0] = MFMA32(pa1, mk8(lo[1], hi[1]), o[d0]);
        o[d0] = MFMA32(pa2, mk8(lo[2], hi[2]), o[d0]);
        o[d0] = MFMA32(pa3, mk8(lo[3], hi[3]), o[d0]);
    }
}
template <int THRL, bool FAST> __device__ __forceinline__ void attn_pass(const h16_t* Qw, int QP, const h16_t* Kh, int KP, const h16_t* Vh, int VP, char* shm, f32x16 (&o)[2], float& l_out, int wave_in) {
    int tid = wave_in * 64 + lane_id(); asm volatile("" : "+v"(tid));
    const int lane = tid & 63, r32 = lane & 31, hi = lane >> 5; const int wid = wave_in;
    const unsigned lds0 = (unsigned)(uintptr_t)shm;
    float* wsf = (float*)(shm + LDS_WS) + wid * 64;
    const h16_t* ksrc = Kh + (long)lane * KP + wid * 8;
    const h16_t* vsrc = Vh + (long)(16 * (wid & 3) + (lane >> 2)) * VP + (wid >> 2) * 32 + (lane & 3) * 8;
    const unsigned kdst = lds0 + LDS_K + wid * 1024, vdst = lds0 + LDS_V + wid * 1024;
#define DMA_K(t, slot) glds16(ksrc + (long)(t) * KVBLK * KP, (unsigned)__builtin_amdgcn_readfirstlane(kdst + (slot)))
#define DMA_V(t, slot) glds16(vsrc + (long)(t) * KVBLK * VP, (unsigned)__builtin_amdgcn_readfirstlane(vdst + (slot)))
    const int vb0 = (int)(lds0 + LDS_V) + ((lane >> 4) & 1) * 32 + (lane & 3) * 8 + (4 * hi + ((lane & 15) >> 2)) * 64;
    const char* Kbase = shm + LDS_K; f16x8 kf[8];
    const lds_cptr shm3 = (lds_cptr)shm; const lds_cptr kp0 = shm3 + LDS_K + hi * 1024 + r32 * 16; const lds_cptr vp0 = shm3 + LDS_V + ((lane >> 4) & 1) * 32 + (lane & 3) * 8 + (4 * hi + ((lane & 15) >> 2)) * 64;
    DMA_K(0, 0); DMA_V(0, 0); DMA_K(1, SLOTB);
    f16x8 qr[4];
#pragma unroll
    for (int d0 = 0; d0 < 4; ++d0) qr[d0] = *reinterpret_cast<const f16x8*>(&Qw[(long)r32 * QP + d0 * 16 + hi * 8]);
    float mhat = 0.f, l_reg = 0.f; o[0] = f32x16{}; o[1] = f32x16{}; f32x16 negm = f32x16{}; if constexpr (!FAST) asm volatile("" : "+v"(negm));
    bool resc = false;
#define NEGM (FAST ? f32x16{} : negm)
#define START(P0, P1) do { if constexpr (!FAST) { const float rm = rowmax(P0, P1); resc = false; \
    { const float dl = rm; mhat = fadd_s(mhat, dl); \
      _Pragma("unroll") for (int r = 0; r < 16; ++r) { P0[r] = fsub_s(P0[r], dl); P1[r] = fsub_s(P1[r], dl); } \
      _Pragma("unroll") for (int r = 0; r < 16; ++r) negm[r] = -mhat; asm volatile("" : "+v"(negm)); } } \
    _Pragma("unroll") for (int r = 0; r < 16; ++r) P0[r] = __builtin_amdgcn_exp2f(P0[r]); } while (0)
#define RESC() do { if constexpr (!FAST) { if (resc) { asm volatile("s_waitcnt lgkmcnt(0)" ::: "memory"); \
      _Pragma("unroll") for (int d_ = 0; d_ < 2; ++d_) _Pragma("unroll") for (int r = 0; r < 16; ++r) o[d_][r] *= wsf[crow(r, hi)]; } } } while (0)
    f32x16 pA0, pA1, pB0, pB1;
    int sl_prev = 0, sl_cur = 0, sl_next = SLOTB;
#define ROT() do { sl_prev = sl_cur; sl_cur = sl_next; sl_next = (sl_next == (NSLOT - 1) * SLOTB) ? 0 : sl_next + SLOTB; } while (0)
    DMA_K(2, 2 * SLOTB);
    WAIT_BAR(3);
    qkt(pA0, pA1, Kbase, qr, NEGM, r32, hi); asm volatile("s_nop 15\n\ts_nop 7" : "+v"(pA0), "+v"(pA1));
    START(pA0, pA1);
    _Pragma("unroll") for (int r = 0; r < 16; ++r) pA1[r] = __builtin_amdgcn_exp2f(pA1[r]);
    WAIT_BAR(0);
    DMA_K(3, 0); DMA_V(1, SLOTB);
    ROT();
    kload8(kf, kp0 + sl_cur);
    WAIT_BAR(2);
    s16x4 vlo[8], vhi[8]; u32x4 pw0, pw1, pw2, pw3;
#define PKW(P, B) pk2h(P[B], P[B + 1])
#define PAF(k) __builtin_bit_cast(f16x8, pw##k)
#define VFR(i) mk8(vlo[i], vhi[i])
#define PIN(x) asm volatile("" : "+v"(x))
#define MX3(a, b, c) __builtin_fmaxf(__builtin_fmaxf((a), (b)), (c))
#define GAPA(MF, A0, A1, A2, A3, W0, W1, PW) do { MF; sacc += A0; sacc += A1; sacc += A2; sacc += A3; PIN(sacc); W0; W1; PIN(PW); SBAR(); } while (0)
#define EX(v) __builtin_amdgcn_exp2f(v)
#define GAPB(MF, X, B) do { MF; X[B] = EX(X[B]); X[B + 1] = EX(X[B + 1]); X[B + 2] = EX(X[B + 2]); X[B + 3] = EX(X[B + 3]); PIN(X); SBAR(); } while (0)
#define VRD(i) do { vlo[i] = vtr(vp_ + (((i) >> 2) * 4096 + ((i) & 3) * 1024)); vhi[i] = vtr(vp_ + (((i) >> 2) * 4096 + ((i) & 3) * 1024 + 512)); } while (0)
#define KRD(G, j) do { if (G) { kload2(kf, kp0 + sl_next, j); SBAR(); } } while (0)
#define STEP(C0, C1, P0, P1, t, GK, GV, GL) do { SBAR(); \
    const lds_cptr vp_ = vp0 + sl_prev; \
    if constexpr (FAST) { if (GK) { DMA_K((t) + 3, sl_cur); } } \
    VRD(0); SBAR(); float sacc = (P0[0] + P0[1]); \
    GAPA(C0 = MFMA32(kf[0], qr[0], NEGM), P0[2], P0[3], P0[4], P0[5],     pw0[0] = PKW(P0, 0), pw0[1] = PKW(P0, 2), pw0); \
    if constexpr (FAST) { if (GV) { DMA_V((t) + 1, sl_next); } } \
    VRD(4); SBAR(); GAPA(C1 = MFMA32(kf[1], qr[0], NEGM), P0[6], P0[7], P0[8], P0[9],     pw0[2] = PKW(P0, 4), pw0[3] = PKW(P0, 6), pw0); \
    VRD(1); SBAR(); GAPA(C0 = MFMA32(kf[2], qr[1], C0),   P0[10], P0[11], P0[12], P0[13], pw1[0] = PKW(P0, 8), pw1[1] = PKW(P0, 10), pw1); \
    VRD(5); SBAR(); GAPA(C1 = MFMA32(kf[3], qr[1], C1),   P0[14], P0[15], P1[0], P1[1],   pw1[2] = PKW(P0, 12), pw1[3] = PKW(P0, 14), pw1); \
    VRD(2); SBAR(); GAPA(C0 = MFMA32(kf[4], qr[2], C0),   P1[2], P1[3], P1[4], P1[5],     pw2[0] = PKW(P1, 0), pw2[1] = PKW(P1, 2), pw2); \
    VRD(6); SBAR(); GAPA(C1 = MFMA32(kf[5], qr[2], C1),   P1[6], P1[7], P1[8], P1[9],     pw2[2] = PKW(P1, 4), pw2[3] = PKW(P1, 6), pw2); \
    VRD(3); SBAR(); GAPA(C0 = MFMA32(kf[6], qr[3], C0),   P1[10], P1[11], P1[12], P1[13], pw3[0] = PKW(P1, 8), pw3[1] = PKW(P1, 10), pw3); \
    VRD(7); SBAR(); GAPA(C1 = MFMA32(kf[7], qr[3], C1),   P1[14], P1[15], 0.f, 0.f,       pw3[2] = PKW(P1, 12), pw3[3] = PKW(P1, 14), pw3); \
    l_reg += sacc; \
    if constexpr (!FAST) { \
    if (GK) { DMA_K((t) + 3, sl_cur); } if (GV) { DMA_V((t) + 1, sl_next); } \
    { float a = MX3(C0[0], C0[1], C1[0]), b = MX3(C0[2], C0[3], C1[1]); a = MX3(a, C1[2], C1[3]); \
      _Pragma("unroll") for (int r = 4; r < 16; r += 4) { a = MX3(a, C0[r], C0[r + 1]); b = MX3(b, C0[r + 2], C0[r + 3]); a = MX3(a, C1[r], C1[r + 1]); b = MX3(b, C1[r + 2], C1[r + 3]); } \
      float rm = __builtin_fmaxf(a, b); { auto rr = __builtin_amdgcn_permlane32_swap(__float_as_uint(rm), __float_as_uint(rm), false, false); rm = __builtin_fmaxf(__uint_as_float(rr[0]), __uint_as_float(rr[1])); } \
      resc = false; \
      if (__builtin_expect(__any(rm > (float)THRL), 0)) { const float dl = __builtin_fmaxf(rm, 0.f); mhat += dl; \
        _Pragma("unroll") for (int r = 0; r < 16; ++r) { C0[r] -= dl; C1[r] -= dl; } \
        _Pragma("unroll") for (int r = 0; r < 16; ++r) negm[r] = -mhat; asm volatile("" : "+v"(negm)); \
        const float f = __builtin_amdgcn_exp2f(-dl); l_reg *= f; if (hi == 0) wsf[r32] = f; resc = true; } } } \
    SBAR(); \
    GAPB(o[0] = MFMA32(PAF(0), VFR(0), o[0]), C0, 0); \
    GAPB(o[1] = MFMA32(PAF(0), VFR(4), o[1]), C0, 4); \
    KRD(GL, 0); GAPB(o[0] = MFMA32(PAF(1), VFR(1), o[0]), C0, 8); \
    KRD(GL, 1); GAPB(o[1] = MFMA32(PAF(1), VFR(5), o[1]), C0, 12); \
    KRD(GL, 2); GAPB(o[0] = MFMA32(PAF(2), VFR(2), o[0]), C1, 0); \
    KRD(GL, 3); GAPB(o[1] = MFMA32(PAF(2), VFR(6), o[1]), C1, 4); \
    GAPB(o[0] = MFMA32(PAF(3), VFR(3), o[0]), C1, 8); \
    GAPB(o[1] = MFMA32(PAF(3), VFR(7), o[1]), C1, 12); \
    } while (0)
    int t = 1;
    for (; t + 5 < NT; t += 2) {
        STEP(pB0, pB1, pA0, pA1, t, true, true, true);     WAIT_BAR(2); RESC(); ROT();
        STEP(pA0, pA1, pB0, pB1, t + 1, true, true, true); WAIT_BAR(2); RESC(); ROT();
    }
#define ENDW(tt) do { if ((tt) + 3 < NT) { WAIT_BAR(2); } else if ((tt) + 2 < NT) { WAIT_BAR(1); } else { WAIT_BAR(0); } } while (0)
    for (; t + 1 < NT; t += 2) {
        STEP(pB0, pB1, pA0, pA1, t, (t + 3 < NT), (t + 1 < NT), (t + 1 < NT));         ENDW(t);     RESC(); ROT();
        STEP(pA0, pA1, pB0, pB1, t + 1, (t + 4 < NT), (t + 2 < NT), (t + 2 < NT));     ENDW(t + 1); RESC(); ROT();
    }
    STEP(pB0, pB1, pA0, pA1, NT - 1, false, false, false); RESC();
    { float sacc = pB0[0] + pB0[1]; _Pragma("unroll") for (int r = 2; r < 16; ++r) sacc += pB0[r]; _Pragma("unroll") for (int r = 0; r < 16; ++r) sacc += pB1[r]; l_reg += sacc;
      pw0 = (u32x4){PKW(pB0, 0), PKW(pB0, 2), PKW(pB0, 4), PKW(pB0, 6)}; pw1 = (u32x4){PKW(pB0, 8), PKW(pB0, 10), PKW(pB0, 12), PKW(pB0, 14)}; pw2 = (u32x4){PKW(pB1, 0), PKW(pB1, 2), PKW(pB1, 4), PKW(pB1, 6)}; pw3 = (u32x4){PKW(pB1, 8), PKW(pB1, 10), PKW(pB1, 12), PKW(pB1, 14)};
      SBAR(); pv(o, vb0 + sl_cur, PAF(0), PAF(1), PAF(2), PAF(3)); }
#undef PKW
#undef PAF
#undef VFR
#undef PIN
#undef MX3
#undef GAPA
#undef GAPB
#undef EX
#undef VRD
#undef KRD
#undef STEP
#undef ENDW
    { auto rr = __builtin_amdgcn_permlane32_swap(__float_as_uint(l_reg), __float_as_uint(l_reg), false, false); l_reg = __uint_as_float(rr[0]) + __uint_as_float(rr[1]); }
    l_out = l_reg;
    asm volatile("s_waitcnt lgkmcnt(0)\n\ts_barrier" ::: "memory");
#undef DMA_K
#undef DMA_V
#undef START
#undef NEGM
#undef RESC
#undef ROT
}

__device__ __forceinline__ void pv128(f32x16* o, int vb, f16x8 pa0, f16x8 pa1, f16x8 pa2, f16x8 pa3) {
#pragma unroll
    for (int d0 = 0; d0 < 4; ++d0) { s16x4 lo[4], hi[4];
#pragma unroll
        for (int ks = 0; ks < 4; ++ks) {
            asm volatile("ds_read_b64_tr_b16 %0,%1 offset:%c2" : "=&v"(lo[ks]) : "v"(vb), "i"(d0 * 4096 + ks * 1024) : "memory");
            asm volatile("ds_read_b64_tr_b16 %0,%1 offset:%c2" : "=&v"(hi[ks]) : "v"(vb), "i"(d0 * 4096 + ks * 1024 + 512) : "memory"); }
        asm volatile("s_waitcnt lgkmcnt(0)" ::: "memory"); SBAR();
        o[d0] = MFMA32(pa0, mk8(lo[0], hi[0]), o[d0]);
        o[d0] = MFMA32(pa1, mk8(lo[1], hi[1]), o[d0]);
        o[d0] = MFMA32(pa2, mk8(lo[2], hi[2]), o[d0]);
        o[d0] = MFMA32(pa3, mk8(lo[3], hi[3]), o[d0]);
    }
}
template <int THRL, bool FAST> __device__ __forceinline__ void attn_pass128(const h16_t* Qw, int QP, const h16_t* Kh, int KP, const h16_t* Vh, int VP, char* shm, f32x16 (&o)[4], float& l_out, int wave_in) {
    int tid = wave_in * 64 + lane_id(); asm volatile("" : "+v"(tid));
    const int lane = tid & 63, r32 = lane & 31, hi = lane >> 5; const int wid = wave_in;
    const unsigned lds0 = (unsigned)(uintptr_t)shm;
    float* wsf = (float*)(shm + LDS_WS) + wid * 64;
    const h16_t* ksrc = Kh + (long)lane * KP + wid * 8;
    const h16_t* vsrc = Vh + (long)(16 * (wid & 3) + (lane >> 2)) * VP + (wid >> 2) * 32 + (lane & 3) * 8;
    const unsigned kdst = lds0 + LDS_K + wid * 1024, vdst = lds0 + LDS_V + wid * 1024;
#define DMA_K(t, slot) glds16(ksrc + (long)(t) * KVBLK * KP, (unsigned)__builtin_amdgcn_readfirstlane(kdst + (slot)))
#define DMA_V(t, slot) do { glds16(vsrc + (long)(t) * KVBLK * VP, (unsigned)__builtin_amdgcn_readfirstlane(vdst + (slot))); glds16(vsrc + (long)(t) * KVBLK * VP + 64, (unsigned)__builtin_amdgcn_readfirstlane(vdst + (slot) + 8192)); } while (0)
    const int vb0 = (int)(lds0 + LDS_V) + ((lane >> 4) & 1) * 32 + (lane & 3) * 8 + (4 * hi + ((lane & 15) >> 2)) * 64;
    const char* Kbase = shm + LDS_K; f16x8 kf[8];
    const lds_cptr shm3 = (lds_cptr)shm; const lds_cptr kp0 = shm3 + LDS_K + hi * 1024 + r32 * 16; const lds_cptr vp0 = shm3 + LDS_V + ((lane >> 4) & 1) * 32 + (lane & 3) * 8 + (4 * hi + ((lane & 15) >> 2)) * 64;
    DMA_K(0, 0); DMA_V(0, 0); DMA_K(1, SLOTB);
    f16x8 qr[4];
#pragma unroll
    for (int d0 = 0; d0 < 4; ++d0) qr[d0] = *reinterpret_cast<const f16x8*>(&Qw[(long)r32 * QP + d0 * 16 + hi * 8]);
    float mhat = 0.f, l_reg = 0.f; o[0] = f32x16{}; o[1] = f32x16{}; o[2] = f32x16{}; o[3] = f32x16{}; f32x16 negm = f32x16{}; if constexpr (!FAST) asm volatile("" : "+v"(negm));
    bool resc = false;
#define NEGM (FAST ? f32x16{} : negm)
#define RESC() do { if constexpr (!FAST) if (resc) { asm volatile("s_waitcnt lgkmcnt(0)" ::: "memory"); \
      _Pragma("unroll") for (int d_ = 0; d_ < 4; ++d_) _Pragma("unroll") for (int r = 0; r < 16; ++r) o[d_][r] *= wsf[crow(r, hi)]; } } while (0)
    f32x16 C0, C1; u32x4 pA0, pA1, pA2, pA3, pB0, pB1, pB2, pB3;
    int sl_prev = 0, sl_cur = 0, sl_next = SLOTB;
#define ROT() do { sl_prev = sl_cur; sl_cur = sl_next; sl_next = (sl_next == (NSLOT - 1) * SLOTB) ? 0 : sl_next + SLOTB; } while (0)
    DMA_K(2, 2 * SLOTB);
    WAIT_BAR(3);
    qkt(C0, C1, Kbase, qr, NEGM, r32, hi); asm volatile("s_nop 15\n\ts_nop 7" : "+v"(C0), "+v"(C1));
    { float rm = 0.f; if constexpr (!FAST) { rm = rowmax(C0, C1); mhat = rm; }
      _Pragma("unroll") for (int r = 0; r < 16; ++r) { C0[r] = __builtin_amdgcn_exp2f(C0[r] - rm); C1[r] = __builtin_amdgcn_exp2f(C1[r] - rm); }
      if constexpr (!FAST) { _Pragma("unroll") for (int r = 0; r < 16; ++r) negm[r] = -mhat; asm volatile("" : "+v"(negm)); }
      float sacc = 0.f; _Pragma("unroll") for (int r = 0; r < 16; ++r) sacc += C0[r] + C1[r]; l_reg = sacc;
      pA0 = (u32x4){pk2h(C0[0], C0[1]), pk2h(C0[2], C0[3]), pk2h(C0[4], C0[5]), pk2h(C0[6], C0[7])}; pA1 = (u32x4){pk2h(C0[8], C0[9]), pk2h(C0[10], C0[11]), pk2h(C0[12], C0[13]), pk2h(C0[14], C0[15])};
      pA2 = (u32x4){pk2h(C1[0], C1[1]), pk2h(C1[2], C1[3]), pk2h(C1[4], C1[5]), pk2h(C1[6], C1[7])}; pA3 = (u32x4){pk2h(C1[8], C1[9]), pk2h(C1[10], C1[11]), pk2h(C1[12], C1[13]), pk2h(C1[14], C1[15])}; }
    WAIT_BAR(0);
    DMA_K(3, 0); DMA_V(1, 2 * SLOTB);
    ROT();
    kload8(kf, kp0 + sl_cur);
    WAIT_BAR(3);
    s16x4 vlo[16], vhi[16];
#define PAFW(w) __builtin_bit_cast(f16x8, w)
#define VFR(i) mk8(vlo[i], vhi[i])
#define PIN(x) asm volatile("" : "+v"(x))
#define MX3(a, b, c) __builtin_fmaxf(__builtin_fmaxf((a), (b)), (c))
#define EX(v) __builtin_amdgcn_exp2f(v)
#define VRD(i) do { vlo[i] = vtr(vp_ + (((i) >> 2) * 4096 + ((i) & 3) * 1024)); vhi[i] = vtr(vp_ + (((i) >> 2) * 4096 + ((i) & 3) * 1024 + 512)); } while (0)
#define KRD(G, j) do { if (G) { kload2(kf, kp0 + sl_next, j); } } while (0)
#define QK1(PRE, CC, KF, QR, CI) do { PRE; SBAR(); CC = MFMA32(KF, QR, CI); SBAR(); } while (0)
#define NOP_ do { } while (0)
#define GB0(PRE, OA, PW, FI, X, B) do { PRE; SBAR(); OA = MFMA32(PAFW(PW), VFR(FI), OA); X[B] = EX(X[B]); X[B + 1] = EX(X[B + 1]); PIN(X); SBAR(); } while (0)
#define GB(PRE, OA, PW, FI, X, B, Y, YB, PN, W) do { PRE; SBAR(); OA = MFMA32(PAFW(PW), VFR(FI), OA); X[B] = EX(X[B]); X[B + 1] = EX(X[B + 1]); PIN(X); \
    sacc += Y[YB]; sacc += Y[YB + 1]; PN[W] = pk2h(Y[YB], Y[YB + 1]); PIN(sacc); PIN(PN); SBAR(); } while (0)
#define STEP128(PC0, PC1, PC2, PC3, PN0, PN1, PN2, PN3, t, GK, GV, GL) do { SBAR(); \
    const lds_cptr vp_ = vp0 + 2 * sl_prev; \
    QK1(if constexpr (FAST) { if (GK) { DMA_K((t) + 3, sl_cur); } }, C0, kf[0], qr[0], NEGM); \
    QK1(if constexpr (FAST) { if (GV) { DMA_V((t) + 1, 2 * sl_next); } }, C1, kf[1], qr[0], NEGM); \
    QK1(NOP_,    C0, kf[2], qr[1], C0); \
    QK1(NOP_,    C1, kf[3], qr[1], C1); \
    QK1(VRD(0),  C0, kf[4], qr[2], C0); \
    QK1(VRD(4),  C1, kf[5], qr[2], C1); \
    QK1(VRD(8),  C0, kf[6], qr[3], C0); \
    QK1(VRD(12), C1, kf[7], qr[3], C1); \
    if constexpr (!FAST) { \
    if (GK) { DMA_K((t) + 3, sl_cur); } if (GV) { DMA_V((t) + 1, 2 * sl_next); } \
    { float a = MX3(C0[0], C0[1], C1[0]), b = MX3(C0[2], C0[3], C1[1]); a = MX3(a, C1[2], C1[3]); \
      _Pragma("unroll") for (int r = 4; r < 16; r += 4) { a = MX3(a, C0[r], C0[r + 1]); b = MX3(b, C0[r + 2], C0[r + 3]); a = MX3(a, C1[r], C1[r + 1]); b = MX3(b, C1[r + 2], C1[r + 3]); } \
      float rm = __builtin_fmaxf(a, b); { auto rr = __builtin_amdgcn_permlane32_swap(__float_as_uint(rm), __float_as_uint(rm), false, false); rm = __builtin_fmaxf(__uint_as_float(rr[0]), __uint_as_float(rr[1])); } \
      resc = false; \
      if (__builtin_expect(__any(rm > (float)THRL), 0)) { const float dl = __builtin_fmaxf(rm, 0.f); mhat += dl; \
        _Pragma("unroll") for (int r = 0; r < 16; ++r) { C0[r] -= dl; C1[r] -= dl; } \
        _Pragma("unroll") for (int r = 0; r < 16; ++r) negm[r] = -mhat; asm volatile("" : "+v"(negm)); \
        const float f = __builtin_amdgcn_exp2f(-dl); l_reg *= f; if (hi == 0) wsf[r32] = f; resc = true; } } } \
    SBAR(); float sacc = 0.f; \
    GB0(VRD(1),  o[0], PC0, 0,  C0, 0); \
    GB(VRD(5),   o[1], PC0, 4,  C0, 2,  C0, 0,  PN0, 0); \
    GB(VRD(9),   o[2], PC0, 8,  C0, 4,  C0, 2,  PN0, 1); \
    GB(VRD(13),  o[3], PC0, 12, C0, 6,  C0, 4,  PN0, 2); \
    GB(VRD(2),   o[0], PC1, 1,  C0, 8,  C0, 6,  PN0, 3); \
    GB(VRD(6),   o[1], PC1, 5,  C0, 10, C0, 8,  PN1, 0); \
    GB(VRD(10),  o[2], PC1, 9,  C0, 12, C0, 10, PN1, 1); \
    GB(VRD(14),  o[3], PC1, 13, C0, 14, C0, 12, PN1, 2); \
    GB(VRD(3),   o[0], PC2, 2,  C1, 0,  C0, 14, PN1, 3); \
    GB(VRD(7),   o[1], PC2, 6,  C1, 2,  C1, 0,  PN2, 0); \
    GB(VRD(11),  o[2], PC2, 10, C1, 4,  C1, 2,  PN2, 1); \
    GB(VRD(15),  o[3], PC2, 14, C1, 6,  C1, 4,  PN2, 2); \
    GB(KRD(GL, 0), o[0], PC3, 3,  C1, 8,  C1, 6,  PN2, 3); \
    GB(KRD(GL, 1), o[1], PC3, 7,  C1, 10, C1, 8,  PN3, 0); \
    GB(KRD(GL, 2), o[2], PC3, 11, C1, 12, C1, 10, PN3, 1); \
    GB(KRD(GL, 3), o[3], PC3, 15, C1, 14, C1, 12, PN3, 2); \
    sacc += C1[14]; sacc += C1[15]; PN3[3] = pk2h(C1[14], C1[15]); l_reg += sacc; \
    } while (0)
    int t = 1;
    for (; t + 5 < NT; t += 2) {
        STEP128(pA0, pA1, pA2, pA3, pB0, pB1, pB2, pB3, t, true, true, true);     WAIT_BAR(3); RESC(); ROT();
        STEP128(pB0, pB1, pB2, pB3, pA0, pA1, pA2, pA3, t + 1, true, true, true); WAIT_BAR(3); RESC(); ROT();
    }
#define ENDW(tt) do { if ((tt) + 3 < NT) { WAIT_BAR(3); } else if ((tt) + 2 < NT) { WAIT_BAR(2); } else { WAIT_BAR(0); } } while (0)
    for (; t + 1 < NT; t += 2) {
        STEP128(pA0, pA1, pA2, pA3, pB0, pB1, pB2, pB3, t, (t + 3 < NT), (t + 1 < NT), (t + 1 < NT));         ENDW(t);     RESC(); ROT();
        STEP128(pB0, pB1, pB2, pB3, pA0, pA1, pA2, pA3, t + 1, (t + 4 < NT), (t + 2 < NT), (t + 2 < NT));     ENDW(t + 1); RESC(); ROT();
    }
    STEP128(pA0, pA1, pA2, pA3, pB0, pB1, pB2, pB3, NT - 1, false, false, false); RESC();
    SBAR(); pv128(o, vb0 + 2 * sl_cur, PAFW(pB0), PAFW(pB1), PAFW(pB2), PAFW(pB3));
#undef PAFW
#undef VFR
#undef PIN
#undef MX3
#undef EX
#undef VRD
#undef KRD
#undef QK1
#undef NOP_
#undef GB0
#undef GB
#undef STEP128
#undef ENDW
    { auto rr = __builtin_amdgcn_permlane32_swap(__float_as_uint(l_reg), __float_as_uint(l_reg), false, false); l_reg = __uint_as_float(rr[0]) + __uint_as_float(rr[1]); }
    l_out = l_reg;
    asm volatile("s_waitcnt lgkmcnt(0)\n\ts_barrier" ::: "memory");
#undef DMA_K
#undef DMA_V
#undef NEGM
#undef RESC
#undef ROT
}

typedef int v8i __attribute__((ext_vector_type(8)));
#define MFMA8(a, b, c) __builtin_amdgcn_mfma_scale_f32_32x32x64_f8f6f4(a, b, c, 0, 0, 0, 0, 0, 0)
#define MFMA8S(a, b, c) __builtin_amdgcn_mfma_scale_f32_16x16x128_f8f6f4(a, b, c, 0, 0, 0, 0, 0, 0)
#define MFMA6(a, b, c) __builtin_amdgcn_mfma_scale_f32_32x32x64_f8f6f4(a, b, c, 2, 2, 0, sc6, 0, sc6)
__device__ __forceinline__ v8i ld24(lds_cptr p16, lds_cptr p8) { const u32x4 a = *(const LAS u32x4*)p16; const u32x2 b = *(const volatile LAS u32x2*)p8;     return (v8i){(int)a.x, (int)a.y, (int)a.z, (int)a.w, (int)b.x, (int)b.y, 0, 0}; }
__device__ __forceinline__ v8i ld32(lds_cptr p0, lds_cptr p1) { const u32x4 a = *(const LAS u32x4*)p0, b = *(const LAS u32x4*)p1; return (v8i){(int)a.x, (int)a.y, (int)a.z, (int)a.w, (int)b.x, (int)b.y, (int)b.z, (int)b.w}; }
template <int NV> __device__ __forceinline__ void attn_first_dma(const unsigned char* Kh8, int KP, const unsigned char* VT, char* shm, int wave_in) {
    int tid = wave_in * 64 + lane_id(); asm volatile("" : "+v"(tid));
    const int lane = tid & 63, wid = wave_in; const bool kw = wid < 4, kwk = wid < 3;
    const unsigned lds0 = (unsigned)(uintptr_t)shm; constexpr int VCH = NV * 512;
    const unsigned char* ksrc = Kh8 + (long)lane * KP + (wid & 3) * 16;
    const unsigned char* vsrc = VT + (long)(lane + ((kw && NV == 4) ? 64 : 0)) * SEQ + (wid & 3) * 16;
    const unsigned kdst = lds0 + LDS_K + (wid & 3) * 1024, vdst = lds0 + LDS_V + (wid & 3) * VCH + ((kw && NV == 4) ? 1024 : 0);
    if (kwk) glds16(ksrc, (unsigned)__builtin_amdgcn_readfirstlane(kdst));
    if (!kw || NV == 4) glds16(vsrc, (unsigned)__builtin_amdgcn_readfirstlane(vdst));
    if (kwk) { glds16(ksrc + (long)KVBLK * KP, (unsigned)__builtin_amdgcn_readfirstlane(kdst + SLOTB)); glds16(ksrc + (long)2 * KVBLK * KP, (unsigned)__builtin_amdgcn_readfirstlane(kdst + 2 * SLOTB)); }
}
template <int NV> __device__ __forceinline__ void attn_pass8(const unsigned char* Qw8, int QP, const unsigned char* Kh8, int KP, const unsigned char* VT, int mI, char* shm, f32x16 (&o)[NV], float& l_out, int wave_in, bool pre = false) {
    int tid = wave_in * 64 + lane_id(); asm volatile("" : "+v"(tid));
    const int lane = tid & 63, r32 = lane & 31, hi = lane >> 5; const int wid = wave_in;
    const unsigned lds0 = (unsigned)(uintptr_t)shm;
    constexpr int VCH = NV * 512;
    const bool kw = wid < 4, kwk = wid < 3;
    const unsigned char* ksrc = Kh8 + (long)lane * KP + (wid & 3) * 16;
    const unsigned char* vsrc = VT + (long)(lane + ((kw && NV == 4) ? 64 : 0)) * SEQ + (wid & 3) * 16;
    const unsigned kdst = lds0 + LDS_K + (wid & 3) * 1024, vdst = lds0 + LDS_V + (wid & 3) * VCH + ((kw && NV == 4) ? 1024 : 0);
#define DMA_K8(t, slot) do { if (kwk) glds16(ksrc + (long)(t) * KVBLK * KP, (unsigned)__builtin_amdgcn_readfirstlane(kdst + (slot))); } while (0)
#define DMA_V8(t, slot) do { if (!kw || NV == 4) glds16(vsrc + (t) * KVBLK, (unsigned)__builtin_amdgcn_readfirstlane(vdst + (slot))); } while (0)
#define OWN_BAR() do { if (kwk && NV == 4) { WAIT_BAR(2); } else { WAIT_BAR(1); } } while (0)
    const lds_cptr shm3 = (lds_cptr)shm;
    const lds_cptr kp0 = shm3 + LDS_K + hi * 1024 + r32 * 16, kq0 = shm3 + LDS_K + 2048 + r32 * 16 + 8 * hi;
    const lds_cptr vp0 = shm3 + LDS_V + (2 * hi) * VCH + r32 * 16;
    if (!pre) { DMA_K8(0, 0); DMA_V8(0, 0); DMA_K8(1, SLOTB); DMA_K8(2, 2 * SLOTB); }
    v8i q8; { const u32x4 a = *(const u32x4*)(Qw8 + (long)r32 * QP + 16 * hi); const u32x2 b = *(const u32x2*)(Qw8 + (long)r32 * QP + 32 + 8 * hi); q8 = (v8i){(int)a.x, (int)a.y, (int)a.z, (int)a.w, (int)b.x, (int)b.y, 0, 0}; }
    float l_reg = 0.f;
#pragma unroll
    for (int d = 0; d < NV; ++d) o[d] = f32x16{};
    f32x16 cinit; { int mI_ = mI; asm volatile("" : "+s"(mI_)); float cv = 8.0f * (float)(7 - mI_) * (1.0f / 65536.0f); asm volatile("" : "+v"(cv));
#pragma unroll
        for (int r = 0; r < 16; ++r) cinit[r] = cv; }
    asm volatile("" : "+v"(cinit));
    int sc6 = 0x77; asm volatile("" : "+v"(sc6));
    f32x16 C0, C1; v8i pA, pB, kf0, kf1;
    v8i ones8; { int one4 = ((lane & 15) == ((lane >> 4) & 1)) ? 0x38383838 : 0; asm volatile("" : "+v"(one4));
#pragma unroll
        for (int w = 0; w < 8; ++w) ones8[w] = one4; }
    f32x4 lsum = f32x4{};
    int sl_prev = 0, sl_cur = 0, sl_next = SLOTB;
#define ROT() do { sl_prev = sl_cur; sl_cur = sl_next; sl_next = (sl_next == (NSLOT - 1) * SLOTB) ? 0 : sl_next + SLOTB; } while (0)
#define KLD(sl) do { kf0 = ld24(kp0 + (sl), kq0 + (sl)); kf1 = ld24(kp0 + (sl) + 512, kq0 + (sl) + 512); } while (0)
#define CODES(PW, w0, w1) do { _Pragma("unroll") for (int w_ = (w0); w_ < (w1); ++w_) { \
      const float c0_ = w_ < 4 ? C0[4 * w_] : C1[4 * (w_ - 4)], c1_ = w_ < 4 ? C0[4 * w_ + 1] : C1[4 * (w_ - 4) + 1], c2_ = w_ < 4 ? C0[4 * w_ + 2] : C1[4 * (w_ - 4) + 2], c3_ = w_ < 4 ? C0[4 * w_ + 3] : C1[4 * (w_ - 4) + 3]; \
      const unsigned x_ = __builtin_bit_cast(unsigned, __builtin_amdgcn_cvt_pknorm_u16(c0_, c1_)), y_ = __builtin_bit_cast(unsigned, __builtin_amdgcn_cvt_pknorm_u16(c2_, c3_));     \
      PW[w_] = (int)__builtin_amdgcn_perm(y_, x_, 0x06040200u); } } while (0)
    asm volatile("s_waitcnt vmcnt(0) lgkmcnt(0)\n\ts_barrier" ::: "memory");
    KLD(0);
    C0 = MFMA6(kf0, q8, cinit); C1 = MFMA6(kf1, q8, cinit);
    CODES(pA, 0, 8);
    asm volatile("s_waitcnt lgkmcnt(0)\n\ts_barrier" ::: "memory");
    DMA_K8(3, 0); DMA_V8(1, 2 * SLOTB);
    ROT();
    KLD(sl_cur);
    OWN_BAR();
#define VLD(db) ld32(vp_ + (db) * 512, vp_ + (db) * 512 + VCH)
#define PINV(x) asm volatile("" : "+v"(x))
#define STEP8(PC, PN, t, GK, GV, GL) do { SBAR(); \
    const lds_cptr vp_ = vp0 + 2 * sl_prev; \
    v8i vfa = VLD(0), vfb = VLD(1); SBAR(); \
    C0 = MFMA6(kf0, q8, cinit); C1 = MFMA6(kf1, q8, cinit); PINV(C0); PINV(C1); SBAR(); \
    if (GK) { DMA_K8((t) + 3, sl_cur); } if (GV) { DMA_V8((t) + 1, 2 * sl_next); } \
    if (GL) { KLD(sl_next); } SBAR(); \
    o[0] = MFMA8(PC, vfa, o[0]); PINV(o[0]); SBAR(); if constexpr (NV == 4) { vfa = VLD(2); } CODES(PN, 0, 8 / NV); PINV(PN); SBAR(); \
    o[1] = MFMA8(PC, vfb, o[1]); PINV(o[1]); SBAR(); if constexpr (NV == 4) { vfb = VLD(3); } CODES(PN, 8 / NV, 16 / NV); PINV(PN); SBAR(); \
    if constexpr (NV == 4) { \
    o[2] = MFMA8(PC, vfa, o[2]); PINV(o[2]); SBAR(); CODES(PN, 4, 6); PINV(PN); SBAR(); \
    o[3] = MFMA8(PC, vfb, o[3]); PINV(o[3]); SBAR(); CODES(PN, 6, 8); PINV(PN); SBAR(); } \
    lsum = MFMA8S(PC, ones8, lsum); PINV(lsum); SBAR(); \
    } while (0)
#define ENDW8(tt) do { if ((tt) + 3 < NT) { OWN_BAR(); } else if ((tt) + 2 < NT) { if (kw && NV != 4) { WAIT_BAR(0); } else { WAIT_BAR(1); } } else { WAIT_BAR(0); } } while (0)
    int t = 1;
    if (wid >= 4) __builtin_amdgcn_s_setprio(1);
#pragma unroll 1
    for (; t + 1 < NT; t += 2) {
        STEP8(pA, pB, t, (t + 3 < NT), (t + 1 < NT), (t + 1 < NT));         ENDW8(t);     ROT();
        STEP8(pB, pA, t + 1, (t + 4 < NT), (t + 2 < NT), (t + 2 < NT));     ENDW8(t + 1); ROT();
    }
    STEP8(pA, pB, NT - 1, false, false, false);
    { const lds_cptr vp_ = vp0 + 2 * sl_cur;
#pragma unroll
      for (int db = 0; db < NV; ++db) { const v8i vf = ld32(vp_ + db * 512, vp_ + db * 512 + VCH); o[db] = MFMA8(pB, vf, o[db]); } }
    lsum = MFMA8S(pB, ones8, lsum);
    __builtin_amdgcn_s_setprio(0);
    { float* wsf = (float*)(shm + LDS_WS) + wid * 64;
#pragma unroll
      for (int r = 0; r < 4; ++r) if ((lane & 15) < 2) wsf[16 * (lane & 15) + 4 * (lane >> 4) + r] = lsum[r];
      asm volatile("s_waitcnt lgkmcnt(0)" ::: "memory");
      l_reg = wsf[r32]; asm volatile("s_waitcnt lgkmcnt(0)" ::: "memory"); }
    l_out = l_reg;
    asm volatile("s_waitcnt lgkmcnt(0)\n\ts_barrier" ::: "memory");
#undef DMA_K8
#undef DMA_V8
#undef OWN_BAR
#undef ROT
#undef KLD
#undef CODES
#undef STEP8
#undef PINV
#undef VLD
#undef ENDW8
}
__device__ __forceinline__ void attn_pass8_2x(const unsigned char* Qw8, int QP, const unsigned char* Kh8, int KP, const unsigned char* VT, int mI, char* shm, f32x16 (&oa)[2], f32x16 (&ob)[2], float& la_out, float& lb_out, int wave_in, bool pre = false) {
    constexpr int NV = 2;
    int tid = wave_in * 64 + lane_id(); asm volatile("" : "+v"(tid));
    const int lane = tid & 63, r32 = lane & 31, hi = lane >> 5; const int wid = wave_in;
    const unsigned lds0 = (unsigned)(uintptr_t)shm;
    constexpr int VCH = NV * 512;
    const bool kw = wid < 4, kwk = wid < 3;
    const unsigned char* ksrc = Kh8 + (long)lane * KP + (wid & 3) * 16;
    const unsigned char* vsrc = VT + (long)lane * SEQ + (wid & 3) * 16;
    const unsigned kdst = lds0 + LDS_K + (wid & 3) * 1024, vdst = lds0 + LDS_V + (wid & 3) * VCH;
#define DMA_K8(t, slot) do { if (kwk) glds16(ksrc + (long)(t) * KVBLK * KP, (unsigned)__builtin_amdgcn_readfirstlane(kdst + (slot))); } while (0)
#define DMA_V8(t, slot) do { if (!kw) glds16(vsrc + (t) * KVBLK, (unsigned)__builtin_amdgcn_readfirstlane(vdst + (slot))); } while (0)
#define OWN_BAR() WAIT_BAR(1)
    const lds_cptr shm3 = (lds_cptr)shm;
    const lds_cptr kp0 = shm3 + LDS_K + hi * 1024 + r32 * 16, kq0 = shm3 + LDS_K + 2048 + r32 * 16 + 8 * hi;
    const lds_cptr vp0 = shm3 + LDS_V + (2 * hi) * VCH + r32 * 16;
    if (!pre) { DMA_K8(0, 0); DMA_V8(0, 0); DMA_K8(1, SLOTB); DMA_K8(2, 2 * SLOTB); }
    v8i q8a, q8b;
    { const u32x4 a = *(const u32x4*)(Qw8 + (long)r32 * QP + 16 * hi); const u32x2 b = *(const u32x2*)(Qw8 + (long)r32 * QP + 32 + 8 * hi); q8a = (v8i){(int)a.x, (int)a.y, (int)a.z, (int)a.w, (int)b.x, (int)b.y, 0, 0}; }
    { const u32x4 a = *(const u32x4*)(Qw8 + (long)(32 + r32) * QP + 16 * hi); const u32x2 b = *(const u32x2*)(Qw8 + (long)(32 + r32) * QP + 32 + 8 * hi); q8b = (v8i){(int)a.x, (int)a.y, (int)a.z, (int)a.w, (int)b.x, (int)b.y, 0, 0}; }
#pragma unroll
    for (int d = 0; d < NV; ++d) { oa[d] = f32x16{}; ob[d] = f32x16{}; }
    f32x16 cinit; { int mI_ = mI; asm volatile("" : "+s"(mI_)); float cv = 8.0f * (float)(7 - mI_) * (1.0f / 65536.0f); asm volatile("" : "+v"(cv));
#pragma unroll
        for (int r = 0; r < 16; ++r) cinit[r] = cv; }
    asm volatile("" : "+v"(cinit));
    int sc6 = 0x77; asm volatile("" : "+v"(sc6));
    f32x16 C0, C1; v8i pAa, pBa, pAb, pBb, kf0, kf1;
    v8i ones8; { int one4 = ((lane & 15) == ((lane >> 4) & 1)) ? 0x38383838 : 0; asm volatile("" : "+v"(one4));
#pragma unroll
        for (int w = 0; w < 8; ++w) ones8[w] = one4; }
    f32x4 lsa = f32x4{}, lsb = f32x4{};
    int sl_prev = 0, sl_cur = 0, sl_next = SLOTB;
#define ROT() do { sl_prev = sl_cur; sl_cur = sl_next; sl_next = (sl_next == (NSLOT - 1) * SLOTB) ? 0 : sl_next + SLOTB; } while (0)
#define KLD(sl) do { kf0 = ld24(kp0 + (sl), kq0 + (sl)); kf1 = ld24(kp0 + (sl) + 512, kq0 + (sl) + 512); } while (0)
#define CODES(PW, w0, w1) do { _Pragma("unroll") for (int w_ = (w0); w_ < (w1); ++w_) { \
      const float c0_ = w_ < 4 ? C0[4 * w_] : C1[4 * (w_ - 4)], c1_ = w_ < 4 ? C0[4 * w_ + 1] : C1[4 * (w_ - 4) + 1], c2_ = w_ < 4 ? C0[4 * w_ + 2] : C1[4 * (w_ - 4) + 2], c3_ = w_ < 4 ? C0[4 * w_ + 3] : C1[4 * (w_ - 4) + 3]; \
      const unsigned x_ = __builtin_bit_cast(unsigned, __builtin_amdgcn_cvt_pknorm_u16(c0_, c1_)), y_ = __builtin_bit_cast(unsigned, __builtin_amdgcn_cvt_pknorm_u16(c2_, c3_));     \
      PW[w_] = (int)__builtin_amdgcn_perm(y_, x_, 0x06040200u); } } while (0)
    asm volatile("s_waitcnt vmcnt(0) lgkmcnt(0)\n\ts_barrier" ::: "memory");
    KLD(0);
    C0 = MFMA6(kf0, q8a, cinit); C1 = MFMA6(kf1, q8a, cinit);
    CODES(pAa, 0, 8);
    C0 = MFMA6(kf0, q8b, cinit); C1 = MFMA6(kf1, q8b, cinit);
    CODES(pAb, 0, 8);
    asm volatile("s_waitcnt lgkmcnt(0)\n\ts_barrier" ::: "memory");
    DMA_K8(3, 0); DMA_V8(1, 2 * SLOTB);
    ROT();
    KLD(sl_cur);
    OWN_BAR();
#define VLD(db) ld32(vp_ + (db) * 512, vp_ + (db) * 512 + VCH)
#define PINV(x) asm volatile("" : "+v"(x))
#define STEP2(PCa, PNa, PCb, PNb, t, GK, GV, GL) do { SBAR(); \
    const lds_cptr vp_ = vp0 + 2 * sl_prev; \
    v8i vfa = VLD(0), vfb = VLD(1); SBAR(); \
    C0 = MFMA6(kf0, q8a, cinit); C1 = MFMA6(kf1, q8a, cinit); PINV(C0); PINV(C1); SBAR(); \
    if (GK) { DMA_K8((t) + 3, sl_cur); } if (GV) { DMA_V8((t) + 1, 2 * sl_next); } SBAR(); \
    oa[0] = MFMA8(PCa, vfa, oa[0]); PINV(oa[0]); SBAR(); CODES(PNa, 0, 4); PINV(PNa); SBAR(); \
    oa[1] = MFMA8(PCa, vfb, oa[1]); PINV(oa[1]); SBAR(); CODES(PNa, 4, 8); PINV(PNa); SBAR(); \
    C0 = MFMA6(kf0, q8b, cinit); C1 = MFMA6(kf1, q8b, cinit); PINV(C0); PINV(C1); SBAR(); \
    if (GL) { KLD(sl_next); } SBAR(); \
    ob[0] = MFMA8(PCb, vfa, ob[0]); PINV(ob[0]); SBAR(); CODES(PNb, 0, 4); PINV(PNb); SBAR(); \
    ob[1] = MFMA8(PCb, vfb, ob[1]); PINV(ob[1]); SBAR(); CODES(PNb, 4, 8); PINV(PNb); SBAR(); \
    lsa = MFMA8S(PCa, ones8, lsa); PINV(lsa); lsb = MFMA8S(PCb, ones8, lsb); PINV(lsb); SBAR(); \
    } while (0)
#define ENDW8(tt) do { if ((tt) + 3 < NT) { OWN_BAR(); } else if ((tt) + 2 < NT) { if (kw) { WAIT_BAR(0); } else { WAIT_BAR(1); } } else { WAIT_BAR(0); } } while (0)
    int t = 1;
    if (wid >= 4) __builtin_amdgcn_s_setprio(1);
#pragma unroll 1
    for (; t + 1 < NT; t += 2) {
        STEP2(pAa, pBa, pAb, pBb, t, (t + 3 < NT), (t + 1 < NT), (t + 1 < NT));         ENDW8(t);     ROT();
        STEP2(pBa, pAa, pBb, pAb, t + 1, (t + 4 < NT), (t + 2 < NT), (t + 2 < NT));     ENDW8(t + 1); ROT();
    }
    STEP2(pAa, pBa, pAb, pBb, NT - 1, false, false, false);
    { const lds_cptr vp_ = vp0 + 2 * sl_cur;
#pragma unroll
      for (int db = 0; db < NV; ++db) { const v8i vf = ld32(vp_ + db * 512, vp_ + db * 512 + VCH); oa[db] = MFMA8(pBa, vf, oa[db]); ob[db] = MFMA8(pBb, vf, ob[db]); } }
    lsa = MFMA8S(pBa, ones8, lsa); lsb = MFMA8S(pBb, ones8, lsb);
    __builtin_amdgcn_s_setprio(0);
    { float* wsf = (float*)(shm + LDS_WS) + wid * 64;
#pragma unroll
      for (int r = 0; r < 4; ++r) if ((lane & 15) < 2) { wsf[16 * (lane & 15) + 4 * (lane >> 4) + r] = lsa[r]; wsf[32 + 16 * (lane & 15) + 4 * (lane >> 4) + r] = lsb[r]; }
      asm volatile("s_waitcnt lgkmcnt(0)" ::: "memory");
      la_out = wsf[r32]; lb_out = wsf[32 + r32]; asm volatile("s_waitcnt lgkmcnt(0)" ::: "memory"); }
    asm volatile("s_waitcnt lgkmcnt(0)\n\ts_barrier" ::: "memory");
#undef DMA_K8
#undef DMA_V8
#undef OWN_BAR
#undef ROT
#undef KLD
#undef CODES
#undef STEP2
#undef PINV
#undef VLD
#undef ENDW8
}
#undef SBAR
#undef WAIT_BAR
}

constexpr int LDS_BYTES = 156 * 1024;
static_assert(att::LDS_BYTES <= LDS_BYTES && pg8::STAGE_BYTES <= LDS_BYTES, "LDS map");
constexpr int NWAVES = 8;

struct Args {
    const float* x_prompt; const float* x_sample; const float* c_prompt; const float* c_sample;
    const float* w_ada; const float* b_ada; const float* norm_g; const float* w_in;
    const float* qn_a; const float* kn_a; const float* qn_b; const float* kn_b;
    const float* lq1; const float* lk1; const float* lq2; const float* lk2; const float* subln_g;
    const float* w_proj_a; const float* w_proj_b; const float* w_out;
    float* out; unsigned char* ws;
};
__constant__ double INV_A[16] = {1.0, 0.5623413251903491, 0.31622776601683794, 0.1778279410038923, 0.1, 0.05623413251903491, 0.03162277660168379, 0.01778279410038923, 0.01, 0.005623413251903491, 0.0031622776601683794, 0.0017782794100389228, 0.001, 0.0005623413251903491, 0.00031622776601683794, 0.00017782794100389227};
__constant__ double INV_B[8] = {1.0, 0.19392274474868576, 0.03760603093086393, 0.007292664737217109, 0.001414213562373095, 0.0002742481756762073, 5.318295896944988e-05, 1.031338537721246e-05};

__device__ __forceinline__ int win_row(int n) {
    const int T = n >> 8, o = n & 255;
    int base;
    if (T < 2) base = T * 256; else if (T == 2) base = 6 * 256; else if (T < 5) base = (9 + (T - 3)) * 256; else if (T < 9) base = (T - 3) * 256; else if (T < 11) base = (T - 2) * 256; else base = T * 256;
    if (T == 3 || T == 4 || T >= 11) return base + 128 * ((o >> 3) & 1) + 32 * (o >> 6) + 8 * ((o >> 4) & 3) + (o & 7);
    return base + 128 * ((o >> 5) & 1) + 32 * (o >> 6) + (o & 31);
}
__device__ __forceinline__ void transpose_item(const float* W, int N, h16_t* WT, int KD, int kofs, int k0, int n0, int drow0, LAS float* scr, int lane, unsigned char* WT8 = nullptr, int drow8 = 0, float sc8 = 1.0f, float wmul = 1.0f) {
#pragma unroll 8
    for (int i = 0; i < 32; ++i) { const int kk = 2 * i + (lane >> 5); scr[kk * 33 + (lane & 31)] = W[(size_t)(k0 + kk) * N + n0 + (lane & 31)]; }
    asm volatile("s_waitcnt lgkmcnt(0)" ::: "memory");
    const int c = lane & 7;
#pragma unroll
    for (int j = 0; j < 4; ++j) { const int n = (lane >> 3) + 8 * j; const LAS float* s = scr + (8 * c) * 33 + n;
        u32x4 o; o.x = pk2h(s[0 * 33] * wmul, s[1 * 33] * wmul); o.y = pk2h(s[2 * 33] * wmul, s[3 * 33] * wmul); o.z = pk2h(s[4 * 33] * wmul, s[5 * 33] * wmul); o.w = pk2h(s[6 * 33] * wmul, s[7 * 33] * wmul);
        *(u32x4*)(WT + (size_t)(drow0 >= 0 ? drow0 + n : win_row(n0 + n)) * KD + kofs + k0 + 8 * c) = o;
        if (WT8) { int w0 = 0, w1 = 0;
            w0 = __builtin_amdgcn_cvt_pk_fp8_f32(s[0 * 33] * sc8, s[1 * 33] * sc8, w0, false); w0 = __builtin_amdgcn_cvt_pk_fp8_f32(s[2 * 33] * sc8, s[3 * 33] * sc8, w0, true);
            w1 = __builtin_amdgcn_cvt_pk_fp8_f32(s[4 * 33] * sc8, s[5 * 33] * sc8, w1, false); w1 = __builtin_amdgcn_cvt_pk_fp8_f32(s[6 * 33] * sc8, s[7 * 33] * sc8, w1, true);
            *(u32x2*)(WT8 + (size_t)(drow8 >= 0 ? drow8 + n : win_row(n0 + n) + drow8) * 1024 + k0 + 8 * c) = (u32x2){(unsigned)w0, (unsigned)w1}; } }
    asm volatile("s_waitcnt lgkmcnt(0)" ::: "memory");
}
__device__ __forceinline__ unsigned amax_bits(const unsigned char* ws, int G, size_t off = WS_AMAX) {
    int ln = lane_id(); asm volatile("" : "+v"(ln));
    float m = 0.f; for (int i = ln; i < G; i += 64) m = fmaxf(m, ((const float*)(ws + off))[i]);
#pragma unroll
    for (int o_ = 1; o_ < 64; o_ <<= 1) m = fmaxf(m, __shfl_xor(m, o_));
    return (unsigned)__builtin_amdgcn_readfirstlane((int)__float_as_uint(m));
}
__device__ __forceinline__ int w8_exp(unsigned amax_bits) {
    const float am = __uint_as_float(amax_bits);
    if (!(am > 1e-30f) || !(am < 1e30f)) return 0;
    const float r = 224.0f / am; return (int)((__float_as_uint(r) >> 23) & 255u) - 127;
}


__device__ __forceinline__ void score_bounds(const Args& A, float& boundA, float& boundB) {
    int ln = lane_id(); asm volatile("" : "+v"(ln));
    float qa = fabsf(A.qn_a[ln]), ka = fabsf(A.kn_a[ln]), qb_ = fabsf(A.qn_b[ln]), kb_ = fabsf(A.kn_b[ln]);
#pragma unroll
    for (int o_ = 1; o_ < 64; o_ <<= 1) { qa = fmaxf(qa, __shfl_xor(qa, o_)); ka = fmaxf(ka, __shfl_xor(ka, o_)); qb_ = fmaxf(qb_, __shfl_xor(qb_, o_)); kb_ = fmaxf(kb_, __shfl_xor(kb_, o_)); }
    boundA = __uint_as_float(__builtin_amdgcn_readfirstlane(__float_as_uint(C2 * 64.0f * 1.01f * qa * ka))); boundB = __uint_as_float(__builtin_amdgcn_readfirstlane(__float_as_uint(C2 * 64.0f * 1.01f * qb_ * kb_)));
}
__device__ __forceinline__ bool use_fp8(float boundA, float boundB) { return (boundA <= 13.7f) && (boundB <= 13.7f); }

#define XB_TMO      128
#define XB_XCNT(j)  (256  + 64 * (j))
#define XB_XSUB(j)  (1280 + 64 * (j))
#define XB_XGEN(j)  (2304 + 64 * (j))
#define XB_TOP      3328
#define XB_TOPGEN   3392
#define XB_AMAX      3456
#define XCD_BAR_WORDS 3472
#define XB_SPIN_CAP (1u << 18)
__device__ __forceinline__ unsigned xb_ld(unsigned* p)              { return __hip_atomic_load(p, __ATOMIC_RELAXED, __HIP_MEMORY_SCOPE_AGENT); }
__device__ __forceinline__ unsigned xb_add(unsigned* p, unsigned v) { return __hip_atomic_fetch_add(p, v, __ATOMIC_RELAXED, __HIP_MEMORY_SCOPE_AGENT); }
__device__ __forceinline__ unsigned xb_xcc_id() { return (unsigned)__builtin_amdgcn_s_getreg((3 << 11) | 20) & 0xFu; }
#define XB_SPIN(cond, bar) do { unsigned _sp = 0; while (cond) { __builtin_amdgcn_s_sleep(1); \
    if ((++_sp & 255u) == 0u) { if (xb_ld(&(bar)[XB_TMO])) break; if (_sp > XB_SPIN_CAP) { atomicAdd(&(bar)[XB_TMO], 1u); break; } } } } while (0)
struct XcdBarrier { unsigned* bar; unsigned x; volatile LAS unsigned* st; int wave; };
__device__ __forceinline__ XcdBarrier xcd_barrier_post(unsigned* bar, volatile LAS unsigned* st, int wave) {
    XcdBarrier b; b.bar = bar; b.x = xb_xcc_id(); b.st = st; b.wave = wave;
    if (wave == 0 && lane_id() == 0) (void)xb_add(&bar[XB_XCNT(b.x)], 1u);
    return b;
}
__device__ __forceinline__ void xcd_barrier_complete(unsigned* bar, unsigned x, unsigned& nloc, unsigned& nx) {
    const unsigned G = gridDim.x * gridDim.y * gridDim.z;
    unsigned sum, cnt, mine, sp = 0u;
    for (;;) {
        sum = 0u; cnt = 0u; mine = 0u;
#pragma unroll
        for (unsigned j = 0; j < 16; ++j) { const unsigned c = xb_ld(&bar[XB_XCNT(j)]); sum += c; cnt += (c > 0u) ? 1u : 0u; mine = (j == x) ? c : mine; }
        if (sum == G) break;
        __builtin_amdgcn_s_sleep(1);
        if ((++sp & 255u) == 0u) { if (xb_ld(&bar[XB_TMO])) break; if (sp > XB_SPIN_CAP) { atomicAdd(&bar[XB_TMO], 1u); break; } }
    }
    nloc = mine > 0u ? mine : 1u; nx = cnt > 0u ? cnt : 1u;
}
__device__ __forceinline__ void xcd_barrier(const XcdBarrier& b) {
    asm volatile("s_waitcnt vmcnt(0)" ::: "memory");
    __syncthreads();
    if (b.wave == 0 && lane_id() == 0) {
        unsigned* bar = b.bar;
        __builtin_amdgcn_s_waitcnt(0);
        unsigned nloc = b.st[0], nx = b.st[1];
        if (nloc == 0u) { xcd_barrier_complete(bar, b.x, nloc, nx); b.st[0] = nloc; b.st[1] = nx; }
        const unsigned old = xb_add(&bar[XB_XSUB(b.x)], 1u);
        const unsigned gen = old / nloc;
        if (old + 1u == (gen + 1u) * nloc) {
            __builtin_amdgcn_fence(__ATOMIC_RELEASE, "agent");
            asm volatile("s_waitcnt vmcnt(0)" ::: "memory");
            const unsigned og = xb_add(&bar[XB_TOP], 1u);
            const unsigned tg = og / nx;
            if (og + 1u == (tg + 1u) * nx) xb_add(&bar[XB_TOPGEN], 1u);
            else XB_SPIN(xb_ld(&bar[XB_TOPGEN]) == tg, bar);
            __builtin_amdgcn_fence(__ATOMIC_ACQUIRE, "agent");
            xb_add(&bar[XB_XGEN(b.x)], 1u);
            asm volatile("s_waitcnt vmcnt(0)" ::: "memory");
        } else {
            XB_SPIN(xb_ld(&bar[XB_XGEN(b.x)]) == gen, bar);
            __builtin_amdgcn_fence(__ATOMIC_ACQUIRE, "agent");
            asm volatile("s_waitcnt vmcnt(0)" ::: "memory");
        }
    }
    __syncthreads();
}

__global__ void __launch_bounds__(NWAVES * 64, 2) mega_fwd(Args A) {
    extern __shared__ __attribute__((aligned(16))) unsigned char lds[];
    LAS unsigned char* ldsl = (LAS unsigned char*)lds;
    const int tid = threadIdx.x, lane = tid & 63, wave = __builtin_amdgcn_readfirstlane(tid >> 6);
    const int G = gridDim.x; const int bx = blockIdx.x; const int vcu = (G % 8 == 0) ? (bx % 8) * (G / 8) + bx / 8 : bx;
    unsigned char* ws = A.ws;
    const int gw = vcu * NWAVES + wave, NGW = G * NWAVES;
    volatile LAS unsigned* bar_st = (volatile LAS unsigned*)(ldsl + LDS_BYTES - 64);
    if (tid == 0) { bar_st[0] = 0u; bar_st[1] = 0u; }
    __syncthreads();
    const XcdBarrier xbar = xcd_barrier_post((unsigned*)ws, bar_st, wave);

    {
        for (int it = gw; it < 48 * 16; it += NGW) {
            const int cgp = it % 48, kc = it / 48, col = cgp * 64 + lane, k0 = kc * 64;
            float sv[6], ac[6];
#pragma unroll
            for (int b = 0; b < 6; ++b) { const float c = b < 4 ? A.c_prompt[b * DM + k0 + lane] : A.c_sample[(b - 4) * DM + k0 + lane]; sv[b] = silu_f(c); ac[b] = 0.f; }
            for (int kk = 0; kk < 64; ++kk) {
                const float w = A.w_ada[(size_t)(k0 + kk) * 3072 + col];
#pragma unroll
                for (int b = 0; b < 6; ++b) ac[b] += __shfl(sv[b], kk) * w;
            }
            float* modp = (float*)(ws + WS_MODP);
#pragma unroll
            for (int b = 0; b < 6; ++b) modp[(size_t)(kc * 6 + b) * 3072 + col] = ac[b];
        }
        {
            float am = 0.f;
            for (int i = gw * 64 + lane; i < DM * 384; i += NGW * 64) {
                const int row = i / 384, c4 = i - row * 384, col = c4 < 128 ? 4 * c4 : 1280 + 4 * (c4 - 128);
                const f32x4 v = *(const f32x4*)(A.w_in + (size_t)row * DIN + col);
                am = fmaxf(fmaxf(am, fmaxf(fabsf(v.x), fabsf(v.y))), fmaxf(fabsf(v.z), fabsf(v.w)));
            }
            float ag = 0.f;
            for (int i = gw * 64 + lane; i < DM * 512; i += NGW * 64) {
                const int row = i >> 9, col = 3328 + 4 * (i & 511);
                const f32x4 v = *(const f32x4*)(A.w_in + (size_t)row * DIN + col);
                ag = fmaxf(fmaxf(ag, fmaxf(fabsf(v.x), fabsf(v.y))), fmaxf(fabsf(v.z), fabsf(v.w)));
            }
#pragma unroll
            for (int o_ = 1; o_ < 64; o_ <<= 1) { am = fmaxf(am, __shfl_xor(am, o_)); ag = fmaxf(ag, __shfl_xor(ag, o_)); }
            LAS float* amw = (LAS float*)(ldsl + 1024);
            if (lane == 0) { amw[wave] = am; amw[8 + wave] = ag; }
            __syncthreads();
            if (tid == 0) { float m = amw[0], mg = amw[8];
#pragma unroll
                for (int w = 1; w < NWAVES; ++w) { m = fmaxf(m, amw[w]); mg = fmaxf(mg, amw[8 + w]); }
                ((float*)(ws + WS_AMAX))[bx] = m; ((float*)(ws + WS_AMAXG))[bx] = mg; }
        }
    }
    xcd_barrier(xbar);

    {
        LAS float* Gt = (LAS float*)(ldsl + 140 * 1024); LAS float* St = Gt + DM;
        const float* modp = (const float*)(ws + WS_MODP);
        if (vcu < NBATCH) {
            for (int c = tid; c < DM; c += NWAVES * 64) { float g = A.b_ada[2048 + c];
                for (int kc = 0; kc < 16; ++kc) g += modp[(size_t)(kc * 6 + vcu) * 3072 + 2048 + c];
                ((float*)(ws + WS_GATE))[vcu * DM + c] = g; }
        }
        const int rstart = (int)((long)TOK * vcu / G), rend = (int)((long)TOK * (vcu + 1) / G);
        const int b_lo = rstart >> 13, b_hi = (rend - 1) >> 13;
        for (int b = b_lo; b <= b_hi; ++b) {
            __syncthreads();
            for (int c = tid; c < DM; c += NWAVES * 64) { float sh = A.b_ada[c], scl = A.b_ada[1024 + c];
                for (int kc = 0; kc < 16; ++kc) { sh += modp[(size_t)(kc * 6 + b) * 3072 + c]; scl += modp[(size_t)(kc * 6 + b) * 3072 + 1024 + c]; }
                Gt[c] = A.norm_g[c] * (1.0f + scl); St[c] = sh; }
            __syncthreads();
            const int lo = rstart > b * SEQ ? rstart : b * SEQ, hi_ = rend < (b + 1) * SEQ ? rend : (b + 1) * SEQ;
            for (int r = lo + wave; r < hi_; r += NWAVES) {
                const float* xrow = r < TOKP ? A.x_prompt + (size_t)r * DM : A.x_sample + (size_t)(r - TOKP) * DM;
                const f32x4* xr = (const f32x4*)xrow + lane;
                f32x4 v[4]; float s = 0.f;
#pragma unroll
                for (int j = 0; j < 4; ++j) { v[j] = __builtin_nontemporal_load(xr + 64 * j); s += (v[j].x * v[j].x + v[j].y * v[j].y) + (v[j].z * v[j].z + v[j].w * v[j].w); }
                const float rstd = 1.0f / sqrtf(wave_sum(s) * (1.0f / DM) + EPS);
                u32x2* o8 = (u32x2*)((h16_t*)(ws + WS_XN) + (size_t)r * DM) + lane;
                unsigned* o8b = (unsigned*)(ws + WS_XN8 + (size_t)r * DM) + lane;
#pragma unroll
                for (int j = 0; j < 4; ++j) { const f32x4 gq = *(const LAS f32x4*)(Gt + 4 * lane + 256 * j), sq = *(const LAS f32x4*)(St + 4 * lane + 256 * j);
                    const f32x4 h = v[j] * rstd * gq + sq; u32x2 w; w.x = pk2h(h.x, h.y); w.y = pk2h(h.z, h.w); o8[64 * j] = w;
                    int w8 = 0; w8 = __builtin_amdgcn_cvt_pk_fp8_f32(__builtin_amdgcn_fmed3f(h.x, -448.f, 448.f), __builtin_amdgcn_fmed3f(h.y, -448.f, 448.f), w8, false);
                    w8 = __builtin_amdgcn_cvt_pk_fp8_f32(__builtin_amdgcn_fmed3f(h.z, -448.f, 448.f), __builtin_amdgcn_fmed3f(h.w, -448.f, 448.f), w8, true); o8b[64 * j] = (unsigned)w8; }
            }
        }
        __syncthreads();
        LAS float* scr = (LAS float*)(ldsl + wave * 16384);
        const float w8s = __uint_as_float((unsigned)(127 + w8_exp(amax_bits(ws, G))) << 23);
        const float w8g = -1.4426950408889634f * __uint_as_float((unsigned)(127 + w8_exp(amax_bits(ws, G, WS_AMAXG))) << 23);
        constexpr int I_IN = (DM / 64) * (DIN / 32), I_PA = (512 / 64) * (DM / 32), I_OUT = (DM / 64) * (DM / 32);
        constexpr int NITEMS = I_IN + 2 * I_PA + I_OUT;
        for (int it = gw; it < NITEMS; it += NGW) {
            int r = it;
            if (r < I_IN) { const int nblk = DIN / 32, kb = r / nblk, nb = r % nblk, wr_ = win_row(32 * nb), T_ = nb >> 3;
                const bool qk8 = T_ < 2 || (T_ >= 5 && T_ <= 8);
                transpose_item(A.w_in, DIN, (h16_t*)(ws + WS_WIN), DM, 0, 64 * kb, 32 * nb, -1, scr, lane, qk8 ? ws + WS_WIN8 : (T_ >= 13 ? ws + WS_WIN8G : nullptr), qk8 ? wr_ : -13 * 256, qk8 ? w8s : w8g, T_ >= 13 ? -1.4426950408889634f : 1.0f); continue; } r -= I_IN;
            if (r < I_PA) { const int nblk = DM / 32, kb = r / nblk, nb = r % nblk, n0 = 32 * nb; transpose_item(A.w_proj_a, DM, (h16_t*)(ws + WS_WAB), DM, 0, 64 * kb, n0, 256 * (n0 >> 7) + (n0 & 127), scr, lane); continue; } r -= I_PA;
            if (r < I_PA) { const int nblk = DM / 32, kb = r / nblk, nb = r % nblk, n0 = 32 * nb; transpose_item(A.w_proj_b, DM, (h16_t*)(ws + WS_WAB), DM, 512, 64 * kb, n0, 256 * (n0 >> 7) + 128 + (n0 & 127), scr, lane); continue; } r -= I_PA;
            { const int nblk = DM / 32, kb = r / nblk, nb = r % nblk; transpose_item(A.w_out, DM, (h16_t*)(ws + WS_WOUT), DM, 0, 64 * kb, 32 * nb, 32 * nb, scr, lane); }
        }
        for (int row = gw; row < 2048; row += NGW) {
            h16_t* p = (h16_t*)(ws + WS_WAB) + (size_t)row * DM + ((row & 128) ? 0 : 512) + lane * 8;
            *(u32x4*)p = (u32x4){0u, 0u, 0u, 0u};
        }
        if (vcu == 0) { float* nrm = (float*)(ws + WS_NRM);
            if (tid < 64) { nrm[tid] = A.qn_a[tid]; nrm[64 + tid] = A.kn_a[tid]; nrm[128 + tid] = A.qn_b[tid]; nrm[192 + tid] = A.kn_b[tid]; }
            if (tid < 128) nrm[256 + tid] = A.subln_g[tid]; }
        {
            const int gt = vcu * (NWAVES * 64) + tid, NGT = G * NWAVES * 64;
            for (int e = gt; e < 65536 + 2048 + 1024; e += NGT) {
                int pos, j, kind; if (e < 65536) { kind = 0; pos = e >> 3; j = e & 7; } else if (e < 65536 + 2048) { kind = 1; pos = (e - 65536) >> 4; j = e & 15; } else { kind = 2; pos = (e - 65536 - 2048) >> 4; j = e & 15; }
                const double inv = kind == 0 ? INV_B[j] : INV_A[j & 15];
                double rev = (double)pos * inv * 0.15915494309189533577; rev -= floor(rev);
                const double q4 = floor(rev * 4.0 + 0.5); const double xr = (rev - q4 * 0.25) * 6.283185307179586476925; const double x2 = xr * xr;
                const double sp = xr * (1.0 + x2 * (-1.0 / 6 + x2 * (1.0 / 120 + x2 * (-1.0 / 5040 + x2 * (1.0 / 362880 + x2 * (-1.0 / 39916800 + x2 * (1.0 / 6227020800.0)))))));
                const double cp = 1.0 + x2 * (-0.5 + x2 * (1.0 / 24 + x2 * (-1.0 / 720 + x2 * (1.0 / 40320 + x2 * (-1.0 / 3628800 + x2 * (1.0 / 479001600.0 + x2 * (-1.0 / 87178291200.0)))))));
                const int qd = ((int)q4) & 3;
                const double cd = qd == 0 ? cp : qd == 1 ? -sp : qd == 2 ? -cp : sp, sd = qd == 0 ? sp : qd == 1 ? cp : qd == 2 ? -sp : -cp;
                const float cs = (float)cd, sn = (float)sd;
                h16_t* tp; int stride, half;
                if (kind == 0) { tp = (h16_t*)(ws + WS_TB); stride = 16; half = 8; } else if (kind == 1) { tp = (h16_t*)(ws + WS_TAR); stride = 32; half = 16; } else { tp = (h16_t*)(ws + WS_TAC); stride = 32; half = 16; }
                tp[pos * stride + j] = f2h(cs);
                tp[pos * stride + half + j] = f2h(sn);
            }
        }
    }
    xcd_barrier(xbar);

    int p4_u8, p4_eg;
    {
        float bA_, bB_; score_bounds(A, bA_, bB_); const int u8 = use_fp8(bA_, bB_) ? 1 : 0;
        p4_u8 = __builtin_amdgcn_readfirstlane(u8); p4_eg = __builtin_amdgcn_readfirstlane(w8_exp(amax_bits(ws, G, WS_AMAXG)));
        if (u8) {
            const int eqk = w8_exp(amax_bits(ws, G));
            pg8::Gemm g{(const h16_t*)(ws + WS_XN8), (const h16_t*)(ws + WS_WIN8), TOK, 6 * 256, DM / 2, 0x7f00 | (127 - eqk)}; pg8::StaticOrder S; S.init(TOK, 6 * 256, G, bx);
            if (G == 256) { S.i2 = 3; S.G2 = 192; S.c2 = (bx >= 128 && bx < 192) ? -1 : (bx < 128 ? bx : bx - 64); }
            EpiInProj E{0, ws, 1, 0, 1.0f};
            pg8::gemm_phase<EpiInProj, false, true>(ldsl, g, S, E, wave);
        }
        {
            const int nt16 = u8 ? 3 : 9;
            pg8::Gemm g{(const h16_t*)(ws + WS_XN), (const h16_t*)(ws + WS_WIN) + (size_t)(9 - nt16) * 256 * DM, TOK, nt16 * 256, DM}; pg8::StaticOrder S; S.init(TOK, nt16 * 256, G, u8 ? (bx + G / 2) % G : bx);
            EpiInProj E{0, ws, u8, 9 - nt16, 1.0f};
            pg8::gemm_phase<EpiInProj>(ldsl, g, S, E, wave);
        }
    }
    xcd_barrier(xbar);

    {
        float lam;
        { int ln = lane_id(); asm volatile("" : "+v"(ln)); const float p1 = A.lq1[ln] * A.lk1[ln], p2 = A.lq2[ln] * A.lk2[ln]; lam = __uint_as_float(__builtin_amdgcn_readfirstlane(__float_as_uint(__expf(wave_sum(p1)) - __expf(wave_sum(p2)) + LAM_INIT))); }
        float boundA, boundB; score_bounds(A, boundA, boundB); const bool use8 = use_fp8(boundA, boundB);
        auto shift_of = [](float bound) -> int { const unsigned b = __float_as_uint(bound); const int e = (int)(b >> 23) - 127; const unsigned m = (b & 0x7fffffu) | 0x800000u;
            const int fx = e >= 13 ? (int)(m << (e - 13)) : (e >= -10 ? (int)(m >> (13 - e)) : 0);
            return (fx - 8960 + 1024) >> 10; };
        const int mIA = shift_of(boundA), mIB = shift_of(boundB);
        char* shm = (char*)lds;
        h16_t* OAB = (h16_t*)(ws + WS_OAB);
        auto first_dma = [&](int s_, int p_) {
            if (s_ < 768) { const int u = (s_ >> 8) * 32 + (s_ & 31), xg = (s_ & 255) >> 5, j = u >> 4, id = 3 * xg + (j >> 1), b = id >> 2, kvh = (id >> 1) & 1;
                att::attn_first_dma<2>((const unsigned char*)(ws + WS_KA) + (long)b * SEQ * 96 + kvh * 48, 96, (const unsigned char*)(ws + WS_VTA) + (long)((b * 2 + kvh) * 64) * SEQ, shm, wave);
            } else { const int a = s_ - 768, ii = a >> 8, vv = a & 255, xg = vv >> 5, id = 3 * xg + ii, b = id >> 2, h = id & 3;
                att::attn_first_dma<4>((const unsigned char*)(ws + WS_KB) + (long)b * SEQ * 384 + (2 * h + p_) * 48, 384, (const unsigned char*)(ws + WS_VTB) + (long)((b * 4 + h) * 128) * SEQ, shm, wave); }
        };
        if (use8 && vcu < 1536) first_dma(vcu, 0);
        for (int s = vcu; s < 1536; s += G) {
            const bool isB = s >= 768;
            if (!isB) {
                const int u = (s >> 8) * 32 + (s & 31), xg = (s & 255) >> 5, qb = u & 15, j = u >> 4, id = 3 * xg + (j >> 1), sel = j & 1, b = id >> 2;
                const long rowbase = (long)b * SEQ + qb * 512 + wave * 64;
                const int kvh = (id >> 1) & 1, h = 4 * kvh + 2 * (id & 1) + sel;
                const h16_t* Qw = (const h16_t*)(ws + WS_QA) + rowbase * 512 + h * 64;
                const h16_t* Kh = (const h16_t*)(ws + WS_KA) + (long)b * SEQ * 128 + kvh * 64;
                const h16_t* Vh = (const h16_t*)(ws + WS_VA) + (long)b * SEQ * 128 + kvh * 64;
                f32x16 oa[2], ob[2]; float la, lb;
                if (use8) att::attn_pass8_2x((const unsigned char*)(ws + WS_QA) + rowbase * 384 + h * 48, 384, (const unsigned char*)(ws + WS_KA) + (long)b * SEQ * 96 + kvh * 48, 96,
                                             (const unsigned char*)(ws + WS_VTA) + (long)((b * 2 + kvh) * 64) * SEQ, mIA, shm, oa, ob, la, lb, wave, true);
                if (use8 && s + G < 1536) first_dma(s + G, 0);
                auto epiA = [&](const f32x16 (&o)[2], float l, long rb) {
                    int tid2 = wave * 64 + lane_id(); asm volatile("" : "+v"(tid2));
                    const int lane = tid2 & 63, r32 = lane & 31, hi = lane >> 5;
                    float* wsf = (float*)(shm + att::LDS_WS) + wave * 64;
                    h16_t* stg = (h16_t*)(shm + att::LDS_OST + wave * att::OST_WAVE);
                    if (hi == 0) wsf[32 + r32] = l; asm volatile("s_waitcnt lgkmcnt(0)" ::: "memory");
                    float rli[16];
#pragma unroll
                    for (int r = 0; r < 16; ++r) rli[r] = __builtin_amdgcn_rcpf(wsf[32 + att::crow(r, hi)]);
#pragma unroll
                    for (int r = 0; r < 16; ++r) { const int orow = att::crow(r, hi);
#pragma unroll
                        for (int d0 = 0; d0 < 2; ++d0) stg[orow * 64 + d0 * 32 + r32] = f2h(o[d0][r] * rli[r]); }
                    asm volatile("s_waitcnt lgkmcnt(0)" ::: "memory");
                    h16_t* Ow = OAB + rb * 1024 + h * 64;
#pragma unroll
                    for (int i = 0; i < 4; ++i) { const int row = i * 8 + (lane >> 3), ch = lane & 7; const u32x4 v = *(const u32x4*)(stg + row * 64 + ch * 8); *(u32x4*)(Ow + (long)row * 1024 + ch * 8) = v; }
                    asm volatile("s_waitcnt lgkmcnt(0)" ::: "memory");
                };
                if (use8) { epiA(oa, la, rowbase); epiA(ob, lb, rowbase + 32); }
                else {
#pragma unroll 1
                    for (int sub = 0; sub < 2; ++sub) { att::attn_pass<8, false>(Qw + (long)sub * 32 * 512, 512, Kh, 128, Vh, 128, shm, oa, la, wave); epiA(oa, la, rowbase + 32 * sub); }
                }
            } else {
                const int a = s - 768, ii = a >> 8, vv = a & 255, xg = vv >> 5, qb = vv & 31, id = 3 * xg + ii, b = id >> 2, h = id & 3;
                const long rowbase = (long)b * SEQ + qb * 256 + wave * 32;
                const h16_t* Vh = (const h16_t*)(ws + WS_VB) + (long)b * SEQ * 512 + h * 128;
#pragma unroll 1
                for (int p = 0; p < 2; ++p) {
                    const h16_t* Qw = (const h16_t*)(ws + WS_QB) + rowbase * 512 + (2 * h + p) * 64;
                    const h16_t* Kh = (const h16_t*)(ws + WS_KB) + (long)b * SEQ * 512 + (2 * h + p) * 64;
                    f32x16 o[4]; float l;
                    if (use8) att::attn_pass8<4>((const unsigned char*)(ws + WS_QB) + rowbase * 384 + (2 * h + p) * 48, 384, (const unsigned char*)(ws + WS_KB) + (long)b * SEQ * 384 + (2 * h + p) * 48, 384,
                                                 (const unsigned char*)(ws + WS_VTB) + (long)((b * 4 + h) * 128) * SEQ, mIB, shm, o, l, wave, true);
                    else att::attn_pass128<8, false>(Qw, 512, Kh, 512, Vh, 512, shm, o, l, wave);
                    if (use8) { if (p == 0) first_dma(s, 1); else if (s + G < 1536) first_dma(s + G, 0); }
                    int tid2 = wave * 64 + lane_id(); asm volatile("" : "+v"(tid2));
                    const int lane = tid2 & 63, r32 = lane & 31, hi = lane >> 5;
                    float* wsf = (float*)(shm + att::LDS_WS) + wave * 64;
                    unsigned* stw = (unsigned*)(shm + att::LDS_OST + wave * att::OST_WAVE);
                    h16_t* stg = (h16_t*)stw;
                    if (hi == 0) wsf[32 + r32] = l; asm volatile("s_waitcnt lgkmcnt(0)" ::: "memory");
                    float rli[16];
#pragma unroll
                    for (int r = 0; r < 16; ++r) rli[r] = __builtin_amdgcn_rcpf(wsf[32 + att::crow(r, hi)]);
                    if (p == 0) {
#pragma unroll
                        for (int d0 = 0; d0 < 4; ++d0)
#pragma unroll
                            for (int r = 0; r < 16; r += 2) stw[(d0 * 8 + (r >> 1)) * 64 + lane] = pk2h(o[d0][r] * rli[r], o[d0][r + 1] * rli[r + 1]);
                        asm volatile("s_waitcnt lgkmcnt(0)" ::: "memory");
                    } else {
                        unsigned sv[32];
#pragma unroll
                        for (int i = 0; i < 32; ++i) sv[i] = stw[i * 64 + lane];
                        asm volatile("s_waitcnt lgkmcnt(0)" ::: "memory");
#pragma unroll
                        for (int d0 = 0; d0 < 4; ++d0)
#pragma unroll
                            for (int r = 0; r < 16; ++r) { const unsigned w = sv[d0 * 8 + (r >> 1)]; const float o0 = h2f((unsigned short)((r & 1) ? (w >> 16) : (w & 0xffffu)));
                                const float dv = o0 - lam * (o[d0][r] * rli[r]);
                                stg[att::crow(r, hi) * 128 + d0 * 32 + r32] = f2h(dv); }
                        asm volatile("s_waitcnt lgkmcnt(0)" ::: "memory");
                        const float* sg = A.subln_g;
                        h16_t* Ow = OAB + rowbase * 1024 + 512 + h * 128;
#pragma unroll
                        for (int i = 0; i < 8; ++i) { const int row = i * 4 + (lane >> 4), ch = lane & 15; const u32x4 v = *(const u32x4*)(stg + row * 128 + ch * 8);
                            float f[8]; float q = 0.f;
#pragma unroll
                            for (int e = 0; e < 4; ++e) { f[2 * e] = h2f((unsigned short)(v[e] & 0xffffu)); f[2 * e + 1] = h2f((unsigned short)(v[e] >> 16)); q += f[2 * e] * f[2 * e] + f[2 * e + 1] * f[2 * e + 1]; }
                            q += __shfl_xor(q, 1); q += __shfl_xor(q, 2); q += __shfl_xor(q, 4); q += __shfl_xor(q, 8);
                            const float rn = __builtin_amdgcn_rsqf(q * (1.0f / 128.0f) + EPS) * (1.0f - LAM_INIT);
                            const f32x4 g0 = *(const f32x4*)(sg + ch * 8), g1 = *(const f32x4*)(sg + ch * 8 + 4);
                            u32x4 w; w.x = pk2h(f[0] * rn * g0[0], f[1] * rn * g0[1]); w.y = pk2h(f[2] * rn * g0[2], f[3] * rn * g0[3]); w.z = pk2h(f[4] * rn * g1[0], f[5] * rn * g1[1]); w.w = pk2h(f[6] * rn * g1[2], f[7] * rn * g1[3]);
                            *(u32x4*)(Ow + (long)row * 1024 + ch * 8) = w; }
                        asm volatile("s_waitcnt lgkmcnt(0)" ::: "memory");
                    }
                }
            }
        }
    }
    xcd_barrier(xbar);

    {
        const int u8 = p4_u8;
        {
            const int nt16 = u8 ? 4 : 12;
            pg8::Gemm g{(const h16_t*)(ws + WS_XN), (const h16_t*)(ws + WS_WIN) + (size_t)9 * 256 * DM, TOK, nt16 * 256, DM}; pg8::StaticOrder S; S.init(TOK, nt16 * 256, G, bx);
            EpiInProj E{1, ws, 0, 0, 1.0f};
            pg8::gemm_phase<EpiInProj>(ldsl, g, S, E, wave);
        }
        if (u8) {
            pg8::Gemm g{(const h16_t*)(ws + WS_XN8), (const h16_t*)(ws + WS_WIN8G), TOK, 8 * 256, DM / 2, 0x7f00 | (127 - p4_eg)}; pg8::StaticOrder S; S.init(TOK, 8 * 256, G, bx);
            EpiInProj E{1, ws, 0, 4, 1.0f};
            pg8::gemm_phase<EpiInProj, false, true>(ldsl, g, S, E, wave);
        }
    }
    xcd_barrier(xbar);

    {
        pg8::Gemm g{(const h16_t*)(ws + WS_OAB), (const h16_t*)(ws + WS_WAB), TOK, 2048, DM}; pg8::StaticOrder S; S.init(TOK, 2048, G, bx);
        EpiMerge E{ws + WS_SGA, ws + WS_SGB, (h16_t*)(ws + WS_MG)};
        pg8::gemm_phase<EpiMerge, true>(ldsl, g, S, E, wave);
    }
    xcd_barrier(xbar);

    {
        pg8::Gemm g{(const h16_t*)(ws + WS_MG), (const h16_t*)(ws + WS_WOUT), TOK, DM, DM}; pg8::StaticOrder S; S.init(TOK, DM, G, bx);
        EpiOut E{A.x_prompt, (long)((const char*)A.x_sample - (const char*)A.x_prompt) - (long)TOKP * DM * 4, (const float*)(ws + WS_GATE), A.out};
        pg8::gemm_phase<EpiOut>(ldsl, g, S, E, wave);
    }
}

extern "C" void kernel_launch(void* const* d_in, const int* in_sizes, int n_in, void* d_out, int out_size, void* d_ws, size_t ws_size, hipStream_t stream) {
    static int grid = 0;
    if (grid == 0) {
        if (n_in != 20 || out_size != TOK * DM || ws_size < WS_END) { fprintf(stderr, "kernel_launch: unexpected shapes (n_in %d out %d ws %zu)\n", n_in, out_size, ws_size); grid = -1; return; }
        int dev = 0, cus = 0, per_cu = 0;
        hipGetDevice(&dev); hipDeviceGetAttribute(&cus, hipDeviceAttributeMultiprocessorCount, dev);
        hipFuncSetAttribute((const void*)mega_fwd, hipFuncAttributeMaxDynamicSharedMemorySize, LDS_BYTES);
        hipOccupancyMaxActiveBlocksPerMultiprocessor(&per_cu, (const void*)mega_fwd, NWAVES * 64, LDS_BYTES);
        (void)hipGetLastError();
        if (per_cu < 1) fprintf(stderr, "kernel_launch: occupancy query reports %d blocks per CU\n", per_cu);
        grid = cus > 0 ? cus : 256;
    }
    if (grid < 0) return;
    Args a{};
    a.x_prompt = (const float*)d_in[0]; a.x_sample = (const float*)d_in[1]; a.c_prompt = (const float*)d_in[2]; a.c_sample = (const float*)d_in[3];
    a.w_ada = (const float*)d_in[4]; a.b_ada = (const float*)d_in[5]; a.norm_g = (const float*)d_in[6]; a.w_in = (const float*)d_in[7];
    a.qn_a = (const float*)d_in[8]; a.kn_a = (const float*)d_in[9]; a.qn_b = (const float*)d_in[10]; a.kn_b = (const float*)d_in[11];
    a.lq1 = (const float*)d_in[12]; a.lk1 = (const float*)d_in[13]; a.lq2 = (const float*)d_in[14]; a.lk2 = (const float*)d_in[15]; a.subln_g = (const float*)d_in[16];
    a.w_proj_a = (const float*)d_in[17]; a.w_proj_b = (const float*)d_in[18]; a.w_out = (const float*)d_in[19];
    a.out = (float*)d_out; a.ws = (unsigned char*)d_ws;
    if (hipMemsetAsync(d_ws, 0, XCD_BAR_WORDS * 4, stream) != hipSuccess) { fprintf(stderr, "kernel_launch: hipMemsetAsync failed\n"); return; }
    void* args[] = {&a};
    hipError_t e = hipLaunchCooperativeKernel((const void*)mega_fwd, dim3(grid), dim3(NWAVES * 64), args, LDS_BYTES, stream);
    if (e != hipSuccess) fprintf(stderr, "kernel_launch: cooperative launch failed: %s (grid %d)\n", hipGetErrorString(e), grid);
}
```

```cpp
#include <hip/hip_runtime.h>
#include <cstdio>
#include <cstdint>
#include <cmath>

#define LAS __attribute__((address_space(3)))
#define GAS __attribute__((address_space(1)))
typedef unsigned short h16_t;
#ifndef LP_BF16
#define LP_BF16 1
#endif
#if LP_BF16
typedef __bf16 lp_t;
typedef short f16x8 __attribute__((ext_vector_type(8)));
#define MFMA16(a, b, c) __builtin_amdgcn_mfma_f32_16x16x32_bf16(a, b, c, 0, 0, 0)
#define MFMA32(a, b, c) __builtin_amdgcn_mfma_f32_32x32x16_bf16(a, b, c, 0, 0, 0)
#else
typedef _Float16 lp_t;
typedef _Float16 f16x8 __attribute__((ext_vector_type(8)));
#define MFMA16(a, b, c) __builtin_amdgcn_mfma_f32_16x16x32_f16(a, b, c, 0, 0, 0)
#endif
typedef lp_t f16x2 __attribute__((ext_vector_type(2)));
typedef float f32x2 __attribute__((ext_vector_type(2)));
typedef float f32x4 __attribute__((ext_vector_type(4)));
typedef float f32x8 __attribute__((ext_vector_type(8)));
typedef float f32x16 __attribute__((ext_vector_type(16)));
typedef unsigned u32x2 __attribute__((ext_vector_type(2)));
typedef unsigned u32x4 __attribute__((ext_vector_type(4)));
typedef short s16x4 __attribute__((ext_vector_type(4)));
typedef int i32x4 __attribute__((ext_vector_type(4)));
typedef int i32x8 __attribute__((ext_vector_type(8)));
typedef int i32x6 __attribute__((ext_vector_type(6)));
#define MFMA8S_G(a, b, c) __builtin_amdgcn_mfma_scale_f32_16x16x128_f8f6f4(a, b, c, 0, 0, 0, scv, 1, scv)

constexpr int DM = 1024, SEQ = 8192, NBATCH = 6, TOK = NBATCH * SEQ, TOKP = 4 * SEQ, DIN = 5376;
constexpr float EPS = 1e-6f;
constexpr float C2 = 0.125f * 1.4426950408889634f;
constexpr float SQK6 = 1.2011224087864498f;
constexpr float LAM_INIT = 0.2f;

constexpr size_t MiB = 1u << 20;
constexpr size_t WS_MODP = 1 * MiB;
constexpr size_t WS_GATE = 3 * MiB;
constexpr size_t WS_TAR = 3 * MiB + 65536;
constexpr size_t WS_TAC = WS_TAR + 8192;
constexpr size_t WS_TB = WS_TAC + 4096;
constexpr size_t WS_NRM = WS_GATE + 32768;
constexpr size_t WS_AMAX = WS_GATE + 32768 + 4096;
constexpr size_t WS_SSQ = 4 * MiB;
constexpr size_t WS_WIN = 6 * MiB;
constexpr size_t WS_WAB = 17 * MiB;
constexpr size_t WS_WOUT = 21 * MiB;
constexpr size_t WS_XN = 24 * MiB;
constexpr size_t WS_MG = WS_XN;
constexpr size_t WS_QA = 120 * MiB, WS_KA = 168 * MiB, WS_VA = 180 * MiB, WS_QB = 192 * MiB, WS_KB = 240 * MiB, WS_VB = 288 * MiB;
constexpr size_t WS_OAB = 336 * MiB;
constexpr size_t WS_SGA = 120 * MiB, WS_SGB = 216 * MiB;
constexpr size_t WS_VTA = 432 * MiB;
constexpr size_t WS_VTB = 438 * MiB;
constexpr size_t WS_XN8 = WS_VB;
constexpr size_t WS_WIN8G = WS_VA + 2 * MiB;
constexpr size_t WS_AMAXG = WS_AMAX + 1024;
constexpr size_t WS_WIN8 = WS_VA;
constexpr size_t WS_END = 462 * MiB;

__device__ __forceinline__ unsigned pk2h(float lo, float hi) { f32x2 v = {lo, hi}; f16x2 b = __builtin_convertvector(v, f16x2); return __builtin_bit_cast(unsigned, b); }
__device__ __forceinline__ float h2f(unsigned short u) { return (float)__builtin_bit_cast(lp_t, u); }
__device__ __forceinline__ unsigned short f2h(float v) { return __builtin_bit_cast(unsigned short, (lp_t)v); }
__device__ __forceinline__ int lane_id() { unsigned z = 0u; asm volatile("" : "+v"(z)); return (int)__builtin_amdgcn_mbcnt_hi(~0u, __builtin_amdgcn_mbcnt_lo(~0u, z)); }
__device__ __forceinline__ float wave_sum(float v) {
#pragma unroll
    for (int o = 1; o < 64; o <<= 1) v += __shfl_xor(v, o);
    return v;
}
__device__ __forceinline__ float silu_f(float v) { return v * __builtin_amdgcn_rcpf(1.0f + __expf(-v)); }
__device__ __forceinline__ float sigm_f(float v) { return __builtin_amdgcn_rcpf(1.0f + __expf(-v)); }

namespace pg8 {
constexpr int BM = 256, BK = 64, HALF = 128, HTB = HALF * BK * 2, STAGE_BYTES = 8 * HTB, NXCD = 8, WGM = 8;
__host__ __device__ __forceinline__ int lds_byte(int r, int c) { const int st = (r >> 4) * 2 + (c >> 5), rr = r & 15, cc = c & 31, ob = rr * 64 + cc * 2; return st * 1024 + (ob ^ (((ob >> 9) & 1) << 5)); }
__host__ __device__ __forceinline__ void stage_rc(int b, int& R, int& C) { const int st = b / 1024, sb = b % 1024, swz = sb ^ (((sb >> 9) & 1) << 5); R = (st >> 1) * 16 + swz / 64; C = (st & 1) * 32 + (swz % 64) / 2; }
__host__ __device__ __forceinline__ int perm32(int rho) { const int n = rho >> 4, i = rho & 15; return 8 * (i >> 2) + 4 * n + (i & 3); }
struct Unit { int pm, pn; };
struct Gemm { const h16_t* A; const h16_t* Bt; int M, N, K; int sc = 0x7f7f; };
struct StaticOrder {
    int nM, nN, nwg, G, c, i2, G2, c2;
    __device__ void init(int M, int N, int G_, int c_) { nM = M / BM; nN = N / BM; nwg = nM * nN; G = G_; c = c_; i2 = 1 << 20; G2 = G_; c2 = c_; }
    __device__ bool next(int i, Unit& u) const {
        long L;
        if (i < i2) L = (long)i * G + c; else { if (c2 < 0) return false; L = (long)i2 * G + (long)(i - i2) * G2 + c2; }
        if (L >= nwg) return false;
        int wgid = (int)L; { const int q = nwg / NXCD, r = nwg % NXCD, xcd = wgid % NXCD, off = wgid / NXCD; wgid = (xcd < r ? xcd * (q + 1) : r * (q + 1) + (xcd - r) * q) + off; }
        const int nig = WGM * nN, gid = wgid / nig, fm = gid * WGM, gsz = (nM - fm) < WGM ? (nM - fm) : WGM;
        u.pm = fm + ((wgid % nig) % gsz); u.pn = (wgid % nig) / gsz; return true;
    }
};
__device__ __forceinline__ i32x8 cat8(f16x8 a, f16x8 b) { const i32x4 x = __builtin_bit_cast(i32x4, a), y = __builtin_bit_cast(i32x4, b); return __builtin_shufflevector(x, y, 0, 1, 2, 3, 4, 5, 6, 7); }
template <class Epi, bool DIAG = false, bool F8 = false>
__device__ __forceinline__ void gemm_phase(LAS unsigned char* lds, const Gemm g, const StaticOrder& S, const Epi& E, int wave_in) {
    int tid = wave_in * 64 + lane_id(); asm volatile("" : "+v"(tid));
    const int wid = wave_in, lane = tid & 63, wr = wid >> 2, wc = wid & 3, fr = lane & 15, fq = lane >> 4;
    const int K = g.K, nt = K / BK;
    int scv = g.sc; asm volatile("" : "+v"(scv)); (void)scv;
    unsigned voffA[2], voffB[2];
#pragma unroll
    for (int i = 0; i < 2; ++i) { int R, C; stage_rc(tid * 16 + i * 8192, R, C); const int Rb = Epi::PERM ? ((R & ~31) + perm32(R & 31)) : R;
        voffA[i] = (unsigned)(R * K + C) * 2u; voffB[i] = (unsigned)(Rb * K + C) * 2u; }
    const size_t kstep = (size_t)(BK * 2);
    const size_t hstep = (size_t)HALF * K * 2;
    const size_t tstep = 2 * hstep;
    const unsigned ldsw = (unsigned)wid * 1024u;
    const int aoff = lds_byte(wr * 64 + fr, fq * 8), boff = lds_byte(wc * 32 + fr, fq * 8);
#define PG8_SA(b, h) (((b) * 2 + (h)) * HTB)
#define PG8_SB(b, h) ((4 + (b) * 2 + (h)) * HTB)
#define PG8_STAGE(bufoff, gbase, voff) do { _Pragma("unroll") for (int _i = 0; _i < 2; ++_i) \
        __builtin_amdgcn_global_load_lds((const unsigned*)((const char*)(gbase) + (voff)[_i]), (LAS unsigned*)(lds + (bufoff) + ldsw + _i * 8192), 16, 0, 0); } while (0)
#define PG8_LD8(p) ({ const i32x4 x_ = *(const LAS i32x4*)(p), y_ = *(const LAS i32x4*)((p) + 1024); (i32x8){x_[0], x_[1], x_[2], x_[3], y_[0], y_[1], y_[2], y_[3]}; })
#define PG8_LDA(dst, b, h) do { if constexpr (F8) { _Pragma("unroll") for (int m = 0; m < 4; ++m) dst##8[m] = PG8_LD8(lds + PG8_SA(b, h) + aoff + m * 2048); } else { \
        _Pragma("unroll") for (int m = 0; m < 4; ++m) _Pragma("unroll") for (int k = 0; k < 2; ++k) dst[m][k] = *(const LAS f16x8*)(lds + PG8_SA(b, h) + aoff + m * 2048 + k * 1024); } } while (0)
#define PG8_LDB(dst, b, h) do { if constexpr (F8) { _Pragma("unroll") for (int n = 0; n < 2; ++n) dst##8[n] = PG8_LD8(lds + PG8_SB(b, h) + boff + n * 2048); } else { \
        _Pragma("unroll") for (int n = 0; n < 2; ++n) _Pragma("unroll") for (int k = 0; k < 2; ++k) dst[n][k] = *(const LAS f16x8*)(lds + PG8_SB(b, h) + boff + n * 2048 + k * 1024); } } while (0)
#define PG8_MMA(ai, bj, At, Bt) do { __builtin_amdgcn_s_setprio(1); if constexpr (F8) { _Pragma("unroll") for (int m = 0; m < 4; ++m) _Pragma("unroll") for (int n = 0; n < 2; ++n) \
        { if (n == 0) acc8[ai][bj][m].lo = MFMA8S_G(Bt##8[n], At##8[m], acc8[ai][bj][m].lo); else acc8[ai][bj][m].hi = MFMA8S_G(Bt##8[n], At##8[m], acc8[ai][bj][m].hi); } \
        _Pragma("unroll") for (int m = 0; m < 4; ++m) asm volatile("" : "+v"(acc8[ai][bj][m])); } else { \
        _Pragma("unroll") for (int m = 0; m < 4; ++m) _Pragma("unroll") for (int n = 0; n < 2; ++n) _Pragma("unroll") for (int k = 0; k < 2; ++k) \
        acc[ai][bj][m][n] = MFMA16(Bt[n][k], At[m][k], acc[ai][bj][m][n]); } __builtin_amdgcn_s_setprio(0); } while (0)
#define PG8_WAIT_V(n) asm volatile("s_waitcnt vmcnt(" #n ")" ::: "memory")
#define PG8_WAIT_L(n) asm volatile("s_waitcnt lgkmcnt(" #n ")" ::: "memory")
#define PG8_BAR __builtin_amdgcn_s_barrier()
#define PG8_SCHED __builtin_amdgcn_sched_barrier(0)
    Unit cur, nxt; int ui = 0;
    if (!S.next(0, cur)) return;
    f32x4 acc[2][2][4][2];
    f32x8 acc8[2][2][4];
#pragma unroll
    for (int a = 0; a < 2; ++a)
#pragma unroll
        for (int b = 0; b < 2; ++b)
#pragma unroll
            for (int m = 0; m < 4; ++m) acc8[a][b][m] = (f32x8){0.f, 0.f, 0.f, 0.f, 0.f, 0.f, 0.f, 0.f};
#pragma unroll
    for (int a = 0; a < 2; ++a)
#pragma unroll
        for (int b = 0; b < 2; ++b)
#pragma unroll
            for (int m = 0; m < 4; ++m)
#pragma unroll
                for (int n = 0; n < 2; ++n) acc[a][b][m][n] = (f32x4){0.f, 0.f, 0.f, 0.f};
    f16x8 At[4][2], B0[2][2], B1[2][2]; i32x8 At8[4], B08[2], B18[2];
    const char* cA = (const char*)g.A + (size_t)cur.pm * tstep; const char* cB = (const char*)g.Bt + (size_t)cur.pn * tstep;
    PG8_STAGE(PG8_SB(0, 0), cB, voffB); if (!DIAG) PG8_STAGE(PG8_SB(0, 1), cB + hstep, voffB); PG8_STAGE(PG8_SA(0, 0), cA, voffA); PG8_STAGE(PG8_SA(0, 1), cA + hstep, voffA);
    if (wr == 1) PG8_BAR;
    PG8_WAIT_V(2); PG8_BAR;
    PG8_STAGE(PG8_SB(1, 0), cB + kstep, voffB); PG8_STAGE(PG8_SA(1, 0), cA + kstep, voffA); if (!DIAG) PG8_STAGE(PG8_SB(1, 1), cB + hstep + kstep, voffB);
    if (DIAG) { PG8_WAIT_V(4); } else { PG8_WAIT_V(6); } PG8_BAR;
    for (;;) {
        const bool has_next = S.next(ui + 1, nxt);
        const char* nA = has_next ? (const char*)g.A + (size_t)nxt.pm * tstep : cA; const char* nB = has_next ? (const char*)g.Bt + (size_t)nxt.pn * tstep : cB;
#pragma unroll 1
        for (int t = 0; t < nt; t += 2) {
            const bool last = (t == nt - 2); const bool lo_half = (2 * t < nt); (void)lo_half;
            const char* a1 = cA + (size_t)(t + 1) * kstep;
            const char* a2 = last ? nA : cA + (size_t)(t + 2) * kstep; const char* b2 = last ? nB : cB + (size_t)(t + 2) * kstep;
            const char* a3 = a2 + kstep; const char* b3 = b2 + kstep;
            const bool lo2 = last || (2 * (t + 2) < nt), lo3 = last || (2 * (t + 3) < nt); (void)lo2; (void)lo3;
#define PG8_WV() do { if (DIAG) { PG8_WAIT_V(6); } else { PG8_WAIT_V(8); } } while (0)
            if (!DIAG || lo_half) PG8_LDB(B0, 0, 0); if (!DIAG || !lo_half) PG8_LDB(B1, 0, 1); PG8_SCHED; PG8_LDA(At, 0, 0); PG8_STAGE(PG8_SA(1, 1), a1 + hstep, voffA);
            PG8_WV(); PG8_WAIT_L(0); PG8_BAR; if (!DIAG || lo_half) PG8_MMA(0, 0, At, B0); if (!DIAG || !lo_half) PG8_MMA(0, 1, At, B1); PG8_BAR; PG8_SCHED;
            PG8_LDA(At, 0, 1); if (!DIAG || lo2) PG8_STAGE(PG8_SB(0, 0), b2, voffB); if (!DIAG || !lo2) PG8_STAGE(PG8_SB(0, 1), b2 + hstep, voffB); PG8_STAGE(PG8_SA(0, 0), a2, voffA);
            PG8_WV(); PG8_WAIT_L(0); PG8_BAR; if (!DIAG || lo_half) PG8_MMA(1, 0, At, B0); if (!DIAG || !lo_half) PG8_MMA(1, 1, At, B1); PG8_BAR; PG8_SCHED;
            if (!DIAG || lo_half) PG8_LDB(B0, 1, 0); if (!DIAG || !lo_half) PG8_LDB(B1, 1, 1); PG8_SCHED; PG8_LDA(At, 1, 0); PG8_STAGE(PG8_SA(0, 1), a2 + hstep, voffA);
            PG8_WV(); PG8_WAIT_L(0); PG8_BAR; if (!DIAG || lo_half) PG8_MMA(0, 0, At, B0); if (!DIAG || !lo_half) PG8_MMA(0, 1, At, B1); PG8_BAR; PG8_SCHED;
            PG8_LDA(At, 1, 1); if (!DIAG || lo3) PG8_STAGE(PG8_SB(1, 0), b3, voffB); if (!DIAG || !lo3) PG8_STAGE(PG8_SB(1, 1), b3 + hstep, voffB); PG8_STAGE(PG8_SA(1, 0), a3, voffA);
            PG8_WV(); PG8_WAIT_L(0); PG8_BAR; if (!DIAG || lo_half) PG8_MMA(1, 0, At, B0); if (!DIAG || !lo_half) PG8_MMA(1, 1, At, B1); PG8_BAR; PG8_SCHED;
#undef PG8_WV
        }
        if (wr == 0) PG8_BAR;
        if constexpr (F8) {
#pragma unroll
            for (int a = 0; a < 2; ++a)
#pragma unroll
                for (int b = 0; b < 2; ++b)
#pragma unroll
                    for (int m = 0; m < 4; ++m) { acc[a][b][m][0] = acc8[a][b][m].lo; acc[a][b][m][1] = acc8[a][b][m].hi; acc8[a][b][m] = (f32x8){0.f, 0.f, 0.f, 0.f, 0.f, 0.f, 0.f, 0.f}; }
        }
        { int l2 = lane_id(); asm volatile("" : "+v"(l2)); E(acc, cur, wr, wc, l2 & 15, l2 >> 4); }
        if (!has_next) break;
#pragma unroll
        for (int a = 0; a < 2; ++a)
#pragma unroll
            for (int b = 0; b < 2; ++b)
#pragma unroll
                for (int m = 0; m < 4; ++m)
#pragma unroll
                    for (int n = 0; n < 2; ++n) acc[a][b][m][n] = (f32x4){0.f, 0.f, 0.f, 0.f};
        cur = nxt; cA = nA; cB = nB; ++ui;
        if (wr == 1) PG8_BAR;
    }
    PG8_WAIT_V(0);
    PG8_BAR;
#undef PG8_SA
#undef PG8_SB
#undef PG8_STAGE
#undef PG8_LDA
#undef PG8_LDB
#undef PG8_MMA
#undef PG8_WAIT_V
#undef PG8_WAIT_L
#undef PG8_BAR
#undef PG8_SCHED
}
}

__device__ __forceinline__ float xsum16(float x) { const auto r = __builtin_amdgcn_permlane16_swap(__float_as_uint(x), __float_as_uint(x), false, false); return __uint_as_float(r[0]) + __uint_as_float(r[1]); }
__device__ __forceinline__ float xsum32(float x) { const auto r = __builtin_amdgcn_permlane32_swap(__float_as_uint(x), __float_as_uint(x), false, false); return __uint_as_float(r[0]) + __uint_as_float(r[1]); }
struct EpiInProj {
    static constexpr bool PERM = true;
    int part; unsigned char* ws; int use8; int pnoff; float wsc;
    __device__ __forceinline__ void operator()(const f32x4 (&acc)[2][2][4][2], const pg8::Unit& u, int wr, int wc, int fr, int fq) const {
        asm volatile("" : "+v"(fr), "+v"(fq));
        const int row0 = u.pm * 256 + wr * 64 + fr;
        const int pi = u.pn + pnoff;
        const int T = part == 0 ? (pi < 2 ? pi : (pi < 6 ? pi + 3 : (pi == 6 ? 2 : pi + 2))) : (pi < 2 ? pi + 3 : pi + 9);
        if (part == 0) {
            const bool normed = (T <= 1) || (T == 2 && wc < 2) || (T >= 5 && T <= 8);
            if (normed) {
                const bool isA = (T <= 2), isQ = (T <= 1) || (T == 5) || (T == 6);
                const float* gw = (const float*)(ws + WS_NRM) + 64 * ((isA ? 0 : 2) + (isQ ? 0 : 1));
                h16_t* dst; int pitch, colbase;
                if (T <= 1) { dst = (h16_t*)(ws + WS_QA); pitch = 512; colbase = 256 * T + 64 * wc; }
                else if (T == 2) { dst = (h16_t*)(ws + WS_KA); pitch = 128; colbase = 64 * wc; }
                else if (T <= 6) { dst = (h16_t*)(ws + WS_QB); pitch = 512; colbase = 256 * (T - 5) + 64 * wc; }
                else { dst = (h16_t*)(ws + WS_KB); pitch = 512; colbase = 256 * (T - 7) + 64 * wc; }
                f32x4 gv[2][2];
#pragma unroll
                for (int bj = 0; bj < 2; ++bj)
#pragma unroll
                    for (int n = 0; n < 2; ++n) gv[bj][n] = *(const f32x4*)(gw + 32 * bj + 8 * fq + 4 * n) * (use8 ? SQK6 : 1.0f);
                const float sc = isQ ? C2 : 1.0f;
                const int pidx32 = ((fr | (fq << 4)) ^ 32) << 2, pidx16 = ((fr | (fq << 4)) ^ 16) << 2;
                const h16_t* tar = (const h16_t*)(ws + WS_TAR); const h16_t* tac = (const h16_t*)(ws + WS_TAC); const h16_t* tb = (const h16_t*)(ws + WS_TB);
                const int pitch6 = (pitch >> 6) * 48, hoff6 = (colbase >> 6) * 48;
                f32x4 ysv[4][2][2];
                extern __shared__ __attribute__((aligned(16))) unsigned char epi_lds_[];
                LAS unsigned char* stl = (LAS unsigned char*)epi_lds_ + pg8::STAGE_BYTES + (wr * 4 + wc) * 3072;
#pragma unroll
                for (int ai = 0; ai < 2; ++ai) {
#pragma unroll
                    for (int m = 0; m < 4; ++m) {
                        const int r = row0 + ai * 128 + m * 16, t = r & (SEQ - 1);
                        float ss = 0.f;
#pragma unroll
                        for (int bj = 0; bj < 2; ++bj)
#pragma unroll
                            for (int n = 0; n < 2; ++n) { const f32x4 v = acc[ai][bj][m][n]; ss += (v[0] * v[0] + v[1] * v[1]) + (v[2] * v[2] + v[3] * v[3]); }
                        ss = xsum16(ss); ss = xsum32(ss);
                        const float rs = __builtin_amdgcn_rsqf(ss * (wsc * wsc * (1.0f / 64.0f)) + EPS) * wsc;
                        f32x4 y[2][2];
#pragma unroll
                        for (int bj = 0; bj < 2; ++bj)
#pragma unroll
                            for (int n = 0; n < 2; ++n) y[bj][n] = acc[ai][bj][m][n] * rs * gv[bj][n];
                        if (isA) {
#pragma unroll
                            for (int bj = 0; bj < 2; ++bj) {
                                const int pos = bj == 0 ? (t >> 6) : (t & 63);
                                const h16_t* tp = (bj == 0 ? tar : tac) + pos * 32 + 8 * (fq & 1);
                                const u32x4 cw = *(const u32x4*)tp, sw = *(const u32x4*)(tp + 16);
                                const float sgn = fq < 2 ? -1.0f : 1.0f;
#pragma unroll
                                for (int n = 0; n < 2; ++n)
#pragma unroll
                                    for (int i = 0; i < 4; ++i) {
                                        const int e = 4 * n + i; const unsigned cwe = cw[e >> 1], swe = sw[e >> 1];
                                        const float cs = h2f((unsigned short)((e & 1) ? (cwe >> 16) : (cwe & 0xffffu))), sn = h2f((unsigned short)((e & 1) ? (swe >> 16) : (swe & 0xffffu)));
                                        const float yv = y[bj][n][i], pv = __uint_as_float((unsigned)__builtin_amdgcn_ds_bpermute(pidx32, (int)__float_as_uint(yv)));
                                        y[bj][n][i] = yv * cs + sgn * pv * sn;
                                    }
                            }
                        } else {
                            const h16_t* tp = tb + t * 16;
                            const u32x4 cw = *(const u32x4*)tp, sw = *(const u32x4*)(tp + 8);
                            const float sgn = fq == 0 ? -1.0f : 1.0f;
#pragma unroll
                            for (int n = 0; n < 2; ++n)
#pragma unroll
                                for (int i = 0; i < 4; ++i) {
                                    const int e = 4 * n + i; const unsigned cwe = cw[e >> 1], swe = sw[e >> 1];
                                    const float cs = h2f((unsigned short)((e & 1) ? (cwe >> 16) : (cwe & 0xffffu))), sn = h2f((unsigned short)((e & 1) ? (swe >> 16) : (swe & 0xffffu)));
                                    const float yv = y[0][n][i], pv = __uint_as_float((unsigned)__builtin_amdgcn_ds_bpermute(pidx16, (int)__float_as_uint(yv)));
                                    y[0][n][i] = fq < 2 ? (yv * cs + sgn * pv * sn) : yv;
                                }
                        }
#pragma unroll
                        for (int bj = 0; bj < 2; ++bj) {
                            if (use8) { ysv[m][bj][0] = y[bj][0]; ysv[m][bj][1] = y[bj][1];
                            } else {
                            u32x4 w; w.x = pk2h(y[bj][0][0] * sc, y[bj][0][1] * sc); w.y = pk2h(y[bj][0][2] * sc, y[bj][0][3] * sc); w.z = pk2h(y[bj][1][0] * sc, y[bj][1][1] * sc); w.w = pk2h(y[bj][1][2] * sc, y[bj][1][3] * sc);
                            *(u32x4*)(dst + (size_t)r * pitch + colbase + 32 * bj + 8 * fq) = w; }
                        }
                    }
                    if (use8) {
#pragma unroll
                        for (int bj = 0; bj < 2; ++bj) {
                            f32x16 s0, s1;
#pragma unroll
                            for (int i = 0; i < 16; ++i) { const int m_ = i >> 2, c0 = 2 * (i & 3); s0[i] = ysv[m_][bj][c0 >> 2][c0 & 3]; s1[i] = ysv[m_][bj][(c0 + 1) >> 2][(c0 + 1) & 3]; }
                            const i32x6 d6 = __builtin_amdgcn_cvt_scalef32_2xpk16_fp6_f32(s0, s1, 1.0f);
                            const int dwoff = fq == 0 ? 16 * bj : (fq == 1 ? 16 * bj + 8 : (fq == 2 ? 16 * bj + 12 : 36 + 8 * bj));
                            const int shoff = fq == 0 ? 16 * bj + 4 : (fq == 1 ? 16 * bj + 6 : (fq == 2 ? 32 + 8 * bj : 34 + 8 * bj));
#pragma unroll
                            for (int m = 0; m < 4; ++m) {
                                const unsigned a0 = (unsigned)d6[3 * (m >> 1)], a1 = (unsigned)d6[3 * (m >> 1) + 1], a2 = (unsigned)d6[3 * (m >> 1) + 2];
                                const unsigned lo = (m & 1) ? ((a1 >> 16) | (a2 << 16)) : a0, hi16 = (m & 1) ? (a2 >> 16) : (a1 & 0xffffu);
                                const unsigned dwv = (fq & 1) ? ((lo >> 16) | (hi16 << 16)) : lo, shv = (fq & 1) ? (lo & 0xffffu) : hi16;
                                LAS unsigned char* p6 = stl + (m * 16 + fr) * 48;
                                *(LAS unsigned*)(p6 + dwoff) = dwv; *(LAS unsigned short*)(p6 + shoff) = (unsigned short)shv;
                            }
                        }
                        asm volatile("s_waitcnt lgkmcnt(0)" ::: "memory");
                        {   const int lrow = fr + 16 * fq;
                            unsigned char* g6 = (unsigned char*)dst + (size_t)(u.pm * 256 + wr * 64 + ai * 128 + lrow) * pitch6 + hoff6;
#pragma unroll
                            for (int j = 0; j < 3; ++j) { const u32x4 v = *(const LAS u32x4*)(stl + lrow * 48 + 16 * j); *(u32x4*)(g6 + 16 * j) = v; }
                        }
                        asm volatile("s_waitcnt lgkmcnt(0)" ::: "memory");
                    }
                }
            } else if (use8) {
                unsigned char* vt; int drow0;
                if (T == 2) { vt = ws + WS_VTA; drow0 = (wc - 2) * 64; } else { vt = ws + WS_VTB; drow0 = (2 * (T - 9) + (wc >> 1)) * 128 + (wc & 1) * 64; }
                const int rows_per_b = (T == 2) ? 128 : 512;
                extern __shared__ __attribute__((aligned(16))) unsigned char epi_lds_[];
                LAS unsigned char* stl = (LAS unsigned char*)epi_lds_ + pg8::STAGE_BYTES + (wr * 4 + wc) * 3072;
#pragma unroll
                for (int ai = 0; ai < 2; ++ai) {
                    const int rt = u.pm * 256 + wr * 64 + ai * 128, b = rt >> 13, tk0 = rt & (SEQ - 1);
#pragma unroll
                    for (int bj = 0; bj < 2; ++bj) {
#pragma unroll
                        for (int m = 0; m < 4; ++m) {
                            const int tau = 16 * m + fr;
                            const int pos = 32 * ((tau >> 2) & 1) + 16 * (tau >> 5) + 4 * ((tau >> 3) & 3) + (tau & 3);
#pragma unroll
                            for (int n = 0; n < 2; ++n) { const f32x4 v = acc[ai][bj][m][n];
                                int w0 = 0; w0 = __builtin_amdgcn_cvt_pk_fp8_f32(v[0], v[1], w0, false); w0 = __builtin_amdgcn_cvt_pk_fp8_f32(v[2], v[3], w0, true);
#pragma unroll
                                for (int i = 0; i < 4; ++i) stl[(8 * fq + 4 * n + i) * 64 + pos] = (unsigned char)((unsigned)w0 >> (8 * i)); }
                        }
                        asm volatile("s_waitcnt lgkmcnt(0)" ::: "memory");
                        const int ln_ = fr + 16 * fq;
#pragma unroll
                        for (int j = 0; j < 2; ++j) { const int id = ln_ + 64 * j, dl = id >> 2, c16 = id & 3;
                            const u32x4 v = *(const LAS u32x4*)(stl + dl * 64 + 16 * c16);
                            *(u32x4*)(vt + ((size_t)(b * rows_per_b + drow0 + 32 * bj + dl)) * SEQ + tk0 + 16 * c16) = v; }
                        asm volatile("s_waitcnt lgkmcnt(0)" ::: "memory");
                    }
                }
            } else {
                h16_t* dst; int pitch, colbase;
                if (T == 2) { dst = (h16_t*)(ws + WS_VA); pitch = 128; colbase = 64 * (wc - 2); }
                else { dst = (h16_t*)(ws + WS_VB); pitch = 512; colbase = 256 * (T - 9) + 64 * wc; }
#pragma unroll
                for (int ai = 0; ai < 2; ++ai)
#pragma unroll
                    for (int m = 0; m < 4; ++m) {
                        const int r = row0 + ai * 128 + m * 16;
#pragma unroll
                        for (int bj = 0; bj < 2; ++bj) {
                            const f32x4 v0 = acc[ai][bj][m][0], v1 = acc[ai][bj][m][1];
                            u32x4 w; w.x = pk2h(v0[0], v0[1]); w.y = pk2h(v0[2], v0[3]); w.z = pk2h(v1[0], v1[1]); w.w = pk2h(v1[2], v1[3]);
                            *(u32x4*)(dst + (size_t)r * pitch + colbase + 32 * bj + 8 * fq) = w;
                        }
                    }
            }
        } else {
            if (T <= 12) {
                h16_t* oab = (h16_t*)(ws + WS_OAB);
                const int colt = (T >= 11 ? 512 + 256 * (T - 11) : 256 * (T - 3)) + 64 * wc;
#pragma unroll
                for (int aim = 0; aim < 4; ++aim) { const int ai = aim >> 1, m0 = (aim & 1) * 2;
                    u32x4 ovs[2][4][2];
#pragma unroll
                    for (int m = m0; m < m0 + 2; ++m)
#pragma unroll
                        for (int bj = 0; bj < 2; ++bj) ovs[ai][m][bj] = *(const u32x4*)(oab + (size_t)(row0 + ai * 128 + m * 16) * 1024 + colt + 16 * fq + 8 * bj);
                    __builtin_amdgcn_sched_barrier(0);
#pragma unroll
                    for (int m = m0; m < m0 + 2; ++m) {
                        const int r = row0 + ai * 128 + m * 16;
#pragma unroll
                        for (int bj = 0; bj < 2; ++bj) {
                            h16_t* p = oab + (size_t)r * 1024 + colt + 16 * fq + 8 * bj;
                            const u32x4 ov = ovs[ai][m][bj];
                            float o[8];
#pragma unroll
                            for (int e = 0; e < 4; ++e) { o[2 * e] = h2f((unsigned short)(ov[e] & 0xffffu)); o[2 * e + 1] = h2f((unsigned short)(ov[e] >> 16)); }
                            float q[8];
#pragma unroll
                            for (int n = 0; n < 2; ++n)
#pragma unroll
                                for (int i = 0; i < 4; ++i) q[4 * n + i] = o[4 * n + i] * silu_f(acc[ai][bj][m][n][i]);
                            u32x4 w; w.x = pk2h(q[0], q[1]); w.y = pk2h(q[2], q[3]); w.z = pk2h(q[4], q[5]); w.w = pk2h(q[6], q[7]);
                            *(u32x4*)p = w;
                        }
                    }
                    __builtin_amdgcn_sched_barrier(0);
                }
            } else {
                unsigned char* dst = ws + (T <= 16 ? WS_SGA : WS_SGB);
                const int colt = 256 * (T <= 16 ? T - 13 : T - 17) + 64 * wc;
#pragma unroll
                for (int ai = 0; ai < 2; ++ai)
#pragma unroll
                    for (int m = 0; m < 4; ++m) {
                        const int r = row0 + ai * 128 + m * 16;
                        u32x4 w;
#pragma unroll
                        for (int bj = 0; bj < 2; ++bj) {
                            const f32x4 v0 = acc[ai][bj][m][0], v1 = acc[ai][bj][m][1];
                            unsigned w0 = 0u, w1 = 0u;
#pragma unroll
                            for (int i = 0; i < 4; ++i) {
                                w0 = __builtin_amdgcn_cvt_pk_u8_f32(__builtin_amdgcn_rcpf(__builtin_fmaf(__builtin_amdgcn_exp2f(v0[i] * wsc), 1.0f / 255.0f, 1.0f / 255.0f)), i, w0);
                                w1 = __builtin_amdgcn_cvt_pk_u8_f32(__builtin_amdgcn_rcpf(__builtin_fmaf(__builtin_amdgcn_exp2f(v1[i] * wsc), 1.0f / 255.0f, 1.0f / 255.0f)), i, w1); }
                            w[2 * bj] = w0; w[2 * bj + 1] = w1;
                        }
                        *(u32x4*)(dst + (size_t)r * 1024 + colt + 16 * fq) = w;
                    }
            }
        }
    }
};
struct EpiMerge {
    static constexpr bool PERM = true;
    const unsigned char* SGA; const unsigned char* SGB; h16_t* MG;
    __device__ __forceinline__ void operator()(const f32x4 (&acc)[2][2][4][2], const pg8::Unit& u, int wr, int wc, int fr, int fq) const {
        asm volatile("" : "+v"(fr), "+v"(fq));
        const int row0 = u.pm * 256 + wr * 64 + fr, col0 = u.pn * 128 + wc * 32 + 8 * fq;
#pragma unroll
        for (int ai = 0; ai < 2; ++ai) {
            u32x2 gas[2][4], gbs[2][4];
#pragma unroll
            for (int m = 0; m < 4; ++m) { const size_t off = (size_t)(row0 + ai * 128 + m * 16) * 1024 + col0; gas[ai][m] = *(const u32x2*)(SGA + off); gbs[ai][m] = *(const u32x2*)(SGB + off); }
            __builtin_amdgcn_sched_barrier(0);
#pragma unroll
            for (int m = 0; m < 4; ++m) {
                const size_t off = (size_t)(row0 + ai * 128 + m * 16) * 1024 + col0;
                const u32x2 ga = gas[ai][m], gb = gbs[ai][m];
                float q[8];
#pragma unroll
                for (int e = 0; e < 8; ++e) {
                    const float a = (float)((ga[e >> 2] >> (8 * (e & 3))) & 0xffu), b = (float)((gb[e >> 2] >> (8 * (e & 3))) & 0xffu);
                    q[e] = (a * acc[ai][0][m][e >> 2][e & 3] + b * acc[ai][1][m][e >> 2][e & 3]) * (1.0f / 255.0f);
                }
                u32x4 w; w.x = pk2h(q[0], q[1]); w.y = pk2h(q[2], q[3]); w.z = pk2h(q[4], q[5]); w.w = pk2h(q[6], q[7]);
                *(u32x4*)(MG + off) = w;
            }
            __builtin_amdgcn_sched_barrier(0);
        }
    }
};
struct EpiOut {
    static constexpr bool PERM = false;
    const float* xp; long xs_delta; const float* gate; float* out;
    __device__ __forceinline__ void operator()(const f32x4 (&acc)[2][2][4][2], const pg8::Unit& u, int wr, int wc, int fr, int fq) const {
        asm volatile("" : "+v"(fr), "+v"(fq));
        const int row0 = u.pm * 256 + wr * 64 + fr, col0 = u.pn * 256 + wc * 32 + 4 * fq;
        const float* grow = gate + ((u.pm * 256) >> 13) * DM;
        f32x4 gvs[2][2];
#pragma unroll
        for (int bj = 0; bj < 2; ++bj)
#pragma unroll
            for (int n = 0; n < 2; ++n) gvs[bj][n] = *(const f32x4*)(grow + col0 + bj * 128 + n * 16);
#pragma unroll
        for (int aim = 0; aim < 4; ++aim) { const int ai = aim >> 1, m0 = (aim & 1) * 2;
            f32x4 xvs[4][2][2];
#pragma unroll
            for (int m = m0; m < m0 + 2; ++m) {
                const int r = row0 + ai * 128 + m * 16;
                const float* xrow = (const float*)((const char*)(xp + (size_t)r * DM) + (r >= TOKP ? xs_delta : 0l));
#pragma unroll
                for (int bj = 0; bj < 2; ++bj)
#pragma unroll
                    for (int n = 0; n < 2; ++n) xvs[m][bj][n] = *(const f32x4*)(xrow + col0 + bj * 128 + n * 16);
            }
            __builtin_amdgcn_sched_barrier(0);
#pragma unroll
            for (int m = m0; m < m0 + 2; ++m) {
                const int r = row0 + ai * 128 + m * 16;
#pragma unroll
                for (int bj = 0; bj < 2; ++bj)
#pragma unroll
                    for (int n = 0; n < 2; ++n) {
                        const int c = col0 + bj * 128 + n * 16;
                        *(f32x4*)(out + (size_t)r * DM + c) = xvs[m][bj][n] + gvs[bj][n] * acc[ai][bj][m][n];
                    }
            }
            __builtin_amdgcn_sched_barrier(0);
        }
    }
};

namespace att {
constexpr int NW = 8, QBLK = 32, QB = QBLK * NW, KVBLK = 64, NT = SEQ / KVBLK;
constexpr int NSLOT = 3, SLOTB = 8192;
constexpr int LDS_K = 0, LDS_V = NSLOT * SLOTB, LDS_WS = LDS_V + NSLOT * 2 * SLOTB, LDS_OST = LDS_WS + NW * 64 * 4, OST_WAVE = 8192, LDS_BYTES = LDS_OST + NW * OST_WAVE;
__device__ __forceinline__ int crow(int r, int hi) { return (r & 3) + 8 * (r >> 2) + 4 * hi; }
#define SBAR() __builtin_amdgcn_sched_barrier(0)
__device__ __forceinline__ void glds16(const void* gsrc, unsigned lds_dst) { unsigned keep;
    asm volatile("s_mov_b32 %0, m0\n\ts_mov_b32 m0, %2\n\ts_nop 0\n\tglobal_load_lds_dwordx4 %1, off\n\ts_mov_b32 m0, %0" : "=&s"(keep) : "v"(gsrc), "s"(lds_dst) : "memory"); }
__device__ __forceinline__ float max3f(float a, float b, float c) { float r; asm("v_max3_f32 %0, %1, %2, %3" : "=v"(r) : "v"(a), "v"(b), "v"(c)); return r; }
__device__ __forceinline__ float max2f(float a, float b) { float r; asm("v_max_f32_e32 %0, %1, %2" : "=v"(r) : "v"(a), "v"(b)); return r; }
__device__ __forceinline__ float fadd_s(float a, float b) { float r; asm("v_add_f32_e32 %0, %1, %2" : "=v"(r) : "v"(a), "v"(b)); return r; }
__device__ __forceinline__ float fsub_s(float a, float b) { float r; asm("v_sub_f32_e32 %0, %1, %2" : "=v"(r) : "v"(a), "v"(b)); return r; }
#define WAIT_BAR(N) asm volatile("s_waitcnt vmcnt(" #N ") lgkmcnt(0)\n\ts_barrier" ::: "memory")
__device__ __forceinline__ void qkt(f32x16& p0, f32x16& p1, const char* Kslot, const f16x8* qr, const f32x16& negm, int r32, int hi) {
    const char* kb = Kslot + hi * 1024 + r32 * 16;
#pragma unroll
    for (int d0 = 0; d0 < 4; ++d0) {
        const f16x8 b0 = *reinterpret_cast<const f16x8*>(kb + d0 * 2048);
        const f16x8 b1 = *reinterpret_cast<const f16x8*>(kb + d0 * 2048 + 512);
        if (d0 == 0) { p0 = MFMA32(b0, qr[0], negm); p1 = MFMA32(b1, qr[0], negm); }
        else { p0 = MFMA32(b0, qr[d0], p0); p1 = MFMA32(b1, qr[d0], p1); } }
}
typedef LAS const char* lds_cptr;
typedef short v4i16_t __attribute__((ext_vector_type(4)));
__device__ __forceinline__ void kload8(f16x8* kf, lds_cptr kp) {
    kf[0] = *(const LAS f16x8*)(kp);        kf[1] = *(const LAS f16x8*)(kp + 512);
    kf[2] = *(const LAS f16x8*)(kp + 2048); kf[3] = *(const LAS f16x8*)(kp + 2560);
    kf[4] = *(const LAS f16x8*)(kp + 4096); kf[5] = *(const LAS f16x8*)(kp + 4608);
    kf[6] = *(const LAS f16x8*)(kp + 6144); kf[7] = *(const LAS f16x8*)(kp + 6656);
}
__device__ __forceinline__ void kload2(f16x8* kf, lds_cptr kp, int j) { kf[2 * j] = *(const LAS f16x8*)(kp + j * 2048); kf[2 * j + 1] = *(const LAS f16x8*)(kp + j * 2048 + 512); }
__device__ __forceinline__ s16x4 vtr(lds_cptr p) { return __builtin_bit_cast(s16x4, __builtin_amdgcn_ds_read_tr16_b64_v4i16((LAS v4i16_t*)p)); }
__device__ __forceinline__ float rowmax(const f32x16& p0, const f32x16& p1) {
    float a = max3f(p0[0], p0[1], p1[0]), b = max3f(p0[2], p0[3], p1[1]); a = max3f(a, p1[2], p1[3]);
#pragma unroll
    for (int r = 4; r < 16; r += 4) { a = max3f(a, p0[r], p0[r + 1]); b = max3f(b, p0[r + 2], p0[r + 3]); a = max3f(a, p1[r], p1[r + 1]); b = max3f(b, p1[r + 2], p1[r + 3]); }
    const float m = max2f(a, b);
    auto rr = __builtin_amdgcn_permlane32_swap(__float_as_uint(m), __float_as_uint(m), false, false);
    return max2f(__uint_as_float(rr[0]), __uint_as_float(rr[1]));
}
__device__ __forceinline__ f16x8 mk8(s16x4 lo, s16x4 hi) { typedef short s16x8 __attribute__((ext_vector_type(8))); s16x8 v = {lo[0], lo[1], lo[2], lo[3], hi[0], hi[1], hi[2], hi[3]}; return __builtin_bit_cast(f16x8, v); }
__device__ __forceinline__ void pv(f32x16* o, int vb, f16x8 pa0, f16x8 pa1, f16x8 pa2, f16x8 pa3) {
#pragma unroll
    for (int d0 = 0; d0 < 2; ++d0) { s16x4 lo[4], hi[4];
#pragma unroll
        for (int ks = 0; ks < 4; ++ks) {
            asm volatile("ds_read_b64_tr_b16 %0,%1 offset:%c2" : "=&v"(lo[ks]) : "v"(vb), "i"(d0 * 4096 + ks * 1024) : "memory");
            asm volatile("ds_read_b64_tr_b16 %0,%1 offset:%c2" : "=&v"(hi[ks]) : "v"(vb), "i"(d0 * 4096 + ks * 1024 + 512) : "memory"); }
        asm volatile("s_waitcnt lgkmcnt(0)" ::: "memory"); SBAR();
        o[d0] = MFMA32(pa0, mk8(lo[0], hi[0]), o[d0]);
        o[d0] = MFMA32(pa1, mk8(lo[1], hi[1]), o[d0]);
        o[d0] = MFMA32(pa2, mk8(lo[2], hi[2]), o[d0]);
        o[d0] = MFMA32(pa3, mk8(lo[3], hi[3]), o[d0]);
    }
}
template <int THRL, bool FAST> __device__ __forceinline__ void attn_pass(const h16_t* Qw, int QP, const h16_t* Kh, int KP, const h16_t* Vh, int VP, char* shm, f32x16 (&o)[2], float& l_out, int wave_in) {
    int tid = wave_in * 64 + lane_id(); asm volatile("" : "+v"(tid));
    const int lane = tid & 63, r32 = lane & 31, hi = lane >> 5; const int wid = wave_in;
    const unsigned lds0 = (unsigned)(uintptr_t)shm;
    float* wsf = (float*)(shm + LDS_WS) + wid * 64;
    const h16_t* ksrc = Kh + (long)lane * KP + wid * 8;
    const h16_t* vsrc = Vh + (long)(16 * (wid & 3) + (lane >> 2)) * VP + (wid >> 2) * 32 + (lane & 3) * 8;
    const unsigned kdst = lds0 + LDS_K + wid * 1024, vdst = lds0 + LDS_V + wid * 1024;
#define DMA_K(t, slot) glds16(ksrc + (long)(t) * KVBLK * KP, (unsigned)__builtin_amdgcn_readfirstlane(kdst + (slot)))
#define DMA_V(t, slot) glds16(vsrc + (long)(t) * KVBLK * VP, (unsigned)__builtin_amdgcn_readfirstlane(vdst + (slot)))
    const int vb0 = (int)(lds0 + LDS_V) + ((lane >> 4) & 1) * 32 + (lane & 3) * 8 + (4 * hi + ((lane & 15) >> 2)) * 64;
    const char* Kbase = shm + LDS_K; f16x8 kf[8];
    const lds_cptr shm3 = (lds_cptr)shm; const lds_cptr kp0 = shm3 + LDS_K + hi * 1024 + r32 * 16; const lds_cptr vp0 = shm3 + LDS_V + ((lane >> 4) & 1) * 32 + (lane & 3) * 8 + (4 * hi + ((lane & 15) >> 2)) * 64;
    DMA_K(0, 0); DMA_V(0, 0); DMA_K(1, SLOTB);
    f16x8 qr[4];
#pragma unroll
    for (int d0 = 0; d0 < 4; ++d0) qr[d0] = *reinterpret_cast<const f16x8*>(&Qw[(long)r32 * QP + d0 * 16 + hi * 8]);
    float mhat = 0.f, l_reg = 0.f; o[0] = f32x16{}; o[1] = f32x16{}; f32x16 negm = f32x16{}; if constexpr (!FAST) asm volatile("" : "+v"(negm));
    bool resc = false;
#define NEGM (FAST ? f32x16{} : negm)
#define START(P0, P1) do { if constexpr (!FAST) { const float rm = rowmax(P0, P1); resc = false; \
    { const float dl = rm; mhat = fadd_s(mhat, dl); \
      _Pragma("unroll") for (int r = 0; r < 16; ++r) { P0[r] = fsub_s(P0[r], dl); P1[r] = fsub_s(P1[r], dl); } \
      _Pragma("unroll") for (int r = 0; r < 16; ++r) negm[r] = -mhat; asm volatile("" : "+v"(negm)); } } \
    _Pragma("unroll") for (int r = 0; r < 16; ++r) P0[r] = __builtin_amdgcn_exp2f(P0[r]); } while (0)
#define RESC() do { if constexpr (!FAST) { if (resc) { asm volatile("s_waitcnt lgkmcnt(0)" ::: "memory"); \
      _Pragma("unroll") for (int d_ = 0; d_ < 2; ++d_) _Pragma("unroll") for (int r = 0; r < 16; ++r) o[d_][r] *= wsf[crow(r, hi)]; } } } while (0)
    f32x16 pA0, pA1, pB0, pB1;
    int sl_prev = 0, sl_cur = 0, sl_next = SLOTB;
#define ROT() do { sl_prev = sl_cur; sl_cur = sl_next; sl_next = (sl_next == (NSLOT - 1) * SLOTB) ? 0 : sl_next + SLOTB; } while (0)
    DMA_K(2, 2 * SLOTB);
    WAIT_BAR(3);
    qkt(pA0, pA1, Kbase, qr, NEGM, r32, hi); asm volatile("s_nop 15\n\ts_nop 7" : "+v"(pA0), "+v"(pA1));
    START(pA0, pA1);
    _Pragma("unroll") for (int r = 0; r < 16; ++r) pA1[r] = __builtin_amdgcn_exp2f(pA1[r]);
    WAIT_BAR(0);
    DMA_K(3, 0); DMA_V(1, SLOTB);
    ROT();
    kload8(kf, kp0 + sl_cur);
    WAIT_BAR(2);
    s16x4 vlo[8], vhi[8]; u32x4 pw0, pw1, pw2, pw3;
#define PKW(P, B) pk2h(P[B], P[B + 1])
#define PAF(k) __builtin_bit_cast(f16x8, pw##k)
#define VFR(i) mk8(vlo[i], vhi[i])
#define PIN(x) asm volatile("" : "+v"(x))
#define MX3(a, b, c) __builtin_fmaxf(__builtin_fmaxf((a), (b)), (c))
#define GAPA(MF, A0, A1, A2, A3, W0, W1, PW) do { MF; sacc += A0; sacc += A1; sacc += A2; sacc += A3; PIN(sacc); W0; W1; PIN(PW); SBAR(); } while (0)
#define EX(v) __builtin_amdgcn_exp2f(v)
#define GAPB(MF, X, B) do { MF; X[B] = EX(X[B]); X[B + 1] = EX(X[B + 1]); X[B + 2] = EX(X[B + 2]); X[B + 3] = EX(X[B + 3]); PIN(X); SBAR(); } while (0)
#define VRD(i) do { vlo[i] = vtr(vp_ + (((i) >> 2) * 4096 + ((i) & 3) * 1024)); vhi[i] = vtr(vp_ + (((i) >> 2) * 4096 + ((i) & 3) * 1024 + 512)); } while (0)
#define KRD(G, j) do { if (G) { kload2(kf, kp0 + sl_next, j); SBAR(); } } while (0)
#define STEP(C0, C1, P0, P1, t, GK, GV, GL) do { SBAR(); \
    const lds_cptr vp_ = vp0 + sl_prev; \
    if constexpr (FAST) { if (GK) { DMA_K((t) + 3, sl_cur); } } \
    VRD(0); SBAR(); float sacc = (P0[0] + P0[1]); \
    GAPA(C0 = MFMA32(kf[0], qr[0], NEGM), P0[2], P0[3], P0[4], P0[5],     pw0[0] = PKW(P0, 0), pw0[1] = PKW(P0, 2), pw0); \
    if constexpr (FAST) { if (GV) { DMA_V((t) + 1, sl_next); } } \
    VRD(4); SBAR(); GAPA(C1 = MFMA32(kf[1], qr[0], NEGM), P0[6], P0[7], P0[8], P0[9],     pw0[2] = PKW(P0, 4), pw0[3] = PKW(P0, 6), pw0); \
    VRD(1); SBAR(); GAPA(C0 = MFMA32(kf[2], qr[1], C0),   P0[10], P0[11], P0[12], P0[13], pw1[0] = PKW(P0, 8), pw1[1] = PKW(P0, 10), pw1); \
    VRD(5); SBAR(); GAPA(C1 = MFMA32(kf[3], qr[1], C1),   P0[14], P0[15], P1[0], P1[1],   pw1[2] = PKW(P0, 12), pw1[3] = PKW(P0, 14), pw1); \
    VRD(2); SBAR(); GAPA(C0 = MFMA32(kf[4], qr[2], C0),   P1[2], P1[3], P1[4], P1[5],     pw2[0] = PKW(P1, 0), pw2[1] = PKW(P1, 2), pw2); \
    VRD(6); SBAR(); GAPA(C1 = MFMA32(kf[5], qr[2], C1),   P1[6], P1[7], P1[8], P1[9],     pw2[2] = PKW(P1, 4), pw2[3] = PKW(P1, 6), pw2); \
    VRD(3); SBAR(); GAPA(C0 = MFMA32(kf[6], qr[3], C0),   P1[10], P1[11], P1[12], P1[13], pw3[0] = PKW(P1, 8), pw3[1] = PKW(P1, 10), pw3); \
    VRD(7); SBAR(); GAPA(C1 = MFMA32(kf[7], qr[3], C1),   P1[14], P1[15], 0.f, 0.f,       pw3[2] = PKW(P1, 12), pw3[3] = PKW(P1, 14), pw3); \
    l_reg += sacc; \
    if constexpr (!FAST) { \
    if (GK) { DMA_K((t) + 3, sl_cur); } if (GV) { DMA_V((t) + 1, sl_next); } \
    { float a = MX3(C0[0], C0[1], C1[0]), b = MX3(C0[2], C0[3], C1[1]); a = MX3(a, C1[2], C1[3]); \
      _Pragma("unroll") for (int r = 4; r < 16; r += 4) { a = MX3(a, C0[r], C0[r + 1]); b = MX3(b, C0[r + 2], C0[r + 3]); a = MX3(a, C1[r], C1[r + 1]); b = MX3(b, C1[r + 2], C1[r + 3]); } \
      float rm = __builtin_fmaxf(a, b); { auto rr = __builtin_amdgcn_permlane32_swap(__float_as_uint(rm), __float_as_uint(rm), false, false); rm = __builtin_fmaxf(__uint_as_float(rr[0]), __uint_as_float(rr[1])); } \
      resc = false; \
      if (__builtin_expect(__any(rm > (float)THRL), 0)) { const float dl = __builtin_fmaxf(rm, 0.f); mhat += dl; \
        _Pragma("unroll") for (int r = 0; r < 16; ++r) { C0[r] -= dl; C1[r] -= dl; } \
        _Pragma("unroll") for (int r = 0; r < 16; ++r) negm[r] = -mhat; asm volatile("" : "+v"(negm)); \
        const float f = __builtin_amdgcn_exp2f(-dl); l_reg *= f; if (hi == 0) wsf[r32] = f; resc = true; } } } \
    SBAR(); \
    GAPB(o[0] = MFMA32(PAF(0), VFR(0), o[0]), C0, 0); \
    GAPB(o[1] = MFMA32(PAF(0), VFR(4), o[1]), C0, 4); \
    KRD(GL, 0); GAPB(o[0] = MFMA32(PAF(1), VFR(1), o[0]), C0, 8); \
    KRD(GL, 1); GAPB(o[1] = MFMA32(PAF(1), VFR(5), o[1]), C0, 12); \
    KRD(GL, 2); GAPB(o[0] = MFMA32(PAF(2), VFR(2), o[0]), C1, 0); \
    KRD(GL, 3); GAPB(o[1] = MFMA32(PAF(2), VFR(6), o[1]), C1, 4); \
    GAPB(o[0] = MFMA32(PAF(3), VFR(3), o[0]), C1, 8); \
    GAPB(o[1] = MFMA32(PAF(3), VFR(7), o[1]), C1, 12); \
    } while (0)
    int t = 1;
    for (; t + 5 < NT; t += 2) {
        STEP(pB0, pB1, pA0, pA1, t, true, true, true);     WAIT_BAR(2); RESC(); ROT();
        STEP(pA0, pA1, pB0, pB1, t + 1, true, true, true); WAIT_BAR(2); RESC(); ROT();
    }
#define ENDW(tt) do { if ((tt) + 3 < NT) { WAIT_BAR(2); } else if ((tt) + 2 < NT) { WAIT_BAR(1); } else { WAIT_BAR(0); } } while (0)
    for (; t + 1 < NT; t += 2) {
        STEP(pB0, pB1, pA0, pA1, t, (t + 3 < NT), (t + 1 < NT), (t + 1 < NT));         ENDW(t);     RESC(); ROT();
        STEP(pA0, pA1, pB0, pB1, t + 1, (t + 4 < NT), (t + 2 < NT), (t + 2 < NT));     ENDW(t + 1); RESC(); ROT();
    }
    STEP(pB0, pB1, pA0, pA1, NT - 1, false, false, false); RESC();
    { float sacc = pB0[0] + pB0[1]; _Pragma("unroll") for (int r = 2; r < 16; ++r) sacc += pB0[r]; _Pragma("unroll") for (int r = 0; r < 16; ++r) sacc += pB1[r]; l_reg += sacc;
      pw0 = (u32x4){PKW(pB0, 0), PKW(pB0, 2), PKW(pB0, 4), PKW(pB0, 6)}; pw1 = (u32x4){PKW(pB0, 8), PKW(pB0, 10), PKW(pB0, 12), PKW(pB0, 14)}; pw2 = (u32x4){PKW(pB1, 0), PKW(pB1, 2), PKW(pB1, 4), PKW(pB1, 6)}; pw3 = (u32x4){PKW(pB1, 8), PKW(pB1, 10), PKW(pB1, 12), PKW(pB1, 14)};
      SBAR(); pv(o, vb0 + sl_cur, PAF(0), PAF(1), PAF(2), PAF(3)); }
#undef PKW
#undef PAF
#undef VFR
#undef PIN
#undef MX3
#undef GAPA
#undef GAPB
#undef EX
#undef VRD
#undef KRD
#undef STEP
#undef ENDW
    { auto rr = __builtin_amdgcn_permlane32_swap(__float_as_uint(l_reg), __float_as_uint(l_reg), false, false); l_reg = __uint_as_float(rr[0]) + __uint_as_float(rr[1]); }
    l_out = l_reg;
    asm volatile("s_waitcnt lgkmcnt(0)\n\ts_barrier" ::: "memory");
#undef DMA_K
#undef DMA_V
#undef START
#undef NEGM
#undef RESC
#undef ROT
}

__device__ __forceinline__ void pv128(f32x16* o, int vb, f16x8 pa0, f16x8 pa1, f16x8 pa2, f16x8 pa3) {
#pragma unroll
    for (int d0 = 0; d0 < 4; ++d0) { s16x4 lo[4], hi[4];
#pragma unroll
        for (int ks = 0; ks < 4; ++ks) {
            asm volatile("ds_read_b64_tr_b16 %0,%1 offset:%c2" : "=&v"(lo[ks]) : "v"(vb), "i"(d0 * 4096 + ks * 1024) : "memory");
            asm volatile("ds_read_b64_tr_b16 %0,%1 offset:%c2" : "=&v"(hi[ks]) : "v"(vb), "i"(d0 * 4096 + ks * 1024 + 512) : "memory"); }
        asm volatile("s_waitcnt lgkmcnt(0)" ::: "memory"); SBAR();
        o[d0] = MFMA32(pa0, mk8(lo[0], hi[0]), o[d0]);
        o[d0] = MFMA32(pa1, mk8(lo[1], hi[1]), o[d0]);
        o[d0] = MFMA32(pa2, mk8(lo[2], hi[2]), o[d0]);
        o[d0] = MFMA32(pa3, mk8(lo[3], hi[3]), o[d0]);
    }
}
template <int THRL, bool FAST> __device__ __forceinline__ void attn_pass128(const h16_t* Qw, int QP, const h16_t* Kh, int KP, const h16_t* Vh, int VP, char* shm, f32x16 (&o)[4], float& l_out, int wave_in) {
    int tid = wave_in * 64 + lane_id(); asm volatile("" : "+v"(tid));
    const int lane = tid & 63, r32 = lane & 31, hi = lane >> 5; const int wid = wave_in;
    const unsigned lds0 = (unsigned)(uintptr_t)shm;
    float* wsf = (float*)(shm + LDS_WS) + wid * 64;
    const h16_t* ksrc = Kh + (long)lane * KP + wid * 8;
    const h16_t* vsrc = Vh + (long)(16 * (wid & 3) + (lane >> 2)) * VP + (wid >> 2) * 32 + (lane & 3) * 8;
    const unsigned kdst = lds0 + LDS_K + wid * 1024, vdst = lds0 + LDS_V + wid * 1024;
#define DMA_K(t, slot) glds16(ksrc + (long)(t) * KVBLK * KP, (unsigned)__builtin_amdgcn_readfirstlane(kdst + (slot)))
#define DMA_V(t, slot) do { glds16(vsrc + (long)(t) * KVBLK * VP, (unsigned)__builtin_amdgcn_readfirstlane(vdst + (slot))); glds16(vsrc + (long)(t) * KVBLK * VP + 64, (unsigned)__builtin_amdgcn_readfirstlane(vdst + (slot) + 8192)); } while (0)
    const int vb0 = (int)(lds0 + LDS_V) + ((lane >> 4) & 1) * 32 + (lane & 3) * 8 + (4 * hi + ((lane & 15) >> 2)) * 64;
    const char* Kbase = shm + LDS_K; f16x8 kf[8];
    const lds_cptr shm3 = (lds_cptr)shm; const lds_cptr kp0 = shm3 + LDS_K + hi * 1024 + r32 * 16; const lds_cptr vp0 = shm3 + LDS_V + ((lane >> 4) & 1) * 32 + (lane & 3) * 8 + (4 * hi + ((lane & 15) >> 2)) * 64;
    DMA_K(0, 0); DMA_V(0, 0); DMA_K(1, SLOTB);
    f16x8 qr[4];
#pragma unroll
    for (int d0 = 0; d0 < 4; ++d0) qr[d0] = *reinterpret_cast<const f16x8*>(&Qw[(long)r32 * QP + d0 * 16 + hi * 8]);
    float mhat = 0.f, l_reg = 0.f; o[0] = f32x16{}; o[1] = f32x16{}; o[2] = f32x16{}; o[3] = f32x16{}; f32x16 negm = f32x16{}; if constexpr (!FAST) asm volatile("" : "+v"(negm));
    bool resc = false;
#define NEGM (FAST ? f32x16{} : negm)
#define RESC() do { if constexpr (!FAST) if (resc) { asm volatile("s_waitcnt lgkmcnt(0)" ::: "memory"); \
      _Pragma("unroll") for (int d_ = 0; d_ < 4; ++d_) _Pragma("unroll") for (int r = 0; r < 16; ++r) o[d_][r] *= wsf[crow(r, hi)]; } } while (0)
    f32x16 C0, C1; u32x4 pA0, pA1, pA2, pA3, pB0, pB1, pB2, pB3;
    int sl_prev = 0, sl_cur = 0, sl_next = SLOTB;
#define ROT() do { sl_prev = sl_cur; sl_cur = sl_next; sl_next = (sl_next == (NSLOT - 1) * SLOTB) ? 0 : sl_next + SLOTB; } while (0)
    DMA_K(2, 2 * SLOTB);
    WAIT_BAR(3);
    qkt(C0, C1, Kbase, qr, NEGM, r32, hi); asm volatile("s_nop 15\n\ts_nop 7" : "+v"(C0), "+v"(C1));
    { float rm = 0.f; if constexpr (!FAST) { rm = rowmax(C0, C1); mhat = rm; }
      _Pragma("unroll") for (int r = 0; r < 16; ++r) { C0[r] = __builtin_amdgcn_exp2f(C0[r] - rm); C1[r] = __builtin_amdgcn_exp2f(C1[r] - rm); }
      if constexpr (!FAST) { _Pragma("unroll") for (int r = 0; r < 16; ++r) negm[r] = -mhat; asm volatile("" : "+v"(negm)); }
      float sacc = 0.f; _Pragma("unroll") for (int r = 0; r < 16; ++r) sacc += C0[r] + C1[r]; l_reg = sacc;
      pA0 = (u32x4){pk2h(C0[0], C0[1]), pk2h(C0[2], C0[3]), pk2h(C0[4], C0[5]), pk2h(C0[6], C0[7])}; pA1 = (u32x4){pk2h(C0[8], C0[9]), pk2h(C0[10], C0[11]), pk2h(C0[12], C0[13]), pk2h(C0[14], C0[15])};
      pA2 = (u32x4){pk2h(C1[0], C1[1]), pk2h(C1[2], C1[3]), pk2h(C1[4], C1[5]), pk2h(C1[6], C1[7])}; pA3 = (u32x4){pk2h(C1[8], C1[9]), pk2h(C1[10], C1[11]), pk2h(C1[12], C1[13]), pk2h(C1[14], C1[15])}; }
    WAIT_BAR(0);
    DMA_K(3, 0); DMA_V(1, 2 * SLOTB);
    ROT();
    kload8(kf, kp0 + sl_cur);
    WAIT_BAR(3);
    s16x4 vlo[16], vhi[16];
#define PAFW(w) __builtin_bit_cast(f16x8, w)
#define VFR(i) mk8(vlo[i], vhi[i])
#define PIN(x) asm volatile("" : "+v"(x))
#define MX3(a, b, c) __builtin_fmaxf(__builtin_fmaxf((a), (b)), (c))
#define EX(v) __builtin_amdgcn_exp2f(v)
#define VRD(i) do { vlo[i] = vtr(vp_ + (((i) >> 2) * 4096 + ((i) & 3) * 1024)); vhi[i] = vtr(vp_ + (((i) >> 2) * 4096 + ((i) & 3) * 1024 + 512)); } while (0)
#define KRD(G, j) do { if (G) { kload2(kf, kp0 + sl_next, j); } } while (0)
#define QK1(PRE, CC, KF, QR, CI) do { PRE; SBAR(); CC = MFMA32(KF, QR, CI); SBAR(); } while (0)
#define NOP_ do { } while (0)
#define GB0(PRE, OA, PW, FI, X, B) do { PRE; SBAR(); OA = MFMA32(PAFW(PW), VFR(FI), OA); X[B] = EX(X[B]); X[B + 1] = EX(X[B + 1]); PIN(X); SBAR(); } while (0)
#define GB(PRE, OA, PW, FI, X, B, Y, YB, PN, W) do { PRE; SBAR(); OA = MFMA32(PAFW(PW), VFR(FI), OA); X[B] = EX(X[B]); X[B + 1] = EX(X[B + 1]); PIN(X); \
    sacc += Y[YB]; sacc += Y[YB + 1]; PN[W] = pk2h(Y[YB], Y[YB + 1]); PIN(sacc); PIN(PN); SBAR(); } while (0)
#define STEP128(PC0, PC1, PC2, PC3, PN0, PN1, PN2, PN3, t, GK, GV, GL) do { SBAR(); \
    const lds_cptr vp_ = vp0 + 2 * sl_prev; \
    QK1(if constexpr (FAST) { if (GK) { DMA_K((t) + 3, sl_cur); } }, C0, kf[0], qr[0], NEGM); \
    QK1(if constexpr (FAST) { if (GV) { DMA_V((t) + 1, 2 * sl_next); } }, C1, kf[1], qr[0], NEGM); \
    QK1(NOP_,    C0, kf[2], qr[1], C0); \
    QK1(NOP_,    C1, kf[3], qr[1], C1); \
    QK1(VRD(0),  C0, kf[4], qr[2], C0); \
    QK1(VRD(4),  C1, kf[5], qr[2], C1); \
    QK1(VRD(8),  C0, kf[6], qr[3], C0); \
    QK1(VRD(12), C1, kf[7], qr[3], C1); \
    if constexpr (!FAST) { \
    if (GK) { DMA_K((t) + 3, sl_cur); } if (GV) { DMA_V((t) + 1, 2 * sl_next); } \
    { float a = MX3(C0[0], C0[1], C1[0]), b = MX3(C0[2], C0[3], C1[1]); a = MX3(a, C1[2], C1[3]); \
      _Pragma("unroll") for (int r = 4; r < 16; r += 4) { a = MX3(a, C0[r], C0[r + 1]); b = MX3(b, C0[r + 2], C0[r + 3]); a = MX3(a, C1[r], C1[r + 1]); b = MX3(b, C1[r + 2], C1[r + 3]); } \
      float rm = __builtin_fmaxf(a, b); { auto rr = __builtin_amdgcn_permlane32_swap(__float_as_uint(rm), __float_as_uint(rm), false, false); rm = __builtin_fmaxf(__uint_as_float(rr[0]), __uint_as_float(rr[1])); } \
      resc = false; \
      if (__builtin_expect(__any(rm > (float)THRL), 0)) { const float dl = __builtin_fmaxf(rm, 0.f); mhat += dl; \
        _Pragma("unroll") for (int r = 0; r < 16; ++r) { C0[r] -= dl; C1[r] -= dl; } \
        _Pragma("unroll") for (int r = 0; r < 16; ++r) negm[r] = -mhat; asm volatile("" : "+v"(negm)); \
        const float f = __builtin_amdgcn_exp2f(-dl); l_reg *= f; if (hi == 0) wsf[r32] = f; resc = true; } } } \
    SBAR(); float sacc = 0.f; \
    GB0(VRD(1),  o[0], PC0, 0,  C0, 0); \
    GB(VRD(5),   o[1], PC0, 4,  C0, 2,  C0, 0,  PN0, 0); \
    GB(VRD(9),   o[2], PC0, 8,  C0, 4,  C0, 2,  PN0, 1); \
    GB(VRD(13),  o[3], PC0, 12, C0, 6,  C0, 4,  PN0, 2); \
    GB(VRD(2),   o[0], PC1, 1,  C0, 8,  C0, 6,  PN0, 3); \
    GB(VRD(6),   o[1], PC1, 5,  C0, 10, C0, 8,  PN1, 0); \
    GB(VRD(10),  o[2], PC1, 9,  C0, 12, C0, 10, PN1, 1); \
    GB(VRD(14),  o[3], PC1, 13, C0, 14, C0, 12, PN1, 2); \
    GB(VRD(3),   o[0], PC2, 2,  C1, 0,  C0, 14, PN1, 3); \
    GB(VRD(7),   o[1], PC2, 6,  C1, 2,  C1, 0,  PN2, 0); \
    GB(VRD(11),  o[2], PC2, 10, C1, 4,  C1, 2,  PN2, 1); \
    GB(VRD(15),  o[3], PC2, 14, C1, 6,  C1, 4,  PN2, 2); \
    GB(KRD(GL, 0), o[0], PC3, 3,  C1, 8,  C1, 6,  PN2, 3); \
    GB(KRD(GL, 1), o[1], PC3, 7,  C1, 10, C1, 8,  PN3, 0); \
    GB(KRD(GL, 2), o[2], PC3, 11, C1, 12, C1, 10, PN3, 1); \
    GB(KRD(GL, 3), o[3], PC3, 15, C1, 14, C1, 12, PN3, 2); \
    sacc += C1[14]; sacc += C1[15]; PN3[3] = pk2h(C1[14], C1[15]); l_reg += sacc; \
    } while (0)
    int t = 1;
    for (; t + 5 < NT; t += 2) {
        STEP128(pA0, pA1, pA2, pA3, pB0, pB1, pB2, pB3, t, true, true, true);     WAIT_BAR(3); RESC(); ROT();
        STEP128(pB0, pB1, pB2, pB3, pA0, pA1, pA2, pA3, t + 1, true, true, true); WAIT_BAR(3); RESC(); ROT();
    }
#define ENDW(tt) do { if ((tt) + 3 < NT) { WAIT_BAR(3); } else if ((tt) + 2 < NT) { WAIT_BAR(2); } else { WAIT_BAR(0); } } while (0)
    for (; t + 1 < NT; t += 2) {
        STEP128(pA0, pA1, pA2, pA3, pB0, pB1, pB2, pB3, t, (t + 3 < NT), (t + 1 < NT), (t + 1 < NT));         ENDW(t);     RESC(); ROT();
        STEP128(pB0, pB1, pB2, pB3, pA0, pA1, pA2, pA3, t + 1, (t + 4 < NT), (t + 2 < NT), (t + 2 < NT));     ENDW(t + 1); RESC(); ROT();
    }
    STEP128(pA0, pA1, pA2, pA3, pB0, pB1, pB2, pB3, NT - 1, false, false, false); RESC();
    SBAR(); pv128(o, vb0 + 2 * sl_cur, PAFW(pB0), PAFW(pB1), PAFW(pB2), PAFW(pB3));
#undef PAFW
#undef VFR
#undef PIN
#undef MX3
#undef EX
#undef VRD
#undef KRD
#undef QK1
#undef NOP_
#undef GB0
#undef GB
#undef STEP128
#undef ENDW
    { auto rr = __builtin_amdgcn_permlane32_swap(__float_as_uint(l_reg), __float_as_uint(l_reg), false, false); l_reg = __uint_as_float(rr[0]) + __uint_as_float(rr[1]); }
    l_out = l_reg;
    asm volatile("s_waitcnt lgkmcnt(0)\n\ts_barrier" ::: "memory");
#undef DMA_K
#undef DMA_V
#undef NEGM
#undef RESC
#undef ROT
}

typedef int v8i __attribute__((ext_vector_type(8)));
#define MFMA8(a, b, c) __builtin_amdgcn_mfma_scale_f32_32x32x64_f8f6f4(a, b, c, 0, 0, 0, 0, 0, 0)
#define MFMA8S(a, b, c) __builtin_amdgcn_mfma_scale_f32_16x16x128_f8f6f4(a, b, c, 0, 0, 0, 0, 0, 0)
#define MFMA6(a, b, c) __builtin_amdgcn_mfma_scale_f32_32x32x64_f8f6f4(a, b, c, 2, 2, 0, sc6, 0, sc6)
__device__ __forceinline__ v8i ld24(lds_cptr p16, lds_cptr p8) { const u32x4 a = *(const LAS u32x4*)p16; const u32x2 b = *(const volatile LAS u32x2*)p8;     return (v8i){(int)a.x, (int)a.y, (int)a.z, (int)a.w, (int)b.x, (int)b.y, 0, 0}; }
__device__ __forceinline__ v8i ld32(lds_cptr p0, lds_cptr p1) { const u32x4 a = *(const LAS u32x4*)p0, b = *(const LAS u32x4*)p1; return (v8i){(int)a.x, (int)a.y, (int)a.z, (int)a.w, (int)b.x, (int)b.y, (int)b.z, (int)b.w}; }
template <int NV> __device__ __forceinline__ void attn_first_dma(const unsigned char* Kh8, int KP, const unsigned char* VT, char* shm, int wave_in) {
    int tid = wave_in * 64 + lane_id(); asm volatile("" : "+v"(tid));
    const int lane = tid & 63, wid = wave_in; const bool kw = wid < 4, kwk = wid < 3;
    const unsigned lds0 = (unsigned)(uintptr_t)shm; constexpr int VCH = NV * 512;
    const unsigned char* ksrc = Kh8 + (long)lane * KP + (wid & 3) * 16;
    const unsigned char* vsrc = VT + (long)(lane + ((kw && NV == 4) ? 64 : 0)) * SEQ + (wid & 3) * 16;
    const unsigned kdst = lds0 + LDS_K + (wid & 3) * 1024, vdst = lds0 + LDS_V + (wid & 3) * VCH + ((kw && NV == 4) ? 1024 : 0);
    if (kwk) glds16(ksrc, (unsigned)__builtin_amdgcn_readfirstlane(kdst));
    if (!kw || NV == 4) glds16(vsrc, (unsigned)__builtin_amdgcn_readfirstlane(vdst));
    if (kwk) { glds16(ksrc + (long)KVBLK * KP, (unsigned)__builtin_amdgcn_readfirstlane(kdst + SLOTB)); glds16(ksrc + (long)2 * KVBLK * KP, (unsigned)__builtin_amdgcn_readfirstlane(kdst + 2 * SLOTB)); }
}
template <int NV> __device__ __forceinline__ void attn_pass8(const unsigned char* Qw8, int QP, const unsigned char* Kh8, int KP, const unsigned char* VT, int mI, char* shm, f32x16 (&o)[NV], float& l_out, int wave_in, bool pre = false) {
    int tid = wave_in * 64 + lane_id(); asm volatile("" : "+v"(tid));
    const int lane = tid & 63, r32 = lane & 31, hi = lane >> 5; const int wid = wave_in;
    const unsigned lds0 = (unsigned)(uintptr_t)shm;
    constexpr int VCH = NV * 512;
    const bool kw = wid < 4, kwk = wid < 3;
    const unsigned char* ksrc = Kh8 + (long)lane * KP + (wid & 3) * 16;
    const unsigned char* vsrc = VT + (long)(lane + ((kw && NV == 4) ? 64 : 0)) * SEQ + (wid & 3) * 16;
    const unsigned kdst = lds0 + LDS_K + (wid & 3) * 1024, vdst = lds0 + LDS_V + (wid & 3) * VCH + ((kw && NV == 4) ? 1024 : 0);
#define DMA_K8(t, slot) do { if (kwk) glds16(ksrc + (long)(t) * KVBLK * KP, (unsigned)__builtin_amdgcn_readfirstlane(kdst + (slot))); } while (0)
#define DMA_V8(t, slot) do { if (!kw || NV == 4) glds16(vsrc + (t) * KVBLK, (unsigned)__builtin_amdgcn_readfirstlane(vdst + (slot))); } while (0)
#define OWN_BAR() do { if (kwk && NV == 4) { WAIT_BAR(2); } else { WAIT_BAR(1); } } while (0)
    const lds_cptr shm3 = (lds_cptr)shm;
    const lds_cptr kp0 = shm3 + LDS_K + hi * 1024 + r32 * 16, kq0 = shm3 + LDS_K + 2048 + r32 * 16 + 8 * hi;
    const lds_cptr vp0 = shm3 + LDS_V + (2 * hi) * VCH + r32 * 16;
    if (!pre) { DMA_K8(0, 0); DMA_V8(0, 0); DMA_K8(1, SLOTB); DMA_K8(2, 2 * SLOTB); }
    v8i q8; { const u32x4 a = *(const u32x4*)(Qw8 + (long)r32 * QP + 16 * hi); const u32x2 b = *(const u32x2*)(Qw8 + (long)r32 * QP + 32 + 8 * hi); q8 = (v8i){(int)a.x, (int)a.y, (int)a.z, (int)a.w, (int)b.x, (int)b.y, 0, 0}; }
    float l_reg = 0.f;
#pragma unroll
    for (int d = 0; d < NV; ++d) o[d] = f32x16{};
    f32x16 cinit; { int mI_ = mI; asm volatile("" : "+s"(mI_)); float cv = 8.0f * (float)(7 - mI_) * (1.0f / 65536.0f); asm volatile("" : "+v"(cv));
#pragma unroll
        for (int r = 0; r < 16; ++r) cinit[r] = cv; }
    asm volatile("" : "+v"(cinit));
    int sc6 = 0x77; asm volatile("" : "+v"(sc6));
    f32x16 C0, C1; v8i pA, pB, kf0, kf1;
    v8i ones8; { int one4 = ((lane & 15) == ((lane >> 4) & 1)) ? 0x38383838 : 0; asm volatile("" : "+v"(one4));
#pragma unroll
        for (int w = 0; w < 8; ++w) ones8[w] = one4; }
    f32x4 lsum = f32x4{};
    int sl_prev = 0, sl_cur = 0, sl_next = SLOTB;
#define ROT() do { sl_prev = sl_cur; sl_cur = sl_next; sl_next = (sl_next == (NSLOT - 1) * SLOTB) ? 0 : sl_next + SLOTB; } while (0)
#define KLD(sl) do { kf0 = ld24(kp0 + (sl), kq0 + (sl)); kf1 = ld24(kp0 + (sl) + 512, kq0 + (sl) + 512); } while (0)
#define CODES(PW, w0, w1) do { _Pragma("unroll") for (int w_ = (w0); w_ < (w1); ++w_) { \
      const float c0_ = w_ < 4 ? C0[4 * w_] : C1[4 * (w_ - 4)], c1_ = w_ < 4 ? C0[4 * w_ + 1] : C1[4 * (w_ - 4) + 1], c2_ = w_ < 4 ? C0[4 * w_ + 2] : C1[4 * (w_ - 4) + 2], c3_ = w_ < 4 ? C0[4 * w_ + 3] : C1[4 * (w_ - 4) + 3]; \
      const unsigned x_ = __builtin_bit_cast(unsigned, __builtin_amdgcn_cvt_pknorm_u16(c0_, c1_)), y_ = __builtin_bit_cast(unsigned, __builtin_amdgcn_cvt_pknorm_u16(c2_, c3_));     \
      PW[w_] = (int)__builtin_amdgcn_perm(y_, x_, 0x06040200u); } } while (0)
    asm volatile("s_waitcnt vmcnt(0) lgkmcnt(0)\n\ts_barrier" ::: "memory");
    KLD(0);
    C0 = MFMA6(kf0, q8, cinit); C1 = MFMA6(kf1, q8, cinit);
    CODES(pA, 0, 8);
    asm volatile("s_waitcnt lgkmcnt(0)\n\ts_barrier" ::: "memory");
    DMA_K8(3, 0); DMA_V8(1, 2 * SLOTB);
    ROT();
    KLD(sl_cur);
    OWN_BAR();
#define VLD(db) ld32(vp_ + (db) * 512, vp_ + (db) * 512 + VCH)
#define PINV(x) asm volatile("" : "+v"(x))
#define STEP8(PC, PN, t, GK, GV, GL) do { SBAR(); \
    const lds_cptr vp_ = vp0 + 2 * sl_prev; \
    v8i vfa = VLD(0), vfb = VLD(1); SBAR(); \
    __builtin_amdgcn_s_setprio(1); C0 = MFMA6(kf0, q8, cinit); C1 = MFMA6(kf1, q8, cinit); PINV(C0); PINV(C1); __builtin_amdgcn_s_setprio(0); SBAR(); \
    if (GK) { DMA_K8((t) + 3, sl_cur); } if (GV) { DMA_V8((t) + 1, 2 * sl_next); } \
    if (GL) { KLD(sl_next); } SBAR(); \
    __builtin_amdgcn_s_setprio(1); o[0] = MFMA8(PC, vfa, o[0]); PINV(o[0]); __builtin_amdgcn_s_setprio(0); SBAR(); if constexpr (NV == 4) { vfa = VLD(2); } CODES(PN, 0, 8 / NV); PINV(PN); SBAR(); \
    __builtin_amdgcn_s_setprio(1); o[1] = MFMA8(PC, vfb, o[1]); PINV(o[1]); __builtin_amdgcn_s_setprio(0); SBAR(); if constexpr (NV == 4) { vfb = VLD(3); } CODES(PN, 8 / NV, 16 / NV); PINV(PN); SBAR(); \
    if constexpr (NV == 4) { \
    __builtin_amdgcn_s_setprio(1); o[2] = MFMA8(PC, vfa, o[2]); PINV(o[2]); __builtin_amdgcn_s_setprio(0); SBAR(); CODES(PN, 4, 6); PINV(PN); SBAR(); \
    __builtin_amdgcn_s_setprio(1); o[3] = MFMA8(PC, vfb, o[3]); PINV(o[3]); __builtin_amdgcn_s_setprio(0); SBAR(); CODES(PN, 6, 8); PINV(PN); SBAR(); } \
    __builtin_amdgcn_s_setprio(1); lsum = MFMA8S(PC, ones8, lsum); PINV(lsum); __builtin_amdgcn_s_setprio(0); SBAR(); \
    } while (0)
#define ENDW8(tt) do { if ((tt) + 3 < NT) { OWN_BAR(); } else if ((tt) + 2 < NT) { if (kw && NV != 4) { WAIT_BAR(0); } else { WAIT_BAR(1); } } else { WAIT_BAR(0); } } while (0)
    int t = 1;
#pragma unroll 1
    for (; t + 1 < NT; t += 2) {
        STEP8(pA, pB, t, (t + 3 < NT), (t + 1 < NT), (t + 1 < NT));         ENDW8(t);     ROT();
        STEP8(pB, pA, t + 1, (t + 4 < NT), (t + 2 < NT), (t + 2 < NT));     ENDW8(t + 1); ROT();
    }
    STEP8(pA, pB, NT - 1, false, false, false);
    { const lds_cptr vp_ = vp0 + 2 * sl_cur;
#pragma unroll
      for (int db = 0; db < NV; ++db) { const v8i vf = ld32(vp_ + db * 512, vp_ + db * 512 + VCH); o[db] = MFMA8(pB, vf, o[db]); } }
    lsum = MFMA8S(pB, ones8, lsum);
    __builtin_amdgcn_s_setprio(0);
    { float* wsf = (float*)(shm + LDS_WS) + wid * 64;
#pragma unroll
      for (int r = 0; r < 4; ++r) if ((lane & 15) < 2) wsf[16 * (lane & 15) + 4 * (lane >> 4) + r] = lsum[r];
      asm volatile("s_waitcnt lgkmcnt(0)" ::: "memory");
      l_reg = wsf[r32]; asm volatile("s_waitcnt lgkmcnt(0)" ::: "memory"); }
    l_out = l_reg;
    asm volatile("s_waitcnt lgkmcnt(0)\n\ts_barrier" ::: "memory");
#undef DMA_K8
#undef DMA_V8
#undef OWN_BAR
#undef ROT
#undef KLD
#undef CODES
#undef STEP8
#undef PINV
#undef VLD
#undef ENDW8
}
__device__ __forceinline__ void attn_pass8_2x(const unsigned char* Qw8, int QP, const unsigned char* Kh8, int KP, const unsigned char* VT, int mI, char* shm, f32x16 (&oa)[2], f32x16 (&ob)[2], float& la_out, float& lb_out, int wave_in, bool pre = false) {
    constexpr int NV = 2;
    int tid = wave_in * 64 + lane_id(); asm volatile("" : "+v"(tid));
    const int lane = tid & 63, r32 = lane & 31, hi = lane >> 5; const int wid = wave_in;
    const unsigned lds0 = (unsigned)(uintptr_t)shm;
    constexpr int VCH = NV * 512;
    const bool kw = wid < 4, kwk = wid < 3;
    const unsigned char* ksrc = Kh8 + (long)lane * KP + (wid & 3) * 16;
    const unsigned char* vsrc = VT + (long)lane * SEQ + (wid & 3) * 16;
    const unsigned kdst = lds0 + LDS_K + (wid & 3) * 1024, vdst = lds0 + LDS_V + (wid & 3) * VCH;
#define DMA_K8(t, slot) do { if (kwk) glds16(ksrc + (long)(t) * KVBLK * KP, (unsigned)__builtin_amdgcn_readfirstlane(kdst + (slot))); } while (0)
#define DMA_V8(t, slot) do { if (!kw) glds16(vsrc + (t) * KVBLK, (unsigned)__builtin_amdgcn_readfirstlane(vdst + (slot))); } while (0)
#define OWN_BAR() WAIT_BAR(1)
    const lds_cptr shm3 = (lds_cptr)shm;
    const lds_cptr kp0 = shm3 + LDS_K + hi * 1024 + r32 * 16, kq0 = shm3 + LDS_K + 2048 + r32 * 16 + 8 * hi;
    const lds_cptr vp0 = shm3 + LDS_V + (2 * hi) * VCH + r32 * 16;
    if (!pre) { DMA_K8(0, 0); DMA_V8(0, 0); DMA_K8(1, SLOTB); DMA_K8(2, 2 * SLOTB); }
    v8i q8a, q8b;
    { const u32x4 a = *(const u32x4*)(Qw8 + (long)r32 * QP + 16 * hi); const u32x2 b = *(const u32x2*)(Qw8 + (long)r32 * QP + 32 + 8 * hi); q8a = (v8i){(int)a.x, (int)a.y, (int)a.z, (int)a.w, (int)b.x, (int)b.y, 0, 0}; }
    { const u32x4 a = *(const u32x4*)(Qw8 + (long)(32 + r32) * QP + 16 * hi); const u32x2 b = *(const u32x2*)(Qw8 + (long)(32 + r32) * QP + 32 + 8 * hi); q8b = (v8i){(int)a.x, (int)a.y, (int)a.z, (int)a.w, (int)b.x, (int)b.y, 0, 0}; }
#pragma unroll
    for (int d = 0; d < NV; ++d) { oa[d] = f32x16{}; ob[d] = f32x16{}; }
    f32x16 cinit; { int mI_ = mI; asm volatile("" : "+s"(mI_)); float cv = 8.0f * (float)(7 - mI_) * (1.0f / 65536.0f); asm volatile("" : "+v"(cv));
#pragma unroll
        for (int r = 0; r < 16; ++r) cinit[r] = cv; }
    asm volatile("" : "+v"(cinit));
    int sc6 = 0x77; asm volatile("" : "+v"(sc6));
    f32x16 C0, C1; v8i pAa, pBa, pAb, pBb, kf0, kf1;
    v8i ones8; { int one4 = ((lane & 15) == ((lane >> 4) & 1)) ? 0x38383838 : 0; asm volatile("" : "+v"(one4));
#pragma unroll
        for (int w = 0; w < 8; ++w) ones8[w] = one4; }
    f32x4 lsa = f32x4{}, lsb = f32x4{};
    int sl_prev = 0, sl_cur = 0, sl_next = SLOTB;
#define ROT() do { sl_prev = sl_cur; sl_cur = sl_next; sl_next = (sl_next == (NSLOT - 1) * SLOTB) ? 0 : sl_next + SLOTB; } while (0)
#define KLD(sl) do { kf0 = ld24(kp0 + (sl), kq0 + (sl)); kf1 = ld24(kp0 + (sl) + 512, kq0 + (sl) + 512); } while (0)
#define CODES(PW, w0, w1) do { _Pragma("unroll") for (int w_ = (w0); w_ < (w1); ++w_) { \
      const float c0_ = w_ < 4 ? C0[4 * w_] : C1[4 * (w_ - 4)], c1_ = w_ < 4 ? C0[4 * w_ + 1] : C1[4 * (w_ - 4) + 1], c2_ = w_ < 4 ? C0[4 * w_ + 2] : C1[4 * (w_ - 4) + 2], c3_ = w_ < 4 ? C0[4 * w_ + 3] : C1[4 * (w_ - 4) + 3]; \
      const unsigned x_ = __builtin_bit_cast(unsigned, __builtin_amdgcn_cvt_pknorm_u16(c0_, c1_)), y_ = __builtin_bit_cast(unsigned, __builtin_amdgcn_cvt_pknorm_u16(c2_, c3_));     \
      PW[w_] = (int)__builtin_amdgcn_perm(y_, x_, 0x06040200u); } } while (0)
    asm volatile("s_waitcnt vmcnt(0) lgkmcnt(0)\n\ts_barrier" ::: "memory");
    KLD(0);
    C0 = MFMA6(kf0, q8a, cinit); C1 = MFMA6(kf1, q8a, cinit);
    CODES(pAa, 0, 8);
    C0 = MFMA6(kf0, q8b, cinit); C1 = MFMA6(kf1, q8b, cinit);
    CODES(pAb, 0, 8);
    asm volatile("s_waitcnt lgkmcnt(0)\n\ts_barrier" ::: "memory");
    DMA_K8(3, 0); DMA_V8(1, 2 * SLOTB);
    ROT();
    KLD(sl_cur);
    OWN_BAR();
#define VLD(db) ld32(vp_ + (db) * 512, vp_ + (db) * 512 + VCH)
#define PINV(x) asm volatile("" : "+v"(x))
#define STEP2(PCa, PNa, PCb, PNb, t, GK, GV, GL) do { SBAR(); \
    const lds_cptr vp_ = vp0 + 2 * sl_prev; \
    v8i vfa = VLD(0), vfb = VLD(1); SBAR(); \
    __builtin_amdgcn_s_setprio(1); C0 = MFMA6(kf0, q8a, cinit); C1 = MFMA6(kf1, q8a, cinit); PINV(C0); PINV(C1); __builtin_amdgcn_s_setprio(0); SBAR(); \
    if (GK) { DMA_K8((t) + 3, sl_cur); } if (GV) { DMA_V8((t) + 1, 2 * sl_next); } SBAR(); \
    __builtin_amdgcn_s_setprio(1); oa[0] = MFMA8(PCa, vfa, oa[0]); PINV(oa[0]); __builtin_amdgcn_s_setprio(0); SBAR(); CODES(PNa, 0, 4); PINV(PNa); SBAR(); \
    __builtin_amdgcn_s_setprio(1); oa[1] = MFMA8(PCa, vfb, oa[1]); PINV(oa[1]); __builtin_amdgcn_s_setprio(0); SBAR(); CODES(PNa, 4, 8); PINV(PNa); SBAR(); \
    __builtin_amdgcn_s_setprio(1); C0 = MFMA6(kf0, q8b, cinit); C1 = MFMA6(kf1, q8b, cinit); PINV(C0); PINV(C1); __builtin_amdgcn_s_setprio(0); SBAR(); \
    if (GL) { KLD(sl_next); } SBAR(); \
    __builtin_amdgcn_s_setprio(1); ob[0] = MFMA8(PCb, vfa, ob[0]); PINV(ob[0]); __builtin_amdgcn_s_setprio(0); SBAR(); CODES(PNb, 0, 4); PINV(PNb); SBAR(); \
    __builtin_amdgcn_s_setprio(1); ob[1] = MFMA8(PCb, vfb, ob[1]); PINV(ob[1]); __builtin_amdgcn_s_setprio(0); SBAR(); CODES(PNb, 4, 8); PINV(PNb); SBAR(); \
    __builtin_amdgcn_s_setprio(1); lsa = MFMA8S(PCa, ones8, lsa); PINV(lsa); lsb = MFMA8S(PCb, ones8, lsb); PINV(lsb); __builtin_amdgcn_s_setprio(0); SBAR(); \
    } while (0)
#define ENDW8(tt) do { if ((tt) + 3 < NT) { OWN_BAR(); } else if ((tt) + 2 < NT) { if (kw) { WAIT_BAR(0); } else { WAIT_BAR(1); } } else { WAIT_BAR(0); } } while (0)
    int t = 1;
#pragma unroll 1
    for (; t + 1 < NT; t += 2) {
        STEP2(pAa, pBa, pAb, pBb, t, (t + 3 < NT), (t + 1 < NT), (t + 1 < NT));         ENDW8(t);     ROT();
        STEP2(pBa, pAa, pBb, pAb, t + 1, (t + 4 < NT), (t + 2 < NT), (t + 2 < NT));     ENDW8(t + 1); ROT();
    }
    STEP2(pAa, pBa, pAb, pBb, NT - 1, false, false, false);
    { const lds_cptr vp_ = vp0 + 2 * sl_cur;
#pragma unroll
      for (int db = 0; db < NV; ++db) { const v8i vf = ld32(vp_ + db * 512, vp_ + db * 512 + VCH); oa[db] = MFMA8(pBa, vf, oa[db]); ob[db] = MFMA8(pBb, vf, ob[db]); } }
    lsa = MFMA8S(pBa, ones8, lsa); lsb = MFMA8S(pBb, ones8, lsb);
    __builtin_amdgcn_s_setprio(0);
    { float* wsf = (float*)(shm + LDS_WS) + wid * 64;
#pragma unroll
      for (int r = 0; r < 4; ++r) if ((lane & 15) < 2) { wsf[16 * (lane & 15) + 4 * (lane >> 4) + r] = lsa[r]; wsf[32 + 16 * (lane & 15) + 4 * (lane >> 4) + r] = lsb[r]; }
      asm volatile("s_waitcnt lgkmcnt(0)" ::: "memory");
      la_out = wsf[r32]; lb_out = wsf[32 + r32]; asm volatile("s_waitcnt lgkmcnt(0)" ::: "memory"); }
    asm volatile("s_waitcnt lgkmcnt(0)\n\ts_barrier" ::: "memory");
#undef DMA_K8
#undef DMA_V8
#undef OWN_BAR
#undef ROT
#undef KLD
#undef CODES
#undef STEP2
#undef PINV
#undef VLD
#undef ENDW8
}
#undef SBAR
#undef WAIT_BAR
}

constexpr int LDS_BYTES = 156 * 1024;
static_assert(att::LDS_BYTES <= LDS_BYTES && pg8::STAGE_BYTES <= LDS_BYTES, "LDS map");
constexpr int NWAVES = 8;

struct Args {
    const float* x_prompt; const float* x_sample; const float* c_prompt; const float* c_sample;
    const float* w_ada; const float* b_ada; const float* norm_g; const float* w_in;
    const float* qn_a; const float* kn_a; const float* qn_b; const float* kn_b;
    const float* lq1; const float* lk1; const float* lq2; const float* lk2; const float* subln_g;
    const float* w_proj_a; const float* w_proj_b; const float* w_out;
    float* out; unsigned char* ws;
};
__constant__ double INV_A[16] = {1.0, 0.5623413251903491, 0.31622776601683794, 0.1778279410038923, 0.1, 0.05623413251903491, 0.03162277660168379, 0.01778279410038923, 0.01, 0.005623413251903491, 0.0031622776601683794, 0.0017782794100389228, 0.001, 0.0005623413251903491, 0.00031622776601683794, 0.00017782794100389227};
__constant__ double INV_B[8] = {1.0, 0.19392274474868576, 0.03760603093086393, 0.007292664737217109, 0.001414213562373095, 0.0002742481756762073, 5.318295896944988e-05, 1.031338537721246e-05};

__device__ __forceinline__ int win_row(int n) {
    const int T = n >> 8, o = n & 255;
    int base;
    if (T < 2) base = T * 256; else if (T == 2) base = 6 * 256; else if (T < 5) base = (9 + (T - 3)) * 256; else if (T < 9) base = (T - 3) * 256; else if (T < 11) base = (T - 2) * 256; else base = T * 256;
    if (T == 3 || T == 4 || T >= 11) return base + 128 * ((o >> 3) & 1) + 32 * (o >> 6) + 8 * ((o >> 4) & 3) + (o & 7);
    return base + 128 * ((o >> 5) & 1) + 32 * (o >> 6) + (o & 31);
}
__device__ __forceinline__ void transpose_item(const float* W, int N, h16_t* WT, int KD, int kofs, int k0, int n0, int drow0, LAS float* scr, int lane, unsigned char* WT8 = nullptr, int drow8 = 0, float sc8 = 1.0f, float wmul = 1.0f) {
#pragma unroll 8
    for (int i = 0; i < 32; ++i) { const int kk = 2 * i + (lane >> 5); scr[kk * 33 + (lane & 31)] = W[(size_t)(k0 + kk) * N + n0 + (lane & 31)]; }
    asm volatile("s_waitcnt lgkmcnt(0)" ::: "memory");
    const int c = lane & 7;
#pragma unroll
    for (int j = 0; j < 4; ++j) { const int n = (lane >> 3) + 8 * j; const LAS float* s = scr + (8 * c) * 33 + n;
        u32x4 o; o.x = pk2h(s[0 * 33] * wmul, s[1 * 33] * wmul); o.y = pk2h(s[2 * 33] * wmul, s[3 * 33] * wmul); o.z = pk2h(s[4 * 33] * wmul, s[5 * 33] * wmul); o.w = pk2h(s[6 * 33] * wmul, s[7 * 33] * wmul);
        *(u32x4*)(WT + (size_t)(drow0 >= 0 ? drow0 + n : win_row(n0 + n)) * KD + kofs + k0 + 8 * c) = o;
        if (WT8) { int w0 = 0, w1 = 0;
            w0 = __builtin_amdgcn_cvt_pk_fp8_f32(s[0 * 33] * sc8, s[1 * 33] * sc8, w0, false); w0 = __builtin_amdgcn_cvt_pk_fp8_f32(s[2 * 33] * sc8, s[3 * 33] * sc8, w0, true);
            w1 = __builtin_amdgcn_cvt_pk_fp8_f32(s[4 * 33] * sc8, s[5 * 33] * sc8, w1, false); w1 = __builtin_amdgcn_cvt_pk_fp8_f32(s[6 * 33] * sc8, s[7 * 33] * sc8, w1, true);
            *(u32x2*)(WT8 + (size_t)(drow8 >= 0 ? drow8 + n : win_row(n0 + n) + drow8) * 1024 + k0 + 8 * c) = (u32x2){(unsigned)w0, (unsigned)w1}; } }
    asm volatile("s_waitcnt lgkmcnt(0)" ::: "memory");
}
__device__ __forceinline__ unsigned amax_bits(const unsigned char* ws, int G, size_t off = WS_AMAX) {
    int ln = lane_id(); asm volatile("" : "+v"(ln));
    float m = 0.f; for (int i = ln; i < G; i += 64) m = fmaxf(m, ((const float*)(ws + off))[i]);
#pragma unroll
    for (int o_ = 1; o_ < 64; o_ <<= 1) m = fmaxf(m, __shfl_xor(m, o_));
    return (unsigned)__builtin_amdgcn_readfirstlane((int)__float_as_uint(m));
}
__device__ __forceinline__ int w8_exp(unsigned amax_bits) {
    const float am = __uint_as_float(amax_bits);
    if (!(am > 1e-30f) || !(am < 1e30f)) return 0;
    const float r = 224.0f / am; return (int)((__float_as_uint(r) >> 23) & 255u) - 127;
}


__device__ __forceinline__ void score_bounds(const Args& A, float& boundA, float& boundB) {
    int ln = lane_id(); asm volatile("" : "+v"(ln));
    float qa = fabsf(A.qn_a[ln]), ka = fabsf(A.kn_a[ln]), qb_ = fabsf(A.qn_b[ln]), kb_ = fabsf(A.kn_b[ln]);
#pragma unroll
    for (int o_ = 1; o_ < 64; o_ <<= 1) { qa = fmaxf(qa, __shfl_xor(qa, o_)); ka = fmaxf(ka, __shfl_xor(ka, o_)); qb_ = fmaxf(qb_, __shfl_xor(qb_, o_)); kb_ = fmaxf(kb_, __shfl_xor(kb_, o_)); }
    boundA = __uint_as_float(__builtin_amdgcn_readfirstlane(__float_as_uint(C2 * 64.0f * 1.01f * qa * ka))); boundB = __uint_as_float(__builtin_amdgcn_readfirstlane(__float_as_uint(C2 * 64.0f * 1.01f * qb_ * kb_)));
}
__device__ __forceinline__ bool use_fp8(float boundA, float boundB) { return (boundA <= 13.7f) && (boundB <= 13.7f); }

#define XB_TMO      128
#define XB_XCNT(j)  (256  + 64 * (j))
#define XB_XSUB(j)  (1280 + 64 * (j))
#define XB_XGEN(j)  (2304 + 64 * (j))
#define XB_TOP      3328
#define XB_TOPGEN   3392
#define XB_AMAX      3456
#define XCD_BAR_WORDS 3472
#define XB_SPIN_CAP (1u << 18)
__device__ __forceinline__ unsigned xb_ld(unsigned* p)              { return __hip_atomic_load(p, __ATOMIC_RELAXED, __HIP_MEMORY_SCOPE_AGENT); }
__device__ __forceinline__ unsigned xb_add(unsigned* p, unsigned v) { return __hip_atomic_fetch_add(p, v, __ATOMIC_RELAXED, __HIP_MEMORY_SCOPE_AGENT); }
__device__ __forceinline__ unsigned xb_xcc_id() { return (unsigned)__builtin_amdgcn_s_getreg((3 << 11) | 20) & 0xFu; }
#define XB_SPIN(cond, bar) do { unsigned _sp = 0; while (cond) { __builtin_amdgcn_s_sleep(1); \
    if ((++_sp & 255u) == 0u) { if (xb_ld(&(bar)[XB_TMO])) break; if (_sp > XB_SPIN_CAP) { atomicAdd(&(bar)[XB_TMO], 1u); break; } } } } while (0)
struct XcdBarrier { unsigned* bar; unsigned x; volatile LAS unsigned* st; int wave; };
__device__ __forceinline__ XcdBarrier xcd_barrier_post(unsigned* bar, volatile LAS unsigned* st, int wave) {
    XcdBarrier b; b.bar = bar; b.x = xb_xcc_id(); b.st = st; b.wave = wave;
    if (wave == 0 && lane_id() == 0) (void)xb_add(&bar[XB_XCNT(b.x)], 1u);
    return b;
}
__device__ __forceinline__ void xcd_barrier_complete(unsigned* bar, unsigned x, unsigned& nloc, unsigned& nx) {
    const unsigned G = gridDim.x * gridDim.y * gridDim.z;
    unsigned sum, cnt, mine, sp = 0u;
    for (;;) {
        sum = 0u; cnt = 0u; mine = 0u;
#pragma unroll
        for (unsigned j = 0; j < 16; ++j) { const unsigned c = xb_ld(&bar[XB_XCNT(j)]); sum += c; cnt += (c > 0u) ? 1u : 0u; mine = (j == x) ? c : mine; }
        if (sum == G) break;
        __builtin_amdgcn_s_sleep(1);
        if ((++sp & 255u) == 0u) { if (xb_ld(&bar[XB_TMO])) break; if (sp > XB_SPIN_CAP) { atomicAdd(&bar[XB_TMO], 1u); break; } }
    }
    nloc = mine > 0u ? mine : 1u; nx = cnt > 0u ? cnt : 1u;
}
__device__ __forceinline__ void xcd_barrier(const XcdBarrier& b) {
    asm volatile("s_waitcnt vmcnt(0)" ::: "memory");
    __syncthreads();
    if (b.wave == 0 && lane_id() == 0) {
        unsigned* bar = b.bar;
        __builtin_amdgcn_s_waitcnt(0);
        unsigned nloc = b.st[0], nx = b.st[1];
        if (nloc == 0u) { xcd_barrier_complete(bar, b.x, nloc, nx); b.st[0] = nloc; b.st[1] = nx; }
        const unsigned old = xb_add(&bar[XB_XSUB(b.x)], 1u);
        const unsigned gen = old / nloc;
        if (old + 1u == (gen + 1u) * nloc) {
            __builtin_amdgcn_fence(__ATOMIC_RELEASE, "agent");
            asm volatile("s_waitcnt vmcnt(0)" ::: "memory");
            const unsigned og = xb_add(&bar[XB_TOP], 1u);
            const unsigned tg = og / nx;
            if (og + 1u == (tg + 1u) * nx) xb_add(&bar[XB_TOPGEN], 1u);
            else XB_SPIN(xb_ld(&bar[XB_TOPGEN]) == tg, bar);
            __builtin_amdgcn_fence(__ATOMIC_ACQUIRE, "agent");
            xb_add(&bar[XB_XGEN(b.x)], 1u);
            asm volatile("s_waitcnt vmcnt(0)" ::: "memory");
        } else {
            XB_SPIN(xb_ld(&bar[XB_XGEN(b.x)]) == gen, bar);
            __builtin_amdgcn_fence(__ATOMIC_ACQUIRE, "agent");
            asm volatile("s_waitcnt vmcnt(0)" ::: "memory");
        }
    }
    __syncthreads();
}

__global__ void __launch_bounds__(NWAVES * 64, 2) mega_fwd(Args A) {
    extern __shared__ __attribute__((aligned(16))) unsigned char lds[];
    LAS unsigned char* ldsl = (LAS unsigned char*)lds;
    const int tid = threadIdx.x, lane = tid & 63, wave = __builtin_amdgcn_readfirstlane(tid >> 6);
    const int G = gridDim.x; const int bx = blockIdx.x; const int vcu = (G % 8 == 0) ? (bx % 8) * (G / 8) + bx / 8 : bx;
    unsigned char* ws = A.ws;
    const int gw = vcu * NWAVES + wave, NGW = G * NWAVES;
    volatile LAS unsigned* bar_st = (volatile LAS unsigned*)(ldsl + LDS_BYTES - 64);
    if (tid == 0) { bar_st[0] = 0u; bar_st[1] = 0u; }
    __syncthreads();
    const XcdBarrier xbar = xcd_barrier_post((unsigned*)ws, bar_st, wave);

    {
        for (int it = gw; it < 48 * 16; it += NGW) {
            const int cgp = it % 48, kc = it / 48, col = cgp * 64 + lane, k0 = kc * 64;
            float sv[6], ac[6];
#pragma unroll
            for (int b = 0; b < 6; ++b) { const float c = b < 4 ? A.c_prompt[b * DM + k0 + lane] : A.c_sample[(b - 4) * DM + k0 + lane]; sv[b] = silu_f(c); ac[b] = 0.f; }
            for (int kk = 0; kk < 64; ++kk) {
                const float w = A.w_ada[(size_t)(k0 + kk) * 3072 + col];
#pragma unroll
                for (int b = 0; b < 6; ++b) ac[b] += __shfl(sv[b], kk) * w;
            }
            float* modp = (float*)(ws + WS_MODP);
#pragma unroll
            for (int b = 0; b < 6; ++b) modp[(size_t)(kc * 6 + b) * 3072 + col] = ac[b];
        }
        {
            float am = 0.f;
            for (int i = gw * 64 + lane; i < DM * 384; i += NGW * 64) {
                const int row = i / 384, c4 = i - row * 384, col = c4 < 128 ? 4 * c4 : 1280 + 4 * (c4 - 128);
                const f32x4 v = *(const f32x4*)(A.w_in + (size_t)row * DIN + col);
                am = fmaxf(fmaxf(am, fmaxf(fabsf(v.x), fabsf(v.y))), fmaxf(fabsf(v.z), fabsf(v.w)));
            }
            float ag = 0.f;
            for (int i = gw * 64 + lane; i < DM * 512; i += NGW * 64) {
                const int row = i >> 9, col = 3328 + 4 * (i & 511);
                const f32x4 v = *(const f32x4*)(A.w_in + (size_t)row * DIN + col);
                ag = fmaxf(fmaxf(ag, fmaxf(fabsf(v.x), fabsf(v.y))), fmaxf(fabsf(v.z), fabsf(v.w)));
            }
#pragma unroll
            for (int o_ = 1; o_ < 64; o_ <<= 1) { am = fmaxf(am, __shfl_xor(am, o_)); ag = fmaxf(ag, __shfl_xor(ag, o_)); }
            LAS float* amw = (LAS float*)(ldsl + 1024);
            if (lane == 0) { amw[wave] = am; amw[8 + wave] = ag; }
            __syncthreads();
            if (tid == 0) { float m = amw[0], mg = amw[8];
#pragma unroll
                for (int w = 1; w < NWAVES; ++w) { m = fmaxf(m, amw[w]); mg = fmaxf(mg, amw[8 + w]); }
                ((float*)(ws + WS_AMAX))[bx] = m; ((float*)(ws + WS_AMAXG))[bx] = mg; }
        }
    }
    xcd_barrier(xbar);

    {
        LAS float* Gt = (LAS float*)(ldsl + 140 * 1024); LAS float* St = Gt + DM;
        const float* modp = (const float*)(ws + WS_MODP);
        if (vcu < NBATCH) {
            for (int c = tid; c < DM; c += NWAVES * 64) { float g = A.b_ada[2048 + c];
                for (int kc = 0; kc < 16; ++kc) g += modp[(size_t)(kc * 6 + vcu) * 3072 + 2048 + c];
                ((float*)(ws + WS_GATE))[vcu * DM + c] = g; }
        }
        const int rstart = (int)((long)TOK * vcu / G), rend = (int)((long)TOK * (vcu + 1) / G);
        const int b_lo = rstart >> 13, b_hi = (rend - 1) >> 13;
        for (int b = b_lo; b <= b_hi; ++b) {
            __syncthreads();
            for (int c = tid; c < DM; c += NWAVES * 64) { float sh = A.b_ada[c], scl = A.b_ada[1024 + c];
                for (int kc = 0; kc < 16; ++kc) { sh += modp[(size_t)(kc * 6 + b) * 3072 + c]; scl += modp[(size_t)(kc * 6 + b) * 3072 + 1024 + c]; }
                Gt[c] = A.norm_g[c] * (1.0f + scl); St[c] = sh; }
            __syncthreads();
            const int lo = rstart > b * SEQ ? rstart : b * SEQ, hi_ = rend < (b + 1) * SEQ ? rend : (b + 1) * SEQ;
            for (int r = lo + wave; r < hi_; r += NWAVES) {
                const float* xrow = r < TOKP ? A.x_prompt + (size_t)r * DM : A.x_sample + (size_t)(r - TOKP) * DM;
                const f32x4* xr = (const f32x4*)xrow + lane;
                f32x4 v[4]; float s = 0.f;
#pragma unroll
                for (int j = 0; j < 4; ++j) { v[j] = __builtin_nontemporal_load(xr + 64 * j); s += (v[j].x * v[j].x + v[j].y * v[j].y) + (v[j].z * v[j].z + v[j].w * v[j].w); }
                const float rstd = 1.0f / sqrtf(wave_sum(s) * (1.0f / DM) + EPS);
                u32x2* o8 = (u32x2*)((h16_t*)(ws + WS_XN) + (size_t)r * DM) + lane;
                unsigned* o8b = (unsigned*)(ws + WS_XN8 + (size_t)r * DM) + lane;
#pragma unroll
                for (int j = 0; j < 4; ++j) { const f32x4 gq = *(const LAS f32x4*)(Gt + 4 * lane + 256 * j), sq = *(const LAS f32x4*)(St + 4 * lane + 256 * j);
                    const f32x4 h = v[j] * rstd * gq + sq; u32x2 w; w.x = pk2h(h.x, h.y); w.y = pk2h(h.z, h.w); o8[64 * j] = w;
                    int w8 = 0; w8 = __builtin_amdgcn_cvt_pk_fp8_f32(__builtin_amdgcn_fmed3f(h.x, -448.f, 448.f), __builtin_amdgcn_fmed3f(h.y, -448.f, 448.f), w8, false);
                    w8 = __builtin_amdgcn_cvt_pk_fp8_f32(__builtin_amdgcn_fmed3f(h.z, -448.f, 448.f), __builtin_amdgcn_fmed3f(h.w, -448.f, 448.f), w8, true); o8b[64 * j] = (unsigned)w8; }
            }
        }
        __syncthreads();
        LAS float* scr = (LAS float*)(ldsl + wave * 16384);
        const float w8s = __uint_as_float((unsigned)(127 + w8_exp(amax_bits(ws, G))) << 23);
        const float w8g = -1.4426950408889634f * __uint_as_float((unsigned)(127 + w8_exp(amax_bits(ws, G, WS_AMAXG))) << 23);
        constexpr int I_IN = (DM / 64) * (DIN / 32), I_PA = (512 / 64) * (DM / 32), I_OUT = (DM / 64) * (DM / 32);
        constexpr int NITEMS = I_IN + 2 * I_PA + I_OUT;
        for (int it = gw; it < NITEMS; it += NGW) {
            int r = it;
            if (r < I_IN) { const int nblk = DIN / 32, kb = r / nblk, nb = r % nblk, wr_ = win_row(32 * nb), T_ = nb >> 3;
                const bool qk8 = T_ < 2 || (T_ >= 5 && T_ <= 8);
                transpose_item(A.w_in, DIN, (h16_t*)(ws + WS_WIN), DM, 0, 64 * kb, 32 * nb, -1, scr, lane, qk8 ? ws + WS_WIN8 : (T_ >= 13 ? ws + WS_WIN8G : nullptr), qk8 ? wr_ : -13 * 256, qk8 ? w8s : w8g, T_ >= 13 ? -1.4426950408889634f : 1.0f); continue; } r -= I_IN;
            if (r < I_PA) { const int nblk = DM / 32, kb = r / nblk, nb = r % nblk, n0 = 32 * nb; transpose_item(A.w_proj_a, DM, (h16_t*)(ws + WS_WAB), DM, 0, 64 * kb, n0, 256 * (n0 >> 7) + (n0 & 127), scr, lane); continue; } r -= I_PA;
            if (r < I_PA) { const int nblk = DM / 32, kb = r / nblk, nb = r % nblk, n0 = 32 * nb; transpose_item(A.w_proj_b, DM, (h16_t*)(ws + WS_WAB), DM, 512, 64 * kb, n0, 256 * (n0 >> 7) + 128 + (n0 & 127), scr, lane); continue; } r -= I_PA;
            { const int nblk = DM / 32, kb = r / nblk, nb = r % nblk; transpose_item(A.w_out, DM, (h16_t*)(ws + WS_WOUT), DM, 0, 64 * kb, 32 * nb, 32 * nb, scr, lane); }
        }
        for (int row = gw; row < 2048; row += NGW) {
            h16_t* p = (h16_t*)(ws + WS_WAB) + (size_t)row * DM + ((row & 128) ? 0 : 512) + lane * 8;
            *(u32x4*)p = (u32x4){0u, 0u, 0u, 0u};
        }
        if (vcu == 0) { float* nrm = (float*)(ws + WS_NRM);
            if (tid < 64) { nrm[tid] = A.qn_a[tid]; nrm[64 + tid] = A.kn_a[tid]; nrm[128 + tid] = A.qn_b[tid]; nrm[192 + tid] = A.kn_b[tid]; }
            if (tid < 128) nrm[256 + tid] = A.subln_g[tid]; }
        {
            const int gt = vcu * (NWAVES * 64) + tid, NGT = G * NWAVES * 64;
            for (int e = gt; e < 65536 + 2048 + 1024; e += NGT) {
                int pos, j, kind; if (e < 65536) { kind = 0; pos = e >> 3; j = e & 7; } else if (e < 65536 + 2048) { kind = 1; pos = (e - 65536) >> 4; j = e & 15; } else { kind = 2; pos = (e - 65536 - 2048) >> 4; j = e & 15; }
                const double inv = kind == 0 ? INV_B[j] : INV_A[j & 15];
                double rev = (double)pos * inv * 0.15915494309189533577; rev -= floor(rev);
                const double q4 = floor(rev * 4.0 + 0.5); const double xr = (rev - q4 * 0.25) * 6.283185307179586476925; const double x2 = xr * xr;
                const double sp = xr * (1.0 + x2 * (-1.0 / 6 + x2 * (1.0 / 120 + x2 * (-1.0 / 5040 + x2 * (1.0 / 362880 + x2 * (-1.0 / 39916800 + x2 * (1.0 / 6227020800.0)))))));
                const double cp = 1.0 + x2 * (-0.5 + x2 * (1.0 / 24 + x2 * (-1.0 / 720 + x2 * (1.0 / 40320 + x2 * (-1.0 / 3628800 + x2 * (1.0 / 479001600.0 + x2 * (-1.0 / 87178291200.0)))))));
                const int qd = ((int)q4) & 3;
                const double cd = qd == 0 ? cp : qd == 1 ? -sp : qd == 2 ? -cp : sp, sd = qd == 0 ? sp : qd == 1 ? cp : qd == 2 ? -sp : -cp;
                const float cs = (float)cd, sn = (float)sd;
                h16_t* tp; int stride, half;
                if (kind == 0) { tp = (h16_t*)(ws + WS_TB); stride = 16; half = 8; } else if (kind == 1) { tp = (h16_t*)(ws + WS_TAR); stride = 32; half = 16; } else { tp = (h16_t*)(ws + WS_TAC); stride = 32; half = 16; }
                tp[pos * stride + j] = f2h(cs);
                tp[pos * stride + half + j] = f2h(sn);
            }
        }
    }
    xcd_barrier(xbar);

    int p4_u8, p4_eg;
    {
        float bA_, bB_; score_bounds(A, bA_, bB_); const int u8 = use_fp8(bA_, bB_) ? 1 : 0;
        p4_u8 = __builtin_amdgcn_readfirstlane(u8); p4_eg = __builtin_amdgcn_readfirstlane(w8_exp(amax_bits(ws, G, WS_AMAXG)));
        if (u8) {
            const int eqk = w8_exp(amax_bits(ws, G));
            pg8::Gemm g{(const h16_t*)(ws + WS_XN8), (const h16_t*)(ws + WS_WIN8), TOK, 6 * 256, DM / 2, 0x7f00 | (127 - eqk)}; pg8::StaticOrder S; S.init(TOK, 6 * 256, G, bx);
            if (G == 256) { S.i2 = 3; S.G2 = 192; S.c2 = (bx >= 128 && bx < 192) ? -1 : (bx < 128 ? bx : bx - 64); }
            EpiInProj E{0, ws, 1, 0, 1.0f};
            pg8::gemm_phase<EpiInProj, false, true>(ldsl, g, S, E, wave);
        }
        {
            const int nt16 = u8 ? 3 : 9;
            pg8::Gemm g{(const h16_t*)(ws + WS_XN), (const h16_t*)(ws + WS_WIN) + (size_t)(9 - nt16) * 256 * DM, TOK, nt16 * 256, DM}; pg8::StaticOrder S; S.init(TOK, nt16 * 256, G, u8 ? (bx + G / 2) % G : bx);
            EpiInProj E{0, ws, u8, 9 - nt16, 1.0f};
            pg8::gemm_phase<EpiInProj>(ldsl, g, S, E, wave);
        }
    }
    xcd_barrier(xbar);

    {
        float lam;
        { int ln = lane_id(); asm volatile("" : "+v"(ln)); const float p1 = A.lq1[ln] * A.lk1[ln], p2 = A.lq2[ln] * A.lk2[ln]; lam = __uint_as_float(__builtin_amdgcn_readfirstlane(__float_as_uint(__expf(wave_sum(p1)) - __expf(wave_sum(p2)) + LAM_INIT))); }
        float boundA, boundB; score_bounds(A, boundA, boundB); const bool use8 = use_fp8(boundA, boundB);
        auto shift_of = [](float bound) -> int { const unsigned b = __float_as_uint(bound); const int e = (int)(b >> 23) - 127; const unsigned m = (b & 0x7fffffu) | 0x800000u;
            const int fx = e >= 13 ? (int)(m << (e - 13)) : (e >= -10 ? (int)(m >> (13 - e)) : 0);
            return (fx - 8960 + 1024) >> 10; };
        const int mIA = shift_of(boundA), mIB = shift_of(boundB);
        char* shm = (char*)lds;
        h16_t* OAB = (h16_t*)(ws + WS_OAB);
        auto first_dma = [&](int s_, int p_) {
            if (s_ < 768) { const int u = (s_ >> 8) * 32 + (s_ & 31), xg = (s_ & 255) >> 5, j = u >> 4, id = 3 * xg + (j >> 1), b = id >> 2, kvh = (id >> 1) & 1;
                att::attn_first_dma<2>((const unsigned char*)(ws + WS_KA) + (long)b * SEQ * 96 + kvh * 48, 96, (const unsigned char*)(ws + WS_VTA) + (long)((b * 2 + kvh) * 64) * SEQ, shm, wave);
            } else { const int a = s_ - 768, ii = a >> 8, vv = a & 255, xg = vv >> 5, id = 3 * xg + ii, b = id >> 2, h = id & 3;
                att::attn_first_dma<4>((const unsigned char*)(ws + WS_KB) + (long)b * SEQ * 384 + (2 * h + p_) * 48, 384, (const unsigned char*)(ws + WS_VTB) + (long)((b * 4 + h) * 128) * SEQ, shm, wave); }
        };
        if (use8 && vcu < 1536) first_dma(vcu, 0);
        for (int s = vcu; s < 1536; s += G) {
            const bool isB = s >= 768;
            if (!isB) {
                const int u = (s >> 8) * 32 + (s & 31), xg = (s & 255) >> 5, qb = u & 15, j = u >> 4, id = 3 * xg + (j >> 1), sel = j & 1, b = id >> 2;
                const long rowbase = (long)b * SEQ + qb * 512 + wave * 64;
                const int kvh = (id >> 1) & 1, h = 4 * kvh + 2 * (id & 1) + sel;
                const h16_t* Qw = (const h16_t*)(ws + WS_QA) + rowbase * 512 + h * 64;
                const h16_t* Kh = (const h16_t*)(ws + WS_KA) + (long)b * SEQ * 128 + kvh * 64;
                const h16_t* Vh = (const h16_t*)(ws + WS_VA) + (long)b * SEQ * 128 + kvh * 64;
                f32x16 oa[2], ob[2]; float la, lb;
                if (use8) att::attn_pass8_2x((const unsigned char*)(ws + WS_QA) + rowbase * 384 + h * 48, 384, (const unsigned char*)(ws + WS_KA) + (long)b * SEQ * 96 + kvh * 48, 96,
                                             (const unsigned char*)(ws + WS_VTA) + (long)((b * 2 + kvh) * 64) * SEQ, mIA, shm, oa, ob, la, lb, wave, true);
                if (use8 && s + G < 1536) first_dma(s + G, 0);
                auto epiA = [&](const f32x16 (&o)[2], float l, long rb) {
                    int tid2 = wave * 64 + lane_id(); asm volatile("" : "+v"(tid2));
                    const int lane = tid2 & 63, r32 = lane & 31, hi = lane >> 5;
                    float* wsf = (float*)(shm + att::LDS_WS) + wave * 64;
                    h16_t* stg = (h16_t*)(shm + att::LDS_OST + wave * att::OST_WAVE);
                    if (hi == 0) wsf[32 + r32] = l; asm volatile("s_waitcnt lgkmcnt(0)" ::: "memory");
                    float rli[16];
#pragma unroll
                    for (int r = 0; r < 16; ++r) rli[r] = __builtin_amdgcn_rcpf(wsf[32 + att::crow(r, hi)]);
#pragma unroll
                    for (int r = 0; r < 16; ++r) { const int orow = att::crow(r, hi);
#pragma unroll
                        for (int d0 = 0; d0 < 2; ++d0) stg[orow * 64 + d0 * 32 + r32] = f2h(o[d0][r] * rli[r]); }
                    asm volatile("s_waitcnt lgkmcnt(0)" ::: "memory");
                    h16_t* Ow = OAB + rb * 1024 + h * 64;
#pragma unroll
                    for (int i = 0; i < 4; ++i) { const int row = i * 8 + (lane >> 3), ch = lane & 7; const u32x4 v = *(const u32x4*)(stg + row * 64 + ch * 8); *(u32x4*)(Ow + (long)row * 1024 + ch * 8) = v; }
                    asm volatile("s_waitcnt lgkmcnt(0)" ::: "memory");
                };
                if (use8) { epiA(oa, la, rowbase); epiA(ob, lb, rowbase + 32); }
                else {
#pragma unroll 1
                    for (int sub = 0; sub < 2; ++sub) { att::attn_pass<8, false>(Qw + (long)sub * 32 * 512, 512, Kh, 128, Vh, 128, shm, oa, la, wave); epiA(oa, la, rowbase + 32 * sub); }
                }
            } else {
                const int a = s - 768, ii = a >> 8, vv = a & 255, xg = vv >> 5, qb = vv & 31, id = 3 * xg + ii, b = id >> 2, h = id & 3;
                const long rowbase = (long)b * SEQ + qb * 256 + wave * 32;
                const h16_t* Vh = (const h16_t*)(ws + WS_VB) + (long)b * SEQ * 512 + h * 128;
#pragma unroll 1
                for (int p = 0; p < 2; ++p) {
                    const h16_t* Qw = (const h16_t*)(ws + WS_QB) + rowbase * 512 + (2 * h + p) * 64;
                    const h16_t* Kh = (const h16_t*)(ws + WS_KB) + (long)b * SEQ * 512 + (2 * h + p) * 64;
                    f32x16 o[4]; float l;
                    if (use8) att::attn_pass8<4>((const unsigned char*)(ws + WS_QB) + rowbase * 384 + (2 * h + p) * 48, 384, (const unsigned char*)(ws + WS_KB) + (long)b * SEQ * 384 + (2 * h + p) * 48, 384,
                                                 (const unsigned char*)(ws + WS_VTB) + (long)((b * 4 + h) * 128) * SEQ, mIB, shm, o, l, wave, true);
                    else att::attn_pass128<8, false>(Qw, 512, Kh, 512, Vh, 512, shm, o, l, wave);
                    if (use8) { if (p == 0) first_dma(s, 1); else if (s + G < 1536) first_dma(s + G, 0); }
                    int tid2 = wave * 64 + lane_id(); asm volatile("" : "+v"(tid2));
                    const int lane = tid2 & 63, r32 = lane & 31, hi = lane >> 5;
                    float* wsf = (float*)(shm + att::LDS_WS) + wave * 64;
                    unsigned* stw = (unsigned*)(shm + att::LDS_OST + wave * att::OST_WAVE);
                    h16_t* stg = (h16_t*)stw;
                    if (hi == 0) wsf[32 + r32] = l; asm volatile("s_waitcnt lgkmcnt(0)" ::: "memory");
                    float rli[16];
#pragma unroll
                    for (int r = 0; r < 16; ++r) rli[r] = __builtin_amdgcn_rcpf(wsf[32 + att::crow(r, hi)]);
                    if (p == 0) {
#pragma unroll
                        for (int d0 = 0; d0 < 4; ++d0)
#pragma unroll
                            for (int r = 0; r < 16; r += 2) stw[(d0 * 8 + (r >> 1)) * 64 + lane] = pk2h(o[d0][r] * rli[r], o[d0][r + 1] * rli[r + 1]);
                        asm volatile("s_waitcnt lgkmcnt(0)" ::: "memory");
                    } else {
                        unsigned sv[32];
#pragma unroll
                        for (int i = 0; i < 32; ++i) sv[i] = stw[i * 64 + lane];
                        asm volatile("s_waitcnt lgkmcnt(0)" ::: "memory");
#pragma unroll
                        for (int d0 = 0; d0 < 4; ++d0)
#pragma unroll
                            for (int r = 0; r < 16; ++r) { const unsigned w = sv[d0 * 8 + (r >> 1)]; const float o0 = h2f((unsigned short)((r & 1) ? (w >> 16) : (w & 0xffffu)));
                                const float dv = o0 - lam * (o[d0][r] * rli[r]);
                                stg[att::crow(r, hi) * 128 + d0 * 32 + r32] = f2h(dv); }
                        asm volatile("s_waitcnt lgkmcnt(0)" ::: "memory");
                        const float* sg = A.subln_g;
                        h16_t* Ow = OAB + rowbase * 1024 + 512 + h * 128;
#pragma unroll
                        for (int i = 0; i < 8; ++i) { const int row = i * 4 + (lane >> 4), ch = lane & 15; const u32x4 v = *(const u32x4*)(stg + row * 128 + ch * 8);
                            float f[8]; float q = 0.f;
#pragma unroll
                            for (int e = 0; e < 4; ++e) { f[2 * e] = h2f((unsigned short)(v[e] & 0xffffu)); f[2 * e + 1] = h2f((unsigned short)(v[e] >> 16)); q += f[2 * e] * f[2 * e] + f[2 * e + 1] * f[2 * e + 1]; }
                            q += __shfl_xor(q, 1); q += __shfl_xor(q, 2); q += __shfl_xor(q, 4); q += __shfl_xor(q, 8);
                            const float rn = __builtin_amdgcn_rsqf(q * (1.0f / 128.0f) + EPS) * (1.0f - LAM_INIT);
                            const f32x4 g0 = *(const f32x4*)(sg + ch * 8), g1 = *(const f32x4*)(sg + ch * 8 + 4);
                            u32x4 w; w.x = pk2h(f[0] * rn * g0[0], f[1] * rn * g0[1]); w.y = pk2h(f[2] * rn * g0[2], f[3] * rn * g0[3]); w.z = pk2h(f[4] * rn * g1[0], f[5] * rn * g1[1]); w.w = pk2h(f[6] * rn * g1[2], f[7] * rn * g1[3]);
                            *(u32x4*)(Ow + (long)row * 1024 + ch * 8) = w; }
                        asm volatile("s_waitcnt lgkmcnt(0)" ::: "memory");
                    }
                }
            }
        }
    }
    xcd_barrier(xbar);

    {
        const int u8 = p4_u8;
        {
            const int nt16 = u8 ? 4 : 12;
            pg8::Gemm g{(const h16_t*)(ws + WS_XN), (const h16_t*)(ws + WS_WIN) + (size_t)9 * 256 * DM, TOK, nt16 * 256, DM}; pg8::StaticOrder S; S.init(TOK, nt16 * 256, G, bx);
            EpiInProj E{1, ws, 0, 0, 1.0f};
            pg8::gemm_phase<EpiInProj>(ldsl, g, S, E, wave);
        }
        if (u8) {
            pg8::Gemm g{(const h16_t*)(ws + WS_XN8), (const h16_t*)(ws + WS_WIN8G), TOK, 8 * 256, DM / 2, 0x7f00 | (127 - p4_eg)}; pg8::StaticOrder S; S.init(TOK, 8 * 256, G, bx);
            EpiInProj E{1, ws, 0, 4, 1.0f};
            pg8::gemm_phase<EpiInProj, false, true>(ldsl, g, S, E, wave);
        }
    }
    xcd_barrier(xbar);

    {
        pg8::Gemm g{(const h16_t*)(ws + WS_OAB), (const h16_t*)(ws + WS_WAB), TOK, 2048, DM}; pg8::StaticOrder S; S.init(TOK, 2048, G, bx);
        EpiMerge E{ws + WS_SGA, ws + WS_SGB, (h16_t*)(ws + WS_MG)};
        pg8::gemm_phase<EpiMerge, true>(ldsl, g, S, E, wave);
    }
    xcd_barrier(xbar);

    {
        pg8::Gemm g{(const h16_t*)(ws + WS_MG), (const h16_t*)(ws + WS_WOUT), TOK, DM, DM}; pg8::StaticOrder S; S.init(TOK, DM, G, bx);
        EpiOut E{A.x_prompt, (long)((const char*)A.x_sample - (const char*)A.x_prompt) - (long)TOKP * DM * 4, (const float*)(ws + WS_GATE), A.out};
        pg8::gemm_phase<EpiOut>(ldsl, g, S, E, wave);
    }
}

extern "C" void kernel_launch(void* const* d_in, const int* in_sizes, int n_in, void* d_out, int out_size, void* d_ws, size_t ws_size, hipStream_t stream) {
    static int grid = 0;
    if (grid == 0) {
        if (n_in != 20 || out_size != TOK * DM || ws_size < WS_END) { fprintf(stderr, "kernel_launch: unexpected shapes (n_in %d out %d ws %zu)\n", n_in, out_size, ws_size); grid = -1; return; }
        int dev = 0, cus = 0, per_cu = 0;
        hipGetDevice(&dev); hipDeviceGetAttribute(&cus, hipDeviceAttributeMultiprocessorCount, dev);
        hipFuncSetAttribute((const void*)mega_fwd, hipFuncAttributeMaxDynamicSharedMemorySize, LDS_BYTES);
        hipOccupancyMaxActiveBlocksPerMultiprocessor(&per_cu, (const void*)mega_fwd, NWAVES * 64, LDS_BYTES);
        (void)hipGetLastError();
        if (per_cu < 1) fprintf(stderr, "kernel_launch: occupancy query reports %d blocks per CU\n", per_cu);
        grid = cus > 0 ? cus : 256;
    }
    if (grid < 0) return;
    Args a{};
    a.x_prompt = (const float*)d_in[0]; a.x_sample = (const float*)d_in[1]; a.c_prompt = (const float*)d_in[2]; a.c_sample = (const float*)d_in[3];
    a.w_ada = (const float*)d_in[4]; a.b_ada = (const float*)d_in[5]; a.norm_g = (const float*)d_in[6]; a.w_in = (const float*)d_in[7];
    a.qn_a = (const float*)d_in[8]; a.kn_a = (const float*)d_in[9]; a.qn_b = (const float*)d_in[10]; a.kn_b = (const float*)d_in[11];
    a.lq1 = (const float*)d_in[12]; a.lk1 = (const float*)d_in[13]; a.lq2 = (const float*)d_in[14]; a.lk2 = (const float*)d_in[15]; a.subln_g = (const float*)d_in[16];
    a.w_proj_a = (const float*)d_in[17]; a.w_proj_b = (const float*)d_in[18]; a.w_out = (const float*)d_in[19];
    a.out = (float*)d_out; a.ws = (unsigned char*)d_ws;
    if (hipMemsetAsync(d_ws, 0, XCD_BAR_WORDS * 4, stream) != hipSuccess) { fprintf(stderr, "kernel_launch: hipMemsetAsync failed\n"); return; }
    void* args[] = {&a};
    hipError_t e = hipLaunchCooperativeKernel((const void*)mega_fwd, dim3(grid), dim3(NWAVES * 64), args, LDS_BYTES, stream);
    if (e != hipSuccess) fprintf(stderr, "kernel_launch: cooperative launch failed: %s (grid %d)\n", hipGetErrorString(e), grid);
}
```
